# Optimizing an MI355X kernel written in HIP

```python
import math
import jax
import jax.numpy as jnp
from jax import lax
import numpy as np

D_MODEL = 1024
BATCH = 4
SEQ = 8192
DEPTH = 4

N_EVEN = (DEPTH + 1) // 2
N_ODD = DEPTH // 2
RMS_EPS = 1e-6
L2_EPS = 1e-6
D_FF = ((8 * D_MODEL + 3 * 256 - 1) // (3 * 256)) * 256

A_WIDTH = 256
A_CONV = 3
GDN_HEADS = 6
GDN_HEAD_DIM = 128
GDN_WIDTH = GDN_HEADS * GDN_HEAD_DIM
GDN_CONV = 4
GDN_CHUNK = 64
EV_SPLITS = (A_WIDTH, A_WIDTH, A_WIDTH, 3 * GDN_WIDTH, GDN_WIDTH, GDN_HEADS, GDN_HEADS)
EV_IN_COLS = sum(EV_SPLITS)
EV_MIX_WIDTH = A_WIDTH + GDN_WIDTH

RWKV_HEADS = 8
RWKV_HEAD_DIM = 64
RWKV_WIDTH = RWKV_HEADS * RWKV_HEAD_DIM
RWKV_W_LORA = 64
RWKV_A_LORA = 64
RWKV_V_LORA = 32
RWKV_G_LORA = 128
RWKV_LN_EPS = 64e-5
RWKV_SPLITS = (RWKV_WIDTH, RWKV_WIDTH, RWKV_WIDTH, RWKV_W_LORA, RWKV_A_LORA, RWKV_G_LORA)
RWKV_SHIFT_COLS = sum(RWKV_SPLITS)
MLA_HEADS = 8
MLA_NOPE = 64
MLA_ROPE = 32
MLA_V = 64
MLA_QK_DIM = MLA_NOPE + MLA_ROPE
MLA_Q_LORA = 512
MLA_KV_LORA = 256
MLA_WIDTH = MLA_HEADS * MLA_V
MLA_SPLITS = (MLA_Q_LORA, MLA_KV_LORA, MLA_ROPE)
MLA_IN_COLS = sum(MLA_SPLITS)
OD_IN_COLS = RWKV_SHIFT_COLS + MLA_IN_COLS
OD_MIX_WIDTH = RWKV_WIDTH + MLA_WIDTH
ROPE_THETA = 10000.0
Q_BLOCK = 128

kernel_name = 'hybrid_conv_gdn_rwkv7_mla_trunk'


def split_cols(z, sizes):
    return jnp.split(z, [int(s) for s in np.cumsum(sizes)[:-1]], axis=-1)


def rms_norm(x, gain, eps=RMS_EPS):
    xf = x.astype(jnp.float32)
    y = xf * lax.rsqrt(jnp.mean(xf * xf, axis=-1, keepdims=True) + eps)
    return (y * gain.astype(jnp.float32)).astype(x.dtype)


def l2_normalize(x):
    xf = x.astype(jnp.float32)
    return xf * lax.rsqrt(jnp.sum(xf * xf, axis=-1, keepdims=True) + L2_EPS)


def token_shift(z):
    return jnp.pad(z, ((0, 0), (1, 0), (0, 0)))[:, :-1]


def shift_lerp(z, mu):
    return z + mu * (token_shift(z) - z)


def causal_depthwise_conv(x, w):
    K = w.shape[0]
    T = x.shape[1]
    xp = jnp.pad(x, ((0, 0), (K - 1, 0), (0, 0)))
    y = xp[:, 0:T] * w[0]
    for j in range(1, K):
        y = y + xp[:, j:j + T] * w[j]
    return y


def swiglu(xn, w_gu, w_down):
    gate, up = jnp.split(xn @ w_gu, 2, axis=-1)
    return (jax.nn.silu(gate) * up) @ w_down


def rope_tables(positions):
    inv_freq = ROPE_THETA ** (-jnp.arange(0, MLA_ROPE, 2, dtype=jnp.float32) / MLA_ROPE)
    ang = positions.astype(jnp.float32)[..., None] * inv_freq
    return jnp.cos(ang), jnp.sin(ang)


def apply_rope(x, cos, sin):
    x = x.astype(jnp.float32)
    x1, x2 = jnp.split(x, 2, axis=-1)
    c = cos[:, :, None, :]
    s = sin[:, :, None, :]
    return jnp.concatenate([x1 * c - x2 * s, x2 * c + x1 * s], axis=-1)


def unit_lower_inverse(L):
    C = L.shape[-1]
    cols = jnp.arange(C)

    def body(i, A):
        row = A[..., i, :]
        upd = row + jnp.einsum('...j,...jk->...k', row, A)
        return A.at[..., i, :].set(jnp.where(cols < i, upd, row))

    A = lax.fori_loop(1, C, body, -L)
    return A + jnp.eye(C, dtype=L.dtype)


def to_chunks(t):
    b, T, h = t.shape[:3]
    t = t.reshape(b, T // GDN_CHUNK, GDN_CHUNK, h, *t.shape[3:])
    return jnp.moveaxis(t, 3, 1)


def gated_delta_rule_chunked(q, k, v, g, beta):
    B_, T, H, dk = q.shape
    dv = v.shape[-1]
    q = to_chunks(q * dk ** -0.5)
    k = to_chunks(k)
    v = to_chunks(v)
    beta = to_chunks(beta)
    g = jnp.cumsum(to_chunks(g), axis=-1)
    idx = jnp.arange(GDN_CHUNK)
    causal = idx[:, None] >= idx[None, :]
    strict = idx[:, None] > idx[None, :]
    diff = g[..., :, None] - g[..., None, :]
    decay = jnp.where(causal, jnp.exp(jnp.where(causal, diff, 0.0)), 0.0)
    kb = k * beta[..., None]
    L = jnp.where(strict, jnp.einsum('bhncd,bhnsd->bhncs', kb, k) * decay, 0.0)
    Tm = unit_lower_inverse(L)
    u = jnp.einsum('bhncs,bhnse->bhnce', Tm, v * beta[..., None])
    w = jnp.einsum('bhncs,bhnsd->bhncd', Tm, kb * jnp.exp(g)[..., None])
    qk = jnp.einsum('bhncd,bhnsd->bhncs', q, k) * decay
    q_dec = q * jnp.exp(g)[..., None]
    k_dec = k * jnp.exp(g[..., -1:] - g)[..., None]
    g_tot = jnp.exp(g[..., -1])
    xs = tuple(jnp.moveaxis(t, 2, 0) for t in (u, w, q_dec, k_dec, qk, g_tot))

    def step(S, inp):
        u_n, w_n, qd_n, kd_n, qk_n, gt_n = inp
        v_new = u_n - jnp.einsum('bhcd,bhde->bhce', w_n, S)
        o_n = jnp.einsum('bhcd,bhde->bhce', qd_n, S) + jnp.einsum('bhcs,bhse->bhce', qk_n, v_new)
        S = S * gt_n[..., None, None] + jnp.einsum('bhcd,bhce->bhde', kd_n, v_new)
        return S, o_n

    S0 = jnp.zeros((B_, H, dk, dv), jnp.float32)
    _, o = lax.scan(step, S0, xs)
    o = jnp.moveaxis(o, 0, 2)
    return jnp.moveaxis(o, 1, 3).reshape(B_, T, H, dv)


def rwkv7_scan(r, decay, k, v, kk, a):
    B_, T, H, N = r.shape

    def step(S, inp):
        r_t, w_t, k_t, v_t, kk_t, a_t = inp
        sa = jnp.einsum('bhvk,bhk->bhv', S, -kk_t)
        S = S * w_t[:, :, None, :] + sa[..., :, None] * (kk_t * a_t)[..., None, :] + v_t[..., :, None] * k_t[..., None, :]
        return S, jnp.einsum('bhvk,bhk->bhv', S, r_t)

    xs = tuple(jnp.moveaxis(t.astype(jnp.float32), 1, 0) for t in (r, decay, k, v, kk, a))
    S0 = jnp.zeros((B_, H, N, N), jnp.float32)
    _, y = lax.scan(step, S0, xs)
    return jnp.moveaxis(y, 0, 1)


def blocked_causal_attention(q, k, v):
    B_, T, H, d = q.shape
    dv = v.shape[-1]
    nb = T // Q_BLOCK
    scale = d ** -0.5
    qb = q.reshape(B_, nb, Q_BLOCK, H, d).transpose(1, 0, 3, 2, 4)
    kf = k.transpose(0, 2, 1, 3)
    vf = v.transpose(0, 2, 1, 3)
    key_pos = jnp.arange(T)

    def one_block(args):
        q_blk, blk = args
        s = jnp.einsum('bhqd,bhkd->bhqk', q_blk, kf).astype(jnp.float32) * scale
        q_pos = blk * Q_BLOCK + jnp.arange(Q_BLOCK)
        s = jnp.where(key_pos[None, :] <= q_pos[:, None], s, -jnp.inf)
        p = jax.nn.softmax(s, axis=-1)
        return jnp.einsum('bhqk,bhkd->bhqd', p, vf)

    o = lax.map(one_block, (qb, jnp.arange(nb)))
    return o.transpose(1, 0, 3, 2, 4).reshape(B_, T, H, dv)


def even_mixer(xn, w_in, conv_a, conv_qkv, a_log, dt_bias, out_norm, w_out):
    B_, T, _ = xn.shape
    a_b, a_c, a_h, qkv, gate_z, b_raw, a_raw = split_cols(xn @ w_in, EV_SPLITS)
    y_a = a_b * causal_depthwise_conv(a_c * a_h, conv_a)
    qkv = jax.nn.silu(causal_depthwise_conv(qkv, conv_qkv))
    q, k, v = [t.reshape(B_, T, GDN_HEADS, GDN_HEAD_DIM) for t in jnp.split(qkv, 3, axis=-1)]
    beta = jax.nn.sigmoid(b_raw.astype(jnp.float32))
    g = -jnp.exp(a_log.astype(jnp.float32)) * jax.nn.softplus(a_raw.astype(jnp.float32) + dt_bias.astype(jnp.float32))
    o = gated_delta_rule_chunked(l2_normalize(q), l2_normalize(k), v.astype(jnp.float32), g, beta)
    o = rms_norm(o, out_norm) * jax.nn.silu(gate_z.reshape(B_, T, GDN_HEADS, GDN_HEAD_DIM).astype(jnp.float32))
    y = jnp.concatenate([y_a, o.reshape(B_, T, GDN_WIDTH).astype(xn.dtype)], axis=-1)
    return y @ w_out


def odd_mixer(xn, cos, sin, v_first, w_in, shift_mu, w0, w2, a0, a2, g2, k_k, k_a, r_k,
              lnx_w, lnx_b, qa_norm, kva_norm, w_uq, w_ukv, q_ln, k_ln, w_out, vres):
    B_, T, _ = xn.shape
    if vres is not None:
        w_in = jnp.concatenate([w_in, vres[0]], axis=1)
    z = xn @ w_in
    z_rwkv = shift_lerp(z[..., :RWKV_SHIFT_COLS], shift_mu).astype(jnp.float32)
    r, k, v, wd, ad, gd = split_cols(z_rwkv, RWKV_SPLITS)
    w_log = -jax.nn.softplus(-(w0 + jnp.tanh(wd) @ w2)) - 0.5
    decay = jnp.exp(-jnp.exp(w_log))
    a = jax.nn.sigmoid(a0 + ad @ a2)
    g = jax.nn.sigmoid(gd) @ g2
    if vres is None:
        v_first = v
    else:
        vd = shift_lerp(z[..., OD_IN_COLS:], vres[1]).astype(jnp.float32)
        v = v + (v_first - v) * jax.nn.sigmoid(vres[2] + vd @ vres[3])
    hshape = (B_, T, RWKV_HEADS, RWKV_HEAD_DIM)
    kk = l2_normalize((k * k_k).reshape(hshape))
    k = k * (1.0 + (a - 1.0) * k_a)
    r_h, k_h, v_h = r.reshape(hshape), k.reshape(hshape), v.reshape(hshape)
    y = rwkv7_scan(r_h, decay.reshape(hshape), k_h, v_h, kk, a.reshape(hshape))
    mu = jnp.mean(y, axis=-1, keepdims=True)
    var = jnp.mean(jnp.square(y - mu), axis=-1, keepdims=True)
    y = ((y - mu) * lax.rsqrt(var + RWKV_LN_EPS)).reshape(B_, T, RWKV_WIDTH) * lnx_w + lnx_b
    y = y + (jnp.sum(r_h * k_h * r_k, axis=-1, keepdims=True) * v_h).reshape(B_, T, RWKV_WIDTH)
    y_rwkv = y * g
    cq, ckv, k_rope = split_cols(z[..., RWKV_SHIFT_COLS:OD_IN_COLS], MLA_SPLITS)
    q = (rms_norm(cq, qa_norm) @ w_uq).reshape(B_, T, MLA_HEADS, MLA_QK_DIM)
    kv = (rms_norm(ckv, kva_norm) @ w_ukv).reshape(B_, T, MLA_HEADS, MLA_NOPE + MLA_V)
    k_nope, v_mla = jnp.split(kv, [MLA_NOPE], axis=-1)
    k_rope_h = jnp.broadcast_to(k_rope[:, :, None, :], (B_, T, MLA_HEADS, MLA_ROPE))
    k_mla = rms_norm(jnp.concatenate([k_nope, k_rope_h], axis=-1), k_ln)
    q = rms_norm(q, q_ln)
    q = jnp.concatenate([q[..., :MLA_NOPE].astype(jnp.float32), apply_rope(q[..., MLA_NOPE:], cos, sin)], axis=-1)
    k_mla = jnp.concatenate([k_mla[..., :MLA_NOPE].astype(jnp.float32), apply_rope(k_mla[..., MLA_NOPE:], cos, sin)], axis=-1)
    o = blocked_causal_attention(q, k_mla, v_mla.astype(jnp.float32))
    y_mix = jnp.concatenate([y_rwkv.astype(xn.dtype), o.reshape(B_, T, MLA_WIDTH).astype(xn.dtype)], axis=-1)
    return y_mix @ w_out, v_first


def setup_inputs(seed: int = 0) -> dict:
    key = jax.random.key(seed)
    keys = jax.random.split(key, 48)
    counter = [0]

    def nk():
        counter[0] += 1
        return keys[counter[0] - 1]

    def nrm(shape, scale):
        return jax.random.normal(nk(), shape, jnp.float32) * scale

    def gain(shape):
        return 1.0 + nrm(shape, 0.02)

    def unif(shape, lo, hi):
        return jax.random.uniform(nk(), shape, jnp.float32, lo, hi)

    NE, NO, NV = N_EVEN, N_ODD, N_ODD - 1
    x = jax.random.normal(nk(), (BATCH, SEQ, D_MODEL), jnp.float32)
    positions = jax.random.randint(nk(), (BATCH, 1), 0, 1024, dtype=jnp.int32) + jnp.arange(SEQ, dtype=jnp.int32)[None, :]
    dt = jnp.exp(unif((NE, GDN_HEADS), math.log(1e-3), math.log(1e-1)))
    return {
        'x': x,
        'positions': positions,
        'norm_mix': gain((DEPTH, D_MODEL)),
        'norm_ffn': gain((DEPTH, D_MODEL)),
        'ffn_w_gu': nrm((DEPTH, D_MODEL, 2 * D_FF), D_MODEL ** -0.5),
        'ffn_w_down': nrm((DEPTH, D_FF, D_MODEL), D_FF ** -0.5),
        'ev_w_in': nrm((NE, D_MODEL, EV_IN_COLS), D_MODEL ** -0.5),
        'ev_conv_a': nrm((NE, A_CONV, A_WIDTH), A_CONV ** -0.5),
        'ev_conv_qkv': nrm((NE, GDN_CONV, 3 * GDN_WIDTH), GDN_CONV ** -0.5),
        'ev_a_log': jnp.log(unif((NE, GDN_HEADS), 1.0, 16.0)),
        'ev_dt_bias': dt + jnp.log(-jnp.expm1(-dt)),
        'ev_out_norm': gain((NE, GDN_HEAD_DIM)),
        'ev_w_out': nrm((NE, EV_MIX_WIDTH, D_MODEL), EV_MIX_WIDTH ** -0.5),
        'od_w_in': nrm((NO, D_MODEL, OD_IN_COLS), D_MODEL ** -0.5),
        'od_shift_mu': unif((NO, RWKV_SHIFT_COLS), 0.0, 1.0),
        'od_w0': unif((NO, RWKV_WIDTH), -6.0, -1.0),
        'od_w2': nrm((NO, RWKV_W_LORA, RWKV_WIDTH), 0.1),
        'od_a0': nrm((NO, RWKV_WIDTH), 0.1),
        'od_a2': nrm((NO, RWKV_A_LORA, RWKV_WIDTH), 0.5 * RWKV_A_LORA ** -0.5),
        'od_g2': nrm((NO, RWKV_G_LORA, RWKV_WIDTH), RWKV_G_LORA ** -0.5),
        'od_k_k': 0.85 + nrm((NO, RWKV_WIDTH), 0.05),
        'od_k_a': 1.0 + nrm((NO, RWKV_WIDTH), 0.05),
        'od_r_k': nrm((NO, RWKV_HEADS, RWKV_HEAD_DIM), 0.1),
        'od_lnx_w': gain((NO, RWKV_WIDTH)),
        'od_lnx_b': nrm((NO, RWKV_WIDTH), 0.01),
        'od_vres_w1': nrm((NV, D_MODEL, RWKV_V_LORA), D_MODEL ** -0.5),
        'od_vres_mu': unif((NV, RWKV_V_LORA), 0.0, 1.0),
        'od_vres_v0': nrm((NV, RWKV_WIDTH), 0.1),
        'od_vres_v2': nrm((NV, RWKV_V_LORA, RWKV_WIDTH), 0.5 * RWKV_V_LORA ** -0.5),
        'od_qa_norm': gain((NO, MLA_Q_LORA)),
        'od_kva_norm': gain((NO, MLA_KV_LORA)),
        'od_w_uq': nrm((NO, MLA_Q_LORA, MLA_HEADS * MLA_QK_DIM), MLA_Q_LORA ** -0.5),
        'od_w_ukv': nrm((NO, MLA_KV_LORA, MLA_HEADS * (MLA_NOPE + MLA_V)), MLA_KV_LORA ** -0.5),
        'od_q_ln': gain((NO, MLA_QK_DIM)),
        'od_k_ln': gain((NO, MLA_QK_DIM)),
        'od_w_out': nrm((NO, OD_MIX_WIDTH, D_MODEL), OD_MIX_WIDTH ** -0.5),
    }


def reference(x, positions, norm_mix, norm_ffn, ffn_w_gu, ffn_w_down,
              ev_w_in, ev_conv_a, ev_conv_qkv, ev_a_log, ev_dt_bias, ev_out_norm, ev_w_out,
              od_w_in, od_shift_mu, od_w0, od_w2, od_a0, od_a2, od_g2, od_k_k, od_k_a, od_r_k,
              od_lnx_w, od_lnx_b, od_vres_w1, od_vres_mu, od_vres_v0, od_vres_v2,
              od_qa_norm, od_kva_norm, od_w_uq, od_w_ukv, od_q_ln, od_k_ln, od_w_out):
    cos, sin = rope_tables(positions)
    v_first = None
    for layer in range(DEPTH):
        xn = rms_norm(x, norm_mix[layer])
        if layer % 2 == 0:
            e = layer // 2
            h = even_mixer(xn, ev_w_in[e], ev_conv_a[e], ev_conv_qkv[e], ev_a_log[e],
                           ev_dt_bias[e], ev_out_norm[e], ev_w_out[e])
        else:
            o = layer // 2
            vres = None if o == 0 else (od_vres_w1[o - 1], od_vres_mu[o - 1], od_vres_v0[o - 1], od_vres_v2[o - 1])
            h, v_first = odd_mixer(xn, cos, sin, v_first, od_w_in[o], od_shift_mu[o], od_w0[o], od_w2[o],
                                   od_a0[o], od_a2[o], od_g2[o], od_k_k[o], od_k_a[o], od_r_k[o],
                                   od_lnx_w[o], od_lnx_b[o], od_qa_norm[o], od_kva_norm[o], od_w_uq[o],
                                   od_w_ukv[o], od_q_ln[o], od_k_ln[o], od_w_out[o], vres)
        x = x + h
        x = x + swiglu(rms_norm(x, norm_ffn[layer]), ffn_w_gu[layer], ffn_w_down[layer])
    return x
```

```cpp
#include <hip/hip_runtime.h>
#include <hip/hip_cooperative_groups.h>
#include <cstdint>
#include <cstdio>
namespace cg = cooperative_groups;

#ifndef MULTI_LAUNCH
#define MULTI_LAUNCH 0
#endif

#ifndef PHASE_MASK
#define PHASE_MASK 0xFFFF
#endif
constexpr int PM = PHASE_MASK;
#ifndef DUP_MASK
#define DUP_MASK 0
#endif
constexpr int DM = DUP_MASK;
#define LAS __attribute__((address_space(3)))
typedef unsigned short bf16_t;
typedef short bf16x8 __attribute__((ext_vector_type(8)));
typedef short s16x4 __attribute__((ext_vector_type(4)));
typedef float f32x4 __attribute__((ext_vector_type(4)));
typedef float f32x2 __attribute__((ext_vector_type(2)));
typedef float f32x16 __attribute__((ext_vector_type(16)));
typedef unsigned u32x4 __attribute__((ext_vector_type(4)));
typedef unsigned u32x2 __attribute__((ext_vector_type(2)));
typedef __bf16 bf16x2_t __attribute__((ext_vector_type(2)));

constexpr int T_ = 8192, M_ = 32768, D_ = 1024, DFF = 2816;
constexpr int ZLD_E = 3856, ZLD_O = 2816;
constexpr size_t MiB = 1u << 20;
constexpr size_t WS_WB = 1 * MiB, WS_AB = 33 * MiB, WS_VF = 97 * MiB, WS_Z = 129 * MiB;
constexpr size_t WS_U = 370 * MiB, WS_WN = 418 * MiB, WS_GC = 466 * MiB, WS_HALO = 468 * MiB, WS_GCB = 476 * MiB;
constexpr size_t WS_CTL = 0;
constexpr size_t WS_RKV = 129 * MiB, WS_Z2 = 225 * MiB, WS_KH = 225 * MiB, WS_VT = 273 * MiB;
constexpr size_t WS_LA = 305 * MiB, WS_LO = 329 * MiB, WS_KR = 457 * MiB, WS_RS = 459 * MiB;
constexpr size_t WS_QR = 460 * MiB, WS_KVR = 33 * MiB;
constexpr size_t WS_BND = 508 * MiB;
constexpr size_t WS_NEED = 511 * MiB;
constexpr int RKV_LD = 1536, Z2_LD = 1280, SCAN_BLOCKS = 128;
constexpr size_t WB_GU = 0, WB_DN = 11534336, WB_IN = 17301504, WB_OUT = 25690112, WB_LORA = 27787264, WB_UQ = 29360128, WB_UKV = 30146560;
constexpr int LDS_BYTES = 135168;

__device__ __forceinline__ float asf(unsigned u) { return __builtin_bit_cast(float, u); }
__device__ __forceinline__ unsigned asu(float f) { return __builtin_bit_cast(unsigned, f); }
__device__ __forceinline__ float bf2f(bf16_t b) { return asf((unsigned)b << 16); }
__device__ __forceinline__ unsigned pk2(float lo, float hi) { f32x2 v = {lo, hi}; bf16x2_t b = __builtin_convertvector(v, bf16x2_t); return __builtin_bit_cast(unsigned, b); }
__device__ __forceinline__ bf16_t f2bf(float f) { return (bf16_t)(pk2(f, 0.f) & 0xffffu); }
__device__ __forceinline__ void unpack8(u32x4 v, float* f) {
    f[0] = asf(v.x << 16); f[1] = asf(v.x & 0xffff0000u); f[2] = asf(v.y << 16); f[3] = asf(v.y & 0xffff0000u);
    f[4] = asf(v.z << 16); f[5] = asf(v.z & 0xffff0000u); f[6] = asf(v.w << 16); f[7] = asf(v.w & 0xffff0000u);
}
__device__ __forceinline__ u32x4 pack8(const float* f) { u32x4 o; o.x = pk2(f[0], f[1]); o.y = pk2(f[2], f[3]); o.z = pk2(f[4], f[5]); o.w = pk2(f[6], f[7]); return o; }
__device__ __forceinline__ float sigmoidf_(float x) { return __builtin_amdgcn_rcpf(1.f + __expf(-x)); }
__device__ __forceinline__ float siluf_(float x) { return x * __builtin_amdgcn_rcpf(1.f + __expf(-x)); }
__device__ __forceinline__ float softplusf_(float x) { return x > 20.f ? x : log1pf(__expf(x)); }
__device__ __forceinline__ int crow(int r, int hi) { return (r & 3) + 8 * (r >> 2) + 4 * hi; }
__device__ __forceinline__ float wsum(float v) {
#pragma unroll
    for (int o = 32; o > 0; o >>= 1) v += __shfl_xor(v, o);
    return v;
}
template <int CTRL> __device__ __forceinline__ float dppf(float v) { return __builtin_bit_cast(float, __builtin_amdgcn_update_dpp(0, __builtin_bit_cast(int, v), CTRL, 0xF, 0xF, true)); }
__device__ __forceinline__ float half32_sum(float v) {
    v += dppf<0x128>(v); v += dppf<0x124>(v); v += dppf<0x122>(v); v += dppf<0x121>(v);
    auto r = __builtin_amdgcn_permlane16_swap(asu(v), asu(v), false, false);
    return asf(r[0]) + asf(r[1]);
}
__device__ __forceinline__ float wave_sum_dpp(float v) { v = half32_sum(v); auto r = __builtin_amdgcn_permlane32_swap(asu(v), asu(v), false, false); return asf(r[0]) + asf(r[1]); }
__device__ __forceinline__ float sum8_dpp(float v) { v += dppf<0xB1>(v); v += dppf<0x4E>(v); v += dppf<0x141>(v); return v; }
__device__ __forceinline__ float sum16_dpp(float v) { v += dppf<0xB1>(v); v += dppf<0x4E>(v); v += dppf<0x141>(v); v += dppf<0x140>(v); return v; }
__device__ __forceinline__ bf16x8 pkfrag(const f32x16& v, int s) {
    u32x4 o; o.x = pk2(v[8 * s + 0], v[8 * s + 1]); o.y = pk2(v[8 * s + 2], v[8 * s + 3]); o.z = pk2(v[8 * s + 4], v[8 * s + 5]); o.w = pk2(v[8 * s + 6], v[8 * s + 7]);
    return __builtin_bit_cast(bf16x8, o);
}
__device__ __forceinline__ bf16x8 ldA_perm(const LAS bf16_t* p) { s16x4 a = *(const LAS s16x4*)p; s16x4 b = *(const LAS s16x4*)(p + 8); return (bf16x8){a[0], a[1], a[2], a[3], b[0], b[1], b[2], b[3]}; }
#define LDS_WAIT() asm volatile("s_waitcnt lgkmcnt(0)" ::: "memory")
#define LDS_BARRIER() do { asm volatile("s_waitcnt lgkmcnt(0)" ::: "memory"); __builtin_amdgcn_s_barrier(); asm volatile("" ::: "memory"); } while (0)

namespace pg8 {
#define PG8_LAS __attribute__((address_space(3)))
constexpr int BM = 256, BK = 64, HALF = 128, HTB = HALF * BK * 2, STAGE_BYTES = 8 * HTB, NXCD = 8, WGM = 8;
__host__ __device__ __forceinline__ int lds_byte(int r, int c) { const int st = (r >> 4) * 2 + (c >> 5), rr = r & 15, cc = c & 31, ob = rr * 64 + cc * 2; return st * 1024 + (ob ^ (((ob >> 9) & 1) << 5)); }
__host__ __device__ __forceinline__ void stage_rc(int b, int& R, int& C) { const int st = b / 1024, sb = b % 1024, swz = sb ^ (((sb >> 9) & 1) << 5); R = (st >> 1) * 16 + swz / 64; C = (st & 1) * 32 + (swz % 64) / 2; }
__host__ __device__ __forceinline__ int perm32(int rho) { const int n = rho >> 4, i = rho & 15; return 8 * (i >> 2) + 4 * n + (i & 3); }
struct Unit { int pm, pn; };
struct Gemm { const bf16_t* A; const bf16_t* Bt; int M, N, K, lda; };
struct StaticOrder {
    int nM, nN, nwg, G, c;
    __host__ __device__ void init(int M, int N, int G_, int c_) { nM = M / BM; nN = N / BM; nwg = nM * nN; G = G_; c = c_; }
    __host__ __device__ bool next(int i, Unit& u) const {
        const long L = (long)i * G + c; if (L >= nwg) return false;
        int wgid = (int)L; { const int q = nwg / NXCD, r = nwg % NXCD, xcd = wgid % NXCD, off = wgid / NXCD; wgid = (xcd < r ? xcd * (q + 1) : r * (q + 1) + (xcd - r) * q) + off; }
        const int nig = WGM * nN, gid = wgid / nig, fm = gid * WGM, gsz = (nM - fm) < WGM ? (nM - fm) : WGM;
        u.pm = fm + ((wgid % nig) % gsz); u.pn = (wgid % nig) / gsz; return true;
    }
    __device__ __forceinline__ void a_ready(const Unit&) const {}
    __device__ __forceinline__ void done(const Unit&) const {}
};
struct EpiBf16 {
    static constexpr bool PERM = true;
    bf16_t* O; int ldc; int ncols;
    __device__ __forceinline__ void operator()(const f32x4 (&acc)[2][2][4][2], const Unit& u, int wr, int wc, int fr, int fq) const {
        const int row0 = u.pm * BM + wr * 64 + fr; const int col0 = u.pn * BM + wc * 32 + 8 * fq;
#pragma unroll
        for (int ai = 0; ai < 2; ++ai)
#pragma unroll
            for (int m = 0; m < 4; ++m) { bf16_t* rowp = O + (size_t)(row0 + ai * HALF + m * 16) * ldc + col0;
#pragma unroll
                for (int bj = 0; bj < 2; ++bj) { if (col0 + bj * HALF < ncols) { const f32x4 v0 = acc[ai][bj][m][0], v1 = acc[ai][bj][m][1];
                    u32x4 w; w.x = pk2(v0[0], v0[1]); w.y = pk2(v0[2], v0[3]); w.z = pk2(v1[0], v1[1]); w.w = pk2(v1[2], v1[3]);
                    *(u32x4*)(rowp + bj * HALF) = w; } } }
    }
};
struct EpiSplit {
    static constexpr bool PERM = true;
    bf16_t* O1; int ld1; int split; bf16_t* O2; int ld2; int ncols;
    __device__ __forceinline__ void operator()(const f32x4 (&acc)[2][2][4][2], const Unit& u, int wr, int wc, int fr, int fq) const {
        const int row0 = u.pm * BM + wr * 64 + fr; const int col0 = u.pn * BM + wc * 32 + 8 * fq;
#pragma unroll
        for (int bj = 0; bj < 2; ++bj) { const int cg = col0 + bj * HALF; if (cg < ncols) { bf16_t* base = (cg < split) ? O1 + cg : O2 + (cg - split); const int ld = (cg < split) ? ld1 : ld2;
#pragma unroll
            for (int ai = 0; ai < 2; ++ai)
#pragma unroll
                for (int m = 0; m < 4; ++m) { const f32x4 v0 = acc[ai][bj][m][0], v1 = acc[ai][bj][m][1];
                    u32x4 w; w.x = pk2(v0[0], v0[1]); w.y = pk2(v0[2], v0[3]); w.z = pk2(v1[0], v1[1]); w.w = pk2(v1[2], v1[3]);
                    *(u32x4*)(base + (size_t)(row0 + ai * HALF + m * 16) * ld) = w; } } }
    }
};
struct EpiSwiglu {
    static constexpr bool PERM = true;
    bf16_t* O; int ldc;
    __device__ __forceinline__ void operator()(const f32x4 (&acc)[2][2][4][2], const Unit& u, int wr, int wc, int fr, int fq) const {
        const int row0 = u.pm * BM + wr * 64 + fr; const int col0 = u.pn * HALF + wc * 32 + 8 * fq;
#pragma unroll
        for (int ai = 0; ai < 2; ++ai)
#pragma unroll
            for (int m = 0; m < 4; ++m) { bf16_t* rowp = O + (size_t)(row0 + ai * HALF + m * 16) * ldc + col0;
                float h[8];
#pragma unroll
                for (int n = 0; n < 2; ++n)
#pragma unroll
                    for (int i = 0; i < 4; ++i) { const float g = acc[ai][0][m][n][i], up = acc[ai][1][m][n][i]; h[4 * n + i] = siluf_(g) * up; }
                *(u32x4*)rowp = pack8(h); }
    }
};
struct EpiResid {
    static constexpr bool PERM = false;
    float* out; int ldc;
    __device__ __forceinline__ void operator()(const f32x4 (&acc)[2][2][4][2], const Unit& u, int wr, int wc, int fr, int fq) const {
        const int row0 = u.pm * BM + wr * 64 + fr; const int col0 = u.pn * BM + wc * 32 + 4 * fq;
#pragma unroll
        for (int ai = 0; ai < 2; ++ai)
#pragma unroll
            for (int m = 0; m < 4; ++m) { float* rowp = out + (size_t)(row0 + ai * HALF + m * 16) * ldc + col0;
#pragma unroll
                for (int bj = 0; bj < 2; ++bj)
#pragma unroll
                    for (int n = 0; n < 2; ++n) { f32x4* q = (f32x4*)(rowp + bj * HALF + n * 16); *q = *q + acc[ai][bj][m][n]; }
                asm volatile("" ::: "memory"); }
    }
};

template <class Epi, class Sched>
__device__ __forceinline__ void gemm_phase(PG8_LAS unsigned char* lds, const int tid, const Gemm g, const Sched& S, const Epi& E) {
    constexpr bool ALIGN_EPI = true;
    const int wid = __builtin_amdgcn_readfirstlane(tid >> 6), lane = tid & 63, wr = wid >> 2, wc = wid & 3, fr = lane & 15, fq = lane >> 4;
    const int K = g.K, nt = K / BK, lda = g.lda;
    unsigned voffA[2], voffB[2];
#pragma unroll
    for (int i = 0; i < 2; ++i) { int R, C; stage_rc(tid * 16 + i * 8192, R, C); const int Rb = Epi::PERM ? ((R & ~31) + perm32(R & 31)) : R;
        voffA[i] = (unsigned)(R * lda + C) * 2u; voffB[i] = (unsigned)(Rb * K + C) * 2u; }
    const size_t kstep = (size_t)(BK * 2);
    const size_t hstepA = (size_t)HALF * lda * 2, hstepB = (size_t)HALF * K * 2;
    const size_t tstepA = 2 * hstepA, tstepB = 2 * hstepB;
    const unsigned ldsw = (unsigned)wid * 1024u;
    const int aoff = lds_byte(wr * 64 + fr, fq * 8), boff = lds_byte(wc * 32 + fr, fq * 8);
#define PG8_SA(b, h) (((b) * 2 + (h)) * HTB)
#define PG8_SB(b, h) ((4 + (b) * 2 + (h)) * HTB)
#define PG8_STAGE(bufoff, gbase, voff) do { _Pragma("unroll") for (int _i = 0; _i < 2; ++_i) \
        __builtin_amdgcn_global_load_lds((const unsigned*)((const char*)(gbase) + (voff)[_i]), (PG8_LAS unsigned*)(lds + (bufoff) + ldsw + _i * 8192), 16, 0, 0); } while (0)
#define PG8_LDA(dst, b, h) do { _Pragma("unroll") for (int m = 0; m < 4; ++m) _Pragma("unroll") for (int k = 0; k < 2; ++k) dst[m][k] = *(const PG8_LAS bf16x8*)(lds + PG8_SA(b, h) + aoff + m * 2048 + k * 1024); } while (0)
#define PG8_LDB(dst, b, h) do { _Pragma("unroll") for (int n = 0; n < 2; ++n) _Pragma("unroll") for (int k = 0; k < 2; ++k) dst[n][k] = *(const PG8_LAS bf16x8*)(lds + PG8_SB(b, h) + boff + n * 2048 + k * 1024); } while (0)
#define PG8_MMA(ai, bj, At, Bt) do { __builtin_amdgcn_s_setprio(1); _Pragma("unroll") for (int m = 0; m < 4; ++m) _Pragma("unroll") for (int n = 0; n < 2; ++n) _Pragma("unroll") for (int k = 0; k < 2; ++k) \
        acc[ai][bj][m][n] = __builtin_amdgcn_mfma_f32_16x16x32_bf16(Bt[n][k], At[m][k], acc[ai][bj][m][n], 0, 0, 0); __builtin_amdgcn_s_setprio(0); } while (0)
#define PG8_WAIT_V(n) asm volatile("s_waitcnt vmcnt(" #n ")" ::: "memory")
#define PG8_WAIT_L(n) asm volatile("s_waitcnt lgkmcnt(" #n ")" ::: "memory")
#define PG8_BAR __builtin_amdgcn_s_barrier()
#define PG8_SCHED __builtin_amdgcn_sched_barrier(0)
    Unit cur, nxt; int ui = 0;
    if (!S.next(0, cur)) return;
    f32x4 acc[2][2][4][2];
#pragma unroll
    for (int a = 0; a < 2; ++a)
#pragma unroll
        for (int b = 0; b < 2; ++b)
#pragma unroll
            for (int m = 0; m < 4; ++m)
#pragma unroll
                for (int n = 0; n < 2; ++n) acc[a][b][m][n] = (f32x4){0.f, 0.f, 0.f, 0.f};
    bf16x8 At[4][2], B0[2][2], B1[2][2];
    const char* cA = (const char*)g.A + (size_t)cur.pm * tstepA; const char* cB = (const char*)g.Bt + (size_t)cur.pn * tstepB;
    S.a_ready(cur);
    PG8_STAGE(PG8_SB(0, 0), cB, voffB); PG8_STAGE(PG8_SB(0, 1), cB + hstepB, voffB); PG8_STAGE(PG8_SA(0, 0), cA, voffA); PG8_STAGE(PG8_SA(0, 1), cA + hstepA, voffA);
    if (wr == 1) PG8_BAR;
    PG8_WAIT_V(2); PG8_BAR;
    PG8_STAGE(PG8_SB(1, 0), cB + kstep, voffB); PG8_STAGE(PG8_SA(1, 0), cA + kstep, voffA); PG8_STAGE(PG8_SB(1, 1), cB + hstepB + kstep, voffB);
    PG8_WAIT_V(6); PG8_BAR;
    for (;;) {
        const bool has_next = S.next(ui + 1, nxt);
        const char* nA = has_next ? (const char*)g.A + (size_t)nxt.pm * tstepA : cA; const char* nB = has_next ? (const char*)g.Bt + (size_t)nxt.pn * tstepB : cB;
        for (int t = 0; t < nt; t += 2) {
            const bool last = (t == nt - 2);
            const char* a1 = cA + (size_t)(t + 1) * kstep;
            const char* a2 = last ? nA : cA + (size_t)(t + 2) * kstep; const char* b2 = last ? nB : cB + (size_t)(t + 2) * kstep;
            const char* a3 = a2 + kstep; const char* b3 = b2 + kstep;
            if (last && has_next) S.a_ready(nxt);
            PG8_LDB(B0, 0, 0); PG8_LDB(B1, 0, 1); PG8_SCHED; PG8_LDA(At, 0, 0); PG8_STAGE(PG8_SA(1, 1), a1 + hstepA, voffA);
            PG8_WAIT_V(8); PG8_WAIT_L(0); PG8_BAR; PG8_MMA(0, 0, At, B0); PG8_MMA(0, 1, At, B1); PG8_BAR; PG8_SCHED;
            PG8_LDA(At, 0, 1); PG8_STAGE(PG8_SB(0, 0), b2, voffB); PG8_STAGE(PG8_SB(0, 1), b2 + hstepB, voffB); PG8_STAGE(PG8_SA(0, 0), a2, voffA);
            PG8_WAIT_V(8); PG8_WAIT_L(0); PG8_BAR; PG8_MMA(1, 0, At, B0); PG8_MMA(1, 1, At, B1); PG8_BAR; PG8_SCHED;
            PG8_LDB(B0, 1, 0); PG8_LDB(B1, 1, 1); PG8_SCHED; PG8_LDA(At, 1, 0); PG8_STAGE(PG8_SA(0, 1), a2 + hstepA, voffA);
            PG8_WAIT_V(8); PG8_WAIT_L(0); PG8_BAR; PG8_MMA(0, 0, At, B0); PG8_MMA(0, 1, At, B1); PG8_BAR; PG8_SCHED;
            PG8_LDA(At, 1, 1); PG8_STAGE(PG8_SB(1, 0), b3, voffB); PG8_STAGE(PG8_SB(1, 1), b3 + hstepB, voffB); PG8_STAGE(PG8_SA(1, 0), a3, voffA);
            PG8_WAIT_V(8); PG8_WAIT_L(0); PG8_BAR; PG8_MMA(1, 0, At, B0); PG8_MMA(1, 1, At, B1); PG8_BAR; PG8_SCHED;
        }
        if constexpr (ALIGN_EPI) { if (wr == 0) PG8_BAR; }
        E(acc, cur, wr, wc, fr, fq); S.done(cur);
        if (!has_next) break;
#pragma unroll
        for (int a = 0; a < 2; ++a)
#pragma unroll
            for (int b = 0; b < 2; ++b)
#pragma unroll
                for (int m = 0; m < 4; ++m)
#pragma unroll
                    for (int n = 0; n < 2; ++n) acc[a][b][m][n] = (f32x4){0.f, 0.f, 0.f, 0.f};
        cur = nxt; cA = nA; cB = nB; ++ui;
        if constexpr (ALIGN_EPI) { if (wr == 1) PG8_BAR; }
    }
    PG8_WAIT_V(0);
    if constexpr (!ALIGN_EPI) { if (wr == 0) PG8_BAR; }
    PG8_BAR;
#undef PG8_SA
#undef PG8_SB
#undef PG8_STAGE
#undef PG8_LDA
#undef PG8_LDB
#undef PG8_MMA
#undef PG8_WAIT_V
#undef PG8_WAIT_L
#undef PG8_BAR
#undef PG8_SCHED
}
}

struct Params { const float* in[36]; float* out; unsigned char* ws; int only; int pad; };
struct Ctx { LAS unsigned char* lds; unsigned char* ws; int tid, lane, wave, bid, G, gw, ngw, zo; };

template <class Epi> __device__ __forceinline__ void run_gemm(const Ctx& c, const bf16_t* A, int lda, const bf16_t* Bt, int N, int K, const Epi& E) {
    pg8::Gemm g{A, Bt, M_, N, K, lda}; pg8::StaticOrder S; S.init(M_, N, c.G, c.bid);
    pg8::gemm_phase<Epi, pg8::StaticOrder>(c.lds, c.tid, g, S, E);
}

__device__ __forceinline__ void tr_item(const float* src, int ld, int kv, int nv, const float* ks, bf16_t* dst, int ldd, LAS float* scr, int lane) {
    const int n = lane & 31;
    if (kv >= 64 && nv >= 32 && !ks) {
        float tmp[32]; const float* sp = src + (size_t)(lane >> 5) * ld + n;
#pragma unroll
        for (int i = 0; i < 32; ++i) tmp[i] = sp[(size_t)(2 * i) * ld];
#pragma unroll
        for (int i = 0; i < 32; ++i) scr[(2 * i + (lane >> 5)) * 33 + n] = tmp[i];
    } else {
#pragma unroll 4
        for (int i = 0; i < 32; ++i) { const int kk = 2 * i + (lane >> 5); float v = 0.f; if (kk < kv && n < nv) { v = src[(size_t)kk * ld + n]; if (ks) v *= ks[kk]; } scr[kk * 33 + n] = v; }
    }
    LDS_WAIT(); asm volatile("" ::: "memory");
    const int c = lane & 7;
#pragma unroll
    for (int j = 0; j < 4; ++j) { const int nn = (lane >> 3) + 8 * j; const LAS float* s = scr + (8 * c) * 33 + nn;
        u32x4 o; o.x = pk2(s[0 * 33], s[1 * 33]); o.y = pk2(s[2 * 33], s[3 * 33]); o.z = pk2(s[4 * 33], s[5 * 33]); o.w = pk2(s[6 * 33], s[7 * 33]);
        *(u32x4*)(dst + (size_t)nn * ldd + 8 * c) = o; }
    LDS_WAIT(); asm volatile("" ::: "memory");
}
__device__ __forceinline__ void tr_job(const Ctx& c, const float* src, int ld, int K, int N, const float* ks, bf16_t* dst, int ldd, int Kpad, int Npad) {
    LAS float* scr = (LAS float*)(c.lds + c.wave * 8448);
    const int nnb = Npad / 32, items = (Kpad / 64) * nnb;
    for (int it = c.gw; it < items; it += c.ngw) { const int kb = it / nnb, nb = it % nnb, k0 = 64 * kb, n0 = 32 * nb;
        tr_item(src + (size_t)k0 * ld + n0, ld, K - k0, N - n0, ks ? ks + k0 : nullptr, dst + (size_t)n0 * ldd + k0, ldd, scr, c.lane); }
}
__device__ __forceinline__ void convert_common(const Ctx& c, const Params& p, int L, const float* wout_src) {
    bf16_t* WB = (bf16_t*)(c.ws + WS_WB);
    LAS float* scr = (LAS float*)(c.lds + c.wave * 8448);
    { const float* src = p.in[c.zo + 4] + (size_t)L * D_ * 2 * DFF; bf16_t* dst = (bf16_t*)((unsigned char*)WB + WB_GU);
      const int nnb = 2 * DFF / 32, items = (D_ / 64) * nnb;
      for (int it = c.gw; it < items; it += c.ngw) { const int kb = it / nnb, nb = it % nnb, k0 = 64 * kb, n0 = 32 * nb; const int t = n0 >> 8, w = n0 & 255;
          const int sc = (w < 128) ? 128 * t + w : DFF + 128 * t + (w - 128);
          tr_item(src + (size_t)k0 * (2 * DFF) + sc, 2 * DFF, 64, 32, nullptr, dst + (size_t)n0 * D_ + k0, D_, scr, c.lane); } }
    tr_job(c, p.in[c.zo + 5] + (size_t)L * DFF * D_, D_, DFF, D_, nullptr, (bf16_t*)((unsigned char*)WB + WB_DN), DFF, DFF, D_);
    tr_job(c, wout_src, D_, D_, D_, nullptr, (bf16_t*)((unsigned char*)WB + WB_OUT), D_, D_, D_);
}
__device__ __forceinline__ void convert_even(const Ctx& c, const Params& p, int L) {
    const int e = L >> 1;
    convert_common(c, p, L, p.in[c.zo + 12] + (size_t)e * D_ * D_);
    tr_job(c, p.in[c.zo + 6] + (size_t)e * D_ * 3852, 3852, D_, 3852, nullptr, (bf16_t*)(c.ws + WS_WB + WB_IN), D_, D_, 4096);
}
__device__ __forceinline__ void convert_odd(const Ctx& c, const Params& p, int L) {
    const int o = L >> 1;
    convert_common(c, p, L, p.in[c.zo + 35] + (size_t)o * D_ * D_);
    bf16_t* win = (bf16_t*)(c.ws + WS_WB + WB_IN);
    tr_job(c, p.in[c.zo + 13] + (size_t)o * D_ * 2592, 2592, D_, 2592, nullptr, win, D_, D_, 2592);
    tr_job(c, o ? p.in[c.zo + 25] + (size_t)(o - 1) * D_ * 32 : p.in[c.zo + 25], 32, D_, o ? 32 : 0, nullptr, win + (size_t)2592 * D_, D_, D_, 32);
    tr_job(c, p.in[c.zo + 25], 32, D_, 0, nullptr, win + (size_t)2624 * D_, D_, D_, 192);
    bf16_t* wl = (bf16_t*)(c.ws + WS_WB + WB_LORA);
    { LAS float* scr = (LAS float*)(c.lds + c.wave * 8448);
      const int items = 6 * 64;
      for (int it = c.gw; it < items; it += c.ngw) { const int kb = it / 64, nb = it % 64, n0 = 32 * nb, R = n0 >> 9, nn0 = n0 & 511;
          const float* src = p.in[c.zo + 16]; int kv = 0, ld = 512;
          if (R == 0 && kb == 0) { src = p.in[c.zo + 16] + (size_t)o * 64 * 512 + nn0; kv = 64; }
          else if (R == 1 && kb == 1) { src = p.in[c.zo + 18] + (size_t)o * 64 * 512 + nn0; kv = 64; }
          else if (R == 2 && (kb == 2 || kb == 3)) { src = p.in[c.zo + 19] + (size_t)o * 128 * 512 + (size_t)(kb - 2) * 64 * 512 + nn0; kv = 64; }
          else if (R == 3 && kb == 4 && o > 0) { src = p.in[c.zo + 28] + (size_t)(o - 1) * 32 * 512 + nn0; kv = 32; }
          tr_item(src, ld, kv, kv ? 32 : 0, nullptr, wl + (size_t)n0 * 384 + 64 * kb, 384, scr, c.lane); } }
    tr_job(c, p.in[c.zo + 31] + (size_t)o * 512 * 768, 768, 512, 768, p.in[c.zo + 29] + (size_t)o * 512, (bf16_t*)(c.ws + WS_WB + WB_UQ), 512, 512, 768);
    tr_job(c, p.in[c.zo + 32] + (size_t)o * 256 * 1024, 1024, 256, 1024, p.in[c.zo + 30] + (size_t)o * 256, (bf16_t*)(c.ws + WS_WB + WB_UKV), 256, 256, 1024);
}

__device__ __forceinline__ void rms_rows(const Ctx& c, const float* x, const float* gain, bf16_t* out, float* xcopy) {
    f32x4 gv[4];
#pragma unroll
    for (int j = 0; j < 4; ++j) gv[j] = ((const f32x4*)gain)[c.lane + 64 * j];
    for (int m = c.gw; m < M_; m += c.ngw) {
        const f32x4* xr = (const f32x4*)(x + (size_t)m * D_) + c.lane;
        f32x4 v[4]; float s = 0.f;
#pragma unroll
        for (int j = 0; j < 4; ++j) { v[j] = xr[64 * j]; s += (v[j].x * v[j].x + v[j].y * v[j].y) + (v[j].z * v[j].z + v[j].w * v[j].w); }
        if (xcopy) { f32x4* xc = (f32x4*)(xcopy + (size_t)m * D_) + c.lane;
#pragma unroll
            for (int j = 0; j < 4; ++j) xc[64 * j] = v[j]; }
        const float r = rsqrtf(wave_sum_dpp(s) * (1.f / D_) + 1e-6f);
        u32x2* o8 = (u32x2*)(out + (size_t)m * D_) + c.lane;
#pragma unroll
        for (int j = 0; j < 4; ++j) { u32x2 w; w.x = pk2(v[j].x * r * gv[j].x, v[j].y * r * gv[j].y); w.y = pk2(v[j].z * r * gv[j].z, v[j].w * r * gv[j].w); o8[64 * j] = w; }
    }
}

__device__ __forceinline__ void conv4_silu8(const bf16_t* zp, int t, const float* cw, float* y) {
#pragma unroll
    for (int i = 0; i < 8; ++i) y[i] = 0.f;
#pragma unroll
    for (int j = 0; j < 4; ++j) { const int dt = j - 3;
        if (t + dt >= 0) { float xv[8]; unpack8(*(const u32x4*)(zp + (long)dt * ZLD_E), xv);
            const f32x4 w0 = *(const f32x4*)(cw + j * 2304), w1 = *(const f32x4*)(cw + j * 2304 + 4);
            y[0] += w0.x * xv[0]; y[1] += w0.y * xv[1]; y[2] += w0.z * xv[2]; y[3] += w0.w * xv[3];
            y[4] += w1.x * xv[4]; y[5] += w1.y * xv[5]; y[6] += w1.z * xv[6]; y[7] += w1.w * xv[7]; } }
#pragma unroll
    for (int i = 0; i < 8; ++i) y[i] = siluf_(y[i]);
}
__device__ __forceinline__ void conv4h(const bf16_t* zc, int row, const bf16_t* hp, bool has_prev, const float* cw, float* y) {
#pragma unroll
    for (int i = 0; i < 8; ++i) y[i] = 0.f;
#pragma unroll
    for (int j = 0; j < 4; ++j) { const int rr = row - 3 + j;
        if (rr >= 0 || has_prev) { const bf16_t* src = (rr >= 0) ? zc + (size_t)rr * ZLD_E : hp + (3 + rr) * 384; float xv[8]; unpack8(*(const u32x4*)src, xv);
            const f32x4 w0 = *(const f32x4*)(cw + j * 2304), w1 = *(const f32x4*)(cw + j * 2304 + 4);
            y[0] += w0.x * xv[0]; y[1] += w0.y * xv[1]; y[2] += w0.z * xv[2]; y[3] += w0.w * xv[3];
            y[4] += w1.x * xv[4]; y[5] += w1.y * xv[5]; y[6] += w1.z * xv[6]; y[7] += w1.w * xv[7]; } }
#pragma unroll
    for (int i = 0; i < 8; ++i) y[i] = siluf_(y[i]);
}
__device__ __forceinline__ float sum16(float v) { v += __shfl_xor(v, 1); v += __shfl_xor(v, 2); v += __shfl_xor(v, 4); v += __shfl_xor(v, 8); return v; }

__device__ __forceinline__ void even_prep(const Ctx& c, const Params& p, int e) {
    const bf16_t* Z = (const bf16_t*)(c.ws + WS_Z); bf16_t* Y = (bf16_t*)(c.ws + WS_AB);
    bf16_t* U = (bf16_t*)(c.ws + WS_U); bf16_t* WN = (bf16_t*)(c.ws + WS_WN); float* GC = (float*)(c.ws + WS_GC);
    const float* conv_a = p.in[c.zo + 7] + (size_t)e * 3 * 256; const float* conv_qkv = p.in[c.zo + 8] + (size_t)e * 4 * 2304;
    { const long NT = (long)c.G * 512;
      for (long it = (long)c.bid * 512 + c.tid; it < (long)M_ * 32; it += NT) { const int m = (int)(it >> 5), c8 = (int)(it & 31) * 8, t = m & (T_ - 1);
          const bf16_t* zr = Z + (size_t)m * ZLD_E; float ab[8], acc[8];
          unpack8(*(const u32x4*)(zr + c8), ab);
#pragma unroll
          for (int i = 0; i < 8; ++i) acc[i] = 0.f;
#pragma unroll
          for (int j = 0; j < 3; ++j) { const int dt = j - 2; if (t + dt >= 0) { const bf16_t* zc = zr + (long)dt * ZLD_E; float ac[8], ah[8];
              unpack8(*(const u32x4*)(zc + 256 + c8), ac); unpack8(*(const u32x4*)(zc + 512 + c8), ah);
#pragma unroll
              for (int i = 0; i < 8; ++i) acc[i] += conv_a[j * 256 + c8 + i] * (ac[i] * ah[i]); } }
#pragma unroll
          for (int i = 0; i < 8; ++i) acc[i] *= ab[i];
          *(u32x4*)(Y + (size_t)m * D_ + c8) = pack8(acc); } }
    const bf16_t* HALO = (const bf16_t*)(c.ws + WS_HALO); const float* GCB = (const float*)(c.ws + WS_GCB);
    bf16_t* Zw = (bf16_t*)(c.ws + WS_Z);
    LAS bf16_t* KN = (LAS bf16_t*)(c.lds);
    LAS float* VB = (LAS float*)(c.lds + 17408);
    LAS float* KBG = (LAS float*)(c.lds + 17408 + 32768);
    LAS float* Lm = (LAS float*)(c.lds + 17408 + 65536);
    LAS float* sgc = (LAS float*)(c.lds + 17408 + 65536 + 16384);
    LAS float* sbeta = sgc + 64;
    LAS bf16_t* QS = (LAS bf16_t*)(c.lds + 17408 + 65536 + 16384 + 512);
    for (int item = c.bid; item < 3072; item += c.G) {
        int tid_i = c.tid; asm volatile("" : "+v"(tid_i)); const int lane_i = tid_i & 63;
        const int n = item & 127, bh = item >> 7, h = bh % 6, b = bh / 6; const int m0 = b * T_ + 64 * n;
        if (tid_i < 128) sgc[tid_i] = GCB[(size_t)item * 128 + tid_i];
        __syncthreads();
        const float glast = sgc[63];
        u32x4 qdp0 = {}, qdp1 = {}, kdp0 = {}, kdp1 = {};
#pragma unroll 1
        for (int rep = 0; rep < 2; ++rep) { const int vi = tid_i + 512 * rep, row = vi >> 4, c8 = (vi & 15) * 8;
            const bf16_t* zc = Z + (size_t)m0 * ZLD_E + 768 + h * 128 + c8; const bf16_t* hp = HALO + (size_t)(bh * 128 + n) * 1152 + c8; float y[8], yd[8];
            conv4h(zc, row, hp, n > 0, conv_qkv + h * 128 + c8, y);
            float ss = 0.f;
#pragma unroll
            for (int i = 0; i < 8; ++i) ss += y[i] * y[i];
            ss = sum16_dpp(ss); float rn = rsqrtf(ss + 1e-6f) * 0.08838834764831845f;
            const float eg = __expf(sgc[row]);
#pragma unroll
            for (int i = 0; i < 8; ++i) { y[i] *= rn; yd[i] = y[i] * eg; }
            *(LAS u32x4*)(QS + row * 136 + c8) = pack8(y); { const u32x4 t_ = pack8(yd); if (rep == 0) qdp0 = t_; else qdp1 = t_; }
            conv4h(zc + 768, row, hp + 128, n > 0, conv_qkv + 768 + h * 128 + c8, y);
            ss = 0.f;
#pragma unroll
            for (int i = 0; i < 8; ++i) ss += y[i] * y[i];
            ss = sum16_dpp(ss); rn = rsqrtf(ss + 1e-6f);
            const float bg = sbeta[row] * eg; const float ek = __expf(glast - sgc[row]);
#pragma unroll
            for (int i = 0; i < 8; ++i) { y[i] *= rn; KBG[row * 128 + c8 + i] = y[i] * bg; yd[i] = y[i] * ek; }
            *(LAS u32x4*)(KN + row * 136 + c8) = pack8(y); { const u32x4 t_ = pack8(yd); if (rep == 0) kdp0 = t_; else kdp1 = t_; }
            conv4h(zc + 1536, row, hp + 256, n > 0, conv_qkv + 1536 + h * 128 + c8, y);
            const float be = sbeta[row];
#pragma unroll
            for (int i = 0; i < 8; ++i) VB[row * 128 + c8 + i] = y[i] * be; }
        __syncthreads();
#pragma unroll
        for (int rep = 0; rep < 2; ++rep) { const int vi = tid_i + 512 * rep, row = vi >> 4, c8 = (vi & 15) * 8;
            bf16_t* zc = Zw + (size_t)(m0 + row) * ZLD_E + 768 + h * 128 + c8; *(u32x4*)zc = rep ? qdp1 : qdp0;
            const u32x4 kd_ = rep ? kdp1 : kdp0; bf16_t* kt_ = Zw + (size_t)(m0 + (c8 >> 1)) * ZLD_E + 768 + 768 + h * 128 + row;
            kt_[0] = (bf16_t)(kd_.x & 0xffffu); kt_[64] = (bf16_t)(kd_.x >> 16); kt_[ZLD_E] = (bf16_t)(kd_.y & 0xffffu); kt_[ZLD_E + 64] = (bf16_t)(kd_.y >> 16);
            kt_[2 * ZLD_E] = (bf16_t)(kd_.z & 0xffffu); kt_[2 * ZLD_E + 64] = (bf16_t)(kd_.z >> 16); kt_[3 * ZLD_E] = (bf16_t)(kd_.w & 0xffffu); kt_[3 * ZLD_E + 64] = (bf16_t)(kd_.w >> 16); }
        { const int l31 = lane_i & 31, hh = lane_i >> 5; const int w = c.wave & 3; const int ti = (w == 0 || w == 3) ? 0 : 1, tj = (w >= 2) ? 1 : 0; const bool isq = c.wave >= 4;
            bf16_t* qko = Zw + (size_t)m0 * ZLD_E + 768 + 1536 + h * 128;
            if (w == 3) {
#pragma unroll
                for (int r = 0; r < 16; ++r) { const int i = 32 * ti + crow(r, hh), j = 32 * tj + l31; if (isq) qko[(size_t)i * ZLD_E + j] = 0; else Lm[i * 64 + j] = 0.f; }
            } else { f32x16 acc = {}; const LAS bf16_t* Am = isq ? QS : KN;
#pragma unroll
                for (int ks = 0; ks < 8; ++ks) { const bf16x8 a = *(const LAS bf16x8*)(Am + (32 * ti + l31) * 136 + 16 * ks + 8 * hh); const bf16x8 bb = *(const LAS bf16x8*)(KN + (32 * tj + l31) * 136 + 16 * ks + 8 * hh);
                    acc = __builtin_amdgcn_mfma_f32_32x32x16_bf16(a, bb, acc, 0, 0, 0); }
                const int j = 32 * tj + l31; const float gj = sgc[j];
#pragma unroll
                for (int r = 0; r < 16; ++r) { const int i = 32 * ti + crow(r, hh); const float dec = __expf(fminf(sgc[i] - gj, 0.f));
                    if (isq) qko[(size_t)i * ZLD_E + j] = (i >= j) ? f2bf(acc[r] * dec) : (bf16_t)0;
                    else Lm[i * 64 + j] = (i > j) ? sbeta[i] * acc[r] * dec : 0.f; } } }
        __syncthreads();
        if (tid_i < 256) { const int cc = tid_i & 127; const LAS float* src = (tid_i < 128) ? VB : KBG; float x[64];
            int vz = 0; asm volatile("" : "+v"(vz)); const LAS float* Lv = Lm + vz;
#pragma unroll
            for (int i = 0; i < 64; ++i) x[i] = src[i * 128 + cc];
#pragma unroll
            for (int i = 1; i < 64; ++i) { const LAS f32x4* Lr = (const LAS f32x4*)(Lv + i * 64); float a0 = x[i], a1 = 0.f, a2 = 0.f, a3 = 0.f;
#pragma unroll
                for (int j4 = 0; j4 < (i + 3) / 4; ++j4) { const f32x4 l = Lr[j4];
                    if (4 * j4 + 0 < i) a0 -= l[0] * x[4 * j4 + 0];
                    if (4 * j4 + 1 < i) a1 -= l[1] * x[4 * j4 + 1];
                    if (4 * j4 + 2 < i) a2 -= l[2] * x[4 * j4 + 2];
                    if (4 * j4 + 3 < i) a3 -= l[3] * x[4 * j4 + 3]; }
                x[i] = (a0 + a1) + (a2 + a3); }
            LAS float* dstl = (tid_i < 128) ? VB : KBG; const float sg = (tid_i < 128) ? 1.f : -1.f;
#pragma unroll
            for (int i = 0; i < 64; ++i) dstl[i * 128 + cc] = x[i] * sg; }
        __syncthreads();
#pragma unroll 1
        for (int rep = 0; rep < 4; ++rep) { const int vi = tid_i + 512 * rep, row = vi >> 5, which = (vi >> 4) & 1, c8 = (vi & 15) * 8;
            const LAS float* sp = (which ? KBG : VB) + row * 128 + c8; float f[8];
#pragma unroll
            for (int i = 0; i < 8; ++i) f[i] = sp[i];
            bf16_t* dp = (which ? WN : U) + (size_t)(m0 + row) * 768 + h * 128 + c8;
            *(u32x4*)dp = pack8(f); }
        __syncthreads();
    }
}

__device__ __forceinline__ void halo_copy(const Ctx& c, const Params& p, int e) {
    const bf16_t* Z = (const bf16_t*)(c.ws + WS_Z); bf16_t* HALO = (bf16_t*)(c.ws + WS_HALO);
    const int NT = c.G * 512, total = 24 * 128 * 3 * 3 * 16;
    for (int it = c.bid * 512 + c.tid; it < total; it += NT) { const int c8 = (it & 15) * 8; int r_ = it >> 4; const int part = r_ % 3; r_ /= 3; const int r = r_ % 3; r_ /= 3; const int n = r_ & 127, bh = r_ >> 7;
        if (n == 0) continue; const int h = bh % 6, b = bh / 6;
        *(u32x4*)(HALO + ((size_t)(bh * 128 + n) * 3 + r) * 384 + part * 128 + c8) = *(const u32x4*)(Z + (size_t)(b * T_ + 64 * n - 3 + r) * ZLD_E + 768 + part * 768 + h * 128 + c8); }
    float* GCB = (float*)(c.ws + WS_GCB); float* GC = (float*)(c.ws + WS_GC);
    for (int item = c.gw; item < 3072; item += c.ngw) { const int n = item & 127, bh = item >> 7, h = bh % 6, b = bh / 6, t = c.lane;
        const bf16_t* zr = Z + (size_t)(b * T_ + 64 * n + t) * ZLD_E;
        const float braw = bf2f(zr[3840 + h]), araw = bf2f(zr[3846 + h]);
        const float beta = sigmoidf_(braw);
        float g = -__expf(p.in[c.zo + 9][e * 6 + h]) * softplusf_(araw + p.in[c.zo + 10][e * 6 + h]);
#pragma unroll
        for (int o = 1; o < 64; o <<= 1) { const float u = __shfl_up(g, o); if (t >= o) g += u; }
        GCB[(size_t)item * 128 + t] = g; GCB[(size_t)item * 128 + 64 + t] = beta; if (t == 63) GC[(size_t)bh * 128 + n] = __expf(g); }
}

__device__ __forceinline__ void gdn_scan(const Ctx& c, const Params& p, int e) {
    const bf16_t* Z = (const bf16_t*)(c.ws + WS_Z); bf16_t* Y = (bf16_t*)(c.ws + WS_AB);
    const bf16_t* U = (const bf16_t*)(c.ws + WS_U); const bf16_t* WNg = (const bf16_t*)(c.ws + WS_WN); const float* GC = (const float*)(c.ws + WS_GC);
    LAS bf16_t* QD = (LAS bf16_t*)(c.lds);
    LAS bf16_t* WNs = (LAS bf16_t*)(c.lds + 17408);
    LAS bf16_t* UT = (LAS bf16_t*)(c.lds + 34816);
    LAS bf16_t* KDT = (LAS bf16_t*)(c.lds + 52224);
    LAS bf16_t* QK = (LAS bf16_t*)(c.lds + 70656);
    LAS bf16_t* OTb = (LAS bf16_t*)(c.lds + 79872);
    const int l31 = c.lane & 31, hh = c.lane >> 5;
    const bool producer = c.wave >= 4; const int ptid = c.tid & 255;
    for (int item = c.bid; item < 48; item += c.G) {
        const int bh = item >> 1, dvh = item & 1, h = bh % 6, b = bh / 6;
        const int e0 = 64 * dvh + 32 * (c.wave & 1);
#define GDN_LOAD_TILES(nn) do { const size_t mb_ = (size_t)(b * T_ + 64 * (nn)); _Pragma("unroll") for (int k_ = 0; k_ < 4; ++k_) { const size_t rz_ = (mb_ + prow + 16 * k_) * ZLD_E + 768 + h * 128 + pc8; const size_t ru_ = (mb_ + prow + 16 * k_) * 768 + h * 128 + pc8; \
            tq[k_] = *(const u32x4*)(Z + rz_); { const int vi_ = pt_ + 256 * k_, d_ = vi_ >> 3; tk[k_] = *(const u32x4*)(Z + (mb_ + (d_ >> 1)) * ZLD_E + 768 + 768 + h * 128 + (d_ & 1) * 64 + (vi_ & 7) * 8); } tw[k_] = *(const u32x4*)(WNg + ru_); tu[k_] = *(const u32x4*)(U + ru_); } \
            _Pragma("unroll") for (int k_ = 0; k_ < 2; ++k_) tqk[k_] = *(const u32x4*)(Z + (mb_ + qrow + 32 * k_) * ZLD_E + 768 + 1536 + h * 128 + qc8); } while (0)
#define GDN_STORE_TILES() do { _Pragma("unroll") for (int k_ = 0; k_ < 4; ++k_) { const int row_ = prow + 16 * k_; *(LAS u32x4*)(QD + row_ * 136 + pc8) = tq[k_]; *(LAS u32x4*)(WNs + row_ * 136 + pc8) = tw[k_]; *(LAS u32x4*)(UT + row_ * 136 + pc8) = tu[k_]; \
            { const int vi_ = pt_ + 256 * k_; *(LAS u32x4*)(KDT + (vi_ >> 3) * 72 + (vi_ & 7) * 8) = tk[k_]; } } \
            _Pragma("unroll") for (int k_ = 0; k_ < 2; ++k_) *(LAS u32x4*)(QK + (qrow + 32 * k_) * 72 + qc8) = tqk[k_]; } while (0)
#define GDN_STORE_O(nn) do { const LAS bf16_t* ob_ = OTb + ((nn) & 1) * 4608; _Pragma("unroll") for (int k_ = 0; k_ < 2; ++k_) { const int vi_ = pt_ + 256 * k_, row_ = vi_ >> 3, c8_ = (vi_ & 7) * 8; \
            *(u32x4*)(Y + (size_t)(b * T_ + 64 * (nn) + row_) * D_ + 256 + h * 128 + 64 * dvh + c8_) = *(const LAS u32x4*)(ob_ + row_ * 72 + c8_); } } while (0)
        if (producer) {
            int pt_ = ptid; asm volatile("" : "+v"(pt_));
            u32x4 tq[4], tk[4], tw[4], tu[4], tqk[2];
            const int prow = pt_ >> 4, pc8 = (pt_ & 15) * 8;
            const int qrow = pt_ >> 3, qc8 = (pt_ & 7) * 8;
            GDN_LOAD_TILES(0); GDN_STORE_TILES();
            for (int n = 0; n < 128; ++n) {
                LDS_BARRIER();
                if (n + 1 < 128) GDN_LOAD_TILES(n + 1);
                if (n >= 1) GDN_STORE_O(n - 1);
                LDS_BARRIER();
                if (n + 1 < 128) GDN_STORE_TILES();
            }
            LDS_BARRIER();
            GDN_STORE_O(127);
        } else {
            f32x16 S[4];
#pragma unroll
            for (int i = 0; i < 4; ++i) S[i] = (f32x16){};
            float gtn = GC[(size_t)bh * 128];
            for (int n = 0; n < 128; ++n) {
                LDS_BARRIER();
                if (c.wave < 2) {
                const float gt = gtn; if (n + 1 < 128) gtn = GC[(size_t)bh * 128 + n + 1];
                f32x16 av[2];
#pragma unroll
                for (int tc = 0; tc < 2; ++tc)
#pragma unroll
                    for (int r = 0; r < 16; ++r) av[tc][r] = bf2f(UT[(32 * tc + crow(r, hh)) * 136 + e0 + l31]);
                f32x16 ao[2] = {(f32x16){}, (f32x16){}};
                bf16x8 fa[8], fb[8];
#define GDN_LDF_WQ(F, td_) do { _Pragma("unroll") for (int tc = 0; tc < 2; ++tc) _Pragma("unroll") for (int s_ = 0; s_ < 2; ++s_) { const int ko_ = 32 * (td_) + 16 * s_ + 4 * hh; \
                    F[tc * 2 + s_] = ldA_perm(WNs + (32 * tc + l31) * 136 + ko_); F[4 + tc * 2 + s_] = ldA_perm(QD + (32 * tc + l31) * 136 + ko_); } } while (0)
#define GDN_MMA_WQ(F, td_) do { const bf16x8 sb0_ = pkfrag(S[td_], 0), sb1_ = pkfrag(S[td_], 1); \
                    av[0] = __builtin_amdgcn_mfma_f32_32x32x16_bf16(F[0], sb0_, av[0], 0, 0, 0); ao[0] = __builtin_amdgcn_mfma_f32_32x32x16_bf16(F[4], sb0_, ao[0], 0, 0, 0); \
                    av[1] = __builtin_amdgcn_mfma_f32_32x32x16_bf16(F[2], sb0_, av[1], 0, 0, 0); ao[1] = __builtin_amdgcn_mfma_f32_32x32x16_bf16(F[6], sb0_, ao[1], 0, 0, 0); \
                    av[0] = __builtin_amdgcn_mfma_f32_32x32x16_bf16(F[1], sb1_, av[0], 0, 0, 0); ao[0] = __builtin_amdgcn_mfma_f32_32x32x16_bf16(F[5], sb1_, ao[0], 0, 0, 0); \
                    av[1] = __builtin_amdgcn_mfma_f32_32x32x16_bf16(F[3], sb1_, av[1], 0, 0, 0); ao[1] = __builtin_amdgcn_mfma_f32_32x32x16_bf16(F[7], sb1_, ao[1], 0, 0, 0); } while (0)
                GDN_LDF_WQ(fa, 0);
                GDN_LDF_WQ(fb, 1); GDN_MMA_WQ(fa, 0);
                GDN_LDF_WQ(fa, 2); GDN_MMA_WQ(fb, 1);
                GDN_LDF_WQ(fb, 3); GDN_MMA_WQ(fa, 2);
#pragma unroll
                for (int tc = 0; tc < 2; ++tc)
#pragma unroll
                    for (int ts = 0; ts < 2; ++ts)
#pragma unroll
                        for (int s_ = 0; s_ < 2; ++s_) fa[tc * 4 + ts * 2 + s_] = ldA_perm(QK + (32 * tc + l31) * 72 + 32 * ts + 16 * s_ + 4 * hh);
                GDN_MMA_WQ(fb, 3);
#undef GDN_LDF_WQ
#undef GDN_MMA_WQ
                bf16x8 Vb[2][2];
#pragma unroll
                for (int tc = 0; tc < 2; ++tc) { Vb[tc][0] = pkfrag(av[tc], 0); Vb[tc][1] = pkfrag(av[tc], 1); }
#define GDN_LDF_K(F, tdp_) do { _Pragma("unroll") for (int t2_ = 0; t2_ < 2; ++t2_) _Pragma("unroll") for (int tc = 0; tc < 2; ++tc) _Pragma("unroll") for (int s_ = 0; s_ < 2; ++s_) \
                    F[t2_ * 4 + tc * 2 + s_] = ldA_perm(KDT + (32 * (2 * (tdp_) + t2_) + l31) * 72 + 32 * tc + 16 * s_ + 4 * hh); } while (0)
#define GDN_MMA_K(F, tdp_) do { S[2 * (tdp_)] = S[2 * (tdp_)] * gt; S[2 * (tdp_) + 1] = S[2 * (tdp_) + 1] * gt; \
                    _Pragma("unroll") for (int tc = 0; tc < 2; ++tc) _Pragma("unroll") for (int s_ = 0; s_ < 2; ++s_) _Pragma("unroll") for (int t2_ = 0; t2_ < 2; ++t2_) \
                        S[2 * (tdp_) + t2_] = __builtin_amdgcn_mfma_f32_32x32x16_bf16(F[t2_ * 4 + tc * 2 + s_], Vb[tc][s_], S[2 * (tdp_) + t2_], 0, 0, 0); } while (0)
                GDN_LDF_K(fb, 0);
#pragma unroll
                for (int ts = 0; ts < 2; ++ts)
#pragma unroll
                    for (int s_ = 0; s_ < 2; ++s_)
#pragma unroll
                        for (int tc = 0; tc < 2; ++tc) ao[tc] = __builtin_amdgcn_mfma_f32_32x32x16_bf16(fa[tc * 4 + ts * 2 + s_], Vb[ts][s_], ao[tc], 0, 0, 0);
                GDN_LDF_K(fa, 1); GDN_MMA_K(fb, 0);
                GDN_MMA_K(fa, 1);
#undef GDN_LDF_K
#undef GDN_MMA_K
                LAS bf16_t* ob = OTb + (n & 1) * 4608;
#pragma unroll
                for (int tc = 0; tc < 2; ++tc)
#pragma unroll
                    for (int r = 0; r < 16; ++r) ob[(32 * tc + crow(r, hh)) * 72 + 32 * (c.wave & 1) + l31] = f2bf(ao[tc][r]);
                }
                LDS_BARRIER();
            }
            LDS_BARRIER();
        }
        __syncthreads();
#undef GDN_LOAD_TILES
#undef GDN_STORE_TILES
#undef GDN_STORE_O
    }
}
__device__ __forceinline__ void gdn_post(const Ctx& c, const Params& p, int e) {
    const bf16_t* Z = (const bf16_t*)(c.ws + WS_Z); bf16_t* Y = (bf16_t*)(c.ws + WS_AB); const float* onorm = p.in[c.zo + 11] + (size_t)e * 128;
    const int NT = c.G * 512, total = M_ * 24;
    for (int it = c.bid * 512 + c.tid; it < total; it += NT) { const int part = it & 3, h = (it >> 2) % 6, m = (it >> 2) / 6;
        bf16_t* yo = Y + (size_t)m * D_ + 256 + h * 128 + 32 * part; const bf16_t* zg = Z + (size_t)m * ZLD_E + 3072 + h * 128 + 32 * part; const float* on = onorm + 32 * part;
        float ov[32]; float ss = 0.f;
#pragma unroll
        for (int k = 0; k < 4; ++k) unpack8(*(const u32x4*)(yo + 8 * k), ov + 8 * k);
#pragma unroll
        for (int k = 0; k < 32; ++k) ss += ov[k] * ov[k];
        ss += __shfl_xor(ss, 1); ss += __shfl_xor(ss, 2);
        const float rn = rsqrtf(ss * (1.f / 128.f) + 1e-6f);
#pragma unroll
        for (int k = 0; k < 4; ++k) { float gz[8], out[8]; unpack8(*(const u32x4*)(zg + 8 * k), gz);
#pragma unroll
            for (int i = 0; i < 8; ++i) out[i] = ov[8 * k + i] * rn * on[8 * k + i] * siluf_(gz[i]);
            *(u32x4*)(yo + 8 * k) = pack8(out); } }
}

__device__ __forceinline__ float lerp_prev(const bf16_t* zp, int ld, int t, float mu) { const float z = bf2f(zp[0]); const float zq = (t > 0) ? bf2f(*(zp - ld)) : 0.f; return z + mu * (zq - z); }

__device__ __forceinline__ void odd_prep_a(const Ctx& c, const Params& p, int o) {
    const bf16_t* Z2 = (const bf16_t*)(c.ws + WS_Z2); bf16_t* LA = (bf16_t*)(c.ws + WS_LA); bf16_t* KR = (bf16_t*)(c.ws + WS_KR); float* RS = (float*)(c.ws + WS_RS);
    const float* mu = p.in[c.zo + 14] + (size_t)o * 1792; const float* vmu = o ? p.in[c.zo + 26] + (size_t)(o - 1) * 32 : p.in[c.zo + 26];
    if (c.bid == 0 && c.tid == 0) { unsigned* ctl = (unsigned*)(c.ws + WS_CTL); ctl[64 * o] = 0u; ctl[64 * o + 16] = 0u; }
    const int grp = c.lane; const int kind = grp < 8 ? 0 : grp < 16 ? 1 : grp < 32 ? 2 : grp < 36 ? 3 : 4;
    const int zc = (kind < 3) ? 8 * grp : 1056 + 8 * (grp - 32);
    float mv[8];
#pragma unroll
    for (int i = 0; i < 8; ++i) mv[i] = (kind < 3) ? mu[1536 + 8 * grp + i] : (kind == 3 ? vmu[8 * (grp - 32) + i] : 0.f);
    for (int m = c.gw; m < M_; m += c.ngw) { const int t = m & (T_ - 1); const bf16_t* zr = Z2 + (size_t)m * Z2_LD;
        if (grp < 48) { float out[8];
#pragma unroll
            for (int i = 0; i < 8; ++i) out[i] = 0.f;
            if (kind < 3 || (kind == 3 && o > 0)) { float cu[8], pv[8]; unpack8(*(const u32x4*)(zr + zc), cu);
                if (t > 0) unpack8(*(const u32x4*)(zr + zc - Z2_LD), pv); else {
#pragma unroll
                    for (int i = 0; i < 8; ++i) pv[i] = 0.f; }
#pragma unroll
                for (int i = 0; i < 8; ++i) { const float x = cu[i] + mv[i] * (pv[i] - cu[i]); out[i] = (kind == 0) ? tanhf(x) : (kind == 2 ? sigmoidf_(x) : x); } }
            *(u32x4*)(LA + (size_t)m * 384 + 8 * grp) = pack8(out); }
        if (c.lane < 32) KR[(size_t)m * 32 + c.lane] = zr[1024 + c.lane];
        float f[8]; unpack8(*(const u32x4*)(zr + 256 + 8 * c.lane), f); float s1 = 0.f;
#pragma unroll
        for (int i = 0; i < 8; ++i) s1 += f[i] * f[i];
        const u32x2 kvv = *(const u32x2*)(zr + 768 + 4 * c.lane);
        const float k0 = asf(kvv.x << 16), k1 = asf(kvv.x & 0xffff0000u), k2 = asf(kvv.y << 16), k3 = asf(kvv.y & 0xffff0000u);
        float s2 = (k0 * k0 + k1 * k1) + (k2 * k2 + k3 * k3);
        s1 = wave_sum_dpp(s1); s2 = wave_sum_dpp(s2);
        if (c.lane == 0) { RS[2 * m] = rsqrtf(s1 * (1.f / 512.f) + 1e-6f); RS[2 * m + 1] = rsqrtf(s2 * (1.f / 256.f) + 1e-6f); } }
}

__device__ __forceinline__ void rwkv_bnd_copy(const Ctx& c, const Params& p) {
    const bf16_t* RKV = (const bf16_t*)(c.ws + WS_RKV); bf16_t* BND = (bf16_t*)(c.ws + WS_BND);
    const int NT = c.G * 512, total = 1024 * 192;
    for (int it = c.bid * 512 + c.tid; it < total; it += NT) { const int rg = it / 192, c8 = (it % 192) * 8;
        if ((rg & 255) == 0) continue;
        *(u32x4*)(BND + (size_t)rg * 1536 + c8) = *(const u32x4*)(RKV + (size_t)(32 * rg - 1) * RKV_LD + c8); }
}
__device__ __forceinline__ void unpack4(u32x2 v, float* f) { f[0] = asf(v.x << 16); f[1] = asf(v.x & 0xffff0000u); f[2] = asf(v.y << 16); f[3] = asf(v.y & 0xffff0000u); }
__device__ __forceinline__ u32x2 pack4(const float* f) { u32x2 o; o.x = pk2(f[0], f[1]); o.y = pk2(f[2], f[3]); return o; }
__device__ __forceinline__ void rwkv_prep(const Ctx& c, const Params& p, int o) {
    bf16_t* RKV = (bf16_t*)(c.ws + WS_RKV); bf16_t* LO = (bf16_t*)(c.ws + WS_LO); bf16_t* VF = (bf16_t*)(c.ws + WS_VF); bf16_t* Y = (bf16_t*)(c.ws + WS_AB);
    const bf16_t* BND = (const bf16_t*)(c.ws + WS_BND); float* BON = (float*)(c.ws + WS_LA);
    const float* mu = p.in[c.zo + 14] + (size_t)o * 1792; const float* w0 = p.in[c.zo + 15] + (size_t)o * 512; const float* a0 = p.in[c.zo + 17] + (size_t)o * 512;
    const float* k_k = p.in[c.zo + 20] + (size_t)o * 512; const float* k_a = p.in[c.zo + 21] + (size_t)o * 512; const float* r_k = p.in[c.zo + 22] + (size_t)o * 512;
    const float* v0p = o ? p.in[c.zo + 27] + (size_t)(o - 1) * 512 : p.in[c.zo + 27];
    for (int item = c.gw; item < 2048; item += c.ngw) { const int rg = item >> 1, hf = item & 1, m0 = 32 * rg; const bool seq0 = (rg & 255) == 0;
        int ln_ = c.lane; asm volatile("" : "+v"(ln_));
        const int h = 4 * hf + (ln_ >> 4), c4 = h * 64 + 4 * (ln_ & 15);
        const f32x4 mur = *(const f32x4*)(mu + c4), muk = *(const f32x4*)(mu + 512 + c4), muv = *(const f32x4*)(mu + 1024 + c4), w0c = *(const f32x4*)(w0 + c4), a0c = *(const f32x4*)(a0 + c4);
        const f32x4 kkc = *(const f32x4*)(k_k + c4), kac = *(const f32x4*)(k_a + c4), v0c = *(const f32x4*)(v0p + c4), rkc = *(const f32x4*)(r_k + c4);
        u32x2 cr, ck, cv, pr, pk, pv, wl, al, vl = {}, vf = {};
        { const bf16_t* zr = RKV + (size_t)(m0 + 31) * RKV_LD + c4; cr = *(const u32x2*)zr; ck = *(const u32x2*)(zr + 512); cv = *(const u32x2*)(zr + 1024);
          const bf16_t* zq = zr - RKV_LD; pr = *(const u32x2*)zq; pk = *(const u32x2*)(zq + 512); pv = *(const u32x2*)(zq + 1024);
          const bf16_t* lo = LO + (size_t)(m0 + 31) * 2048 + c4; wl = *(const u32x2*)lo; al = *(const u32x2*)(lo + 512); if (o) { vl = *(const u32x2*)(lo + 1536); vf = *(const u32x2*)(VF + (size_t)(m0 + 31) * 512 + c4); } }
#pragma unroll 2
        for (int tt = 31; tt >= 0; --tt) { const int m = m0 + tt;
            u32x2 qr = {}, qk = {}, qv = {}, nwl = {}, nal = {}, nvl = {}, nvf = {};
            if (tt >= 2) { const bf16_t* zq = RKV + (size_t)(m - 2) * RKV_LD + c4; qr = *(const u32x2*)zq; qk = *(const u32x2*)(zq + 512); qv = *(const u32x2*)(zq + 1024); }
            else if (tt == 1 && !seq0) { const bf16_t* zq = BND + (size_t)rg * 1536 + c4; qr = *(const u32x2*)zq; qk = *(const u32x2*)(zq + 512); qv = *(const u32x2*)(zq + 1024); }
            if (tt >= 1) { const bf16_t* ln = LO + (size_t)(m - 1) * 2048 + c4; nwl = *(const u32x2*)ln; nal = *(const u32x2*)(ln + 512); if (o) { nvl = *(const u32x2*)(ln + 1536); nvf = *(const u32x2*)(VF + (size_t)(m - 1) * 512 + c4); } }
            const bool has_prev = (tt > 0) || !seq0;
            float fcr[4], fck[4], fcv[4], fpr[4], fpk[4], fpv[4], fwl[4], fal[4], fvl[4], fvf[4];
            unpack4(cr, fcr); unpack4(ck, fck); unpack4(cv, fcv); unpack4(pr, fpr); unpack4(pk, fpk); unpack4(pv, fpv); unpack4(wl, fwl); unpack4(al, fal); unpack4(vl, fvl); unpack4(vf, fvf);
            float r_[4], kx_[4], v_[4], ew_[4], ka_[4], kq_[4], a_[4]; float ss = 0.f, bs = 0.f;
#pragma unroll
            for (int j = 0; j < 4; ++j) { const float xr = has_prev ? fpr[j] : 0.f, xk = has_prev ? fpk[j] : 0.f, xv = has_prev ? fpv[j] : 0.f;
                r_[j] = fcr[j] + mur[j] * (xr - fcr[j]); const float kr = fck[j] + muk[j] * (xk - fck[j]); float v = fcv[j] + muv[j] * (xv - fcv[j]);
                const float wlog = -softplusf_(-(w0c[j] + fwl[j])) - 0.5f; ew_[j] = __expf(wlog);
                a_[j] = sigmoidf_(a0c[j] + fal[j]);
                kq_[j] = kr * kkc[j]; ss += kq_[j] * kq_[j];
                kx_[j] = kr * (1.f + (a_[j] - 1.f) * kac[j]);
                if (o) v = v + (fvf[j] - v) * sigmoidf_(v0c[j] + fvl[j]);
                v_[j] = v; bs += r_[j] * kx_[j] * rkc[j]; }
            ss = sum16_dpp(ss); bs = sum16_dpp(bs);
            const float rn = rsqrtf(ss + 1e-6f); float kk_[4];
#pragma unroll
            for (int j = 0; j < 4; ++j) { kk_[j] = kq_[j] * rn; ka_[j] = kk_[j] * a_[j]; }
            if (o == 0) *(u32x2*)(VF + (size_t)m * 512 + c4) = pack4(v_);
            bf16_t* zr = RKV + (size_t)m * RKV_LD + c4; *(u32x2*)zr = pack4(r_); *(u32x2*)(zr + 512) = pack4(kx_); *(u32x2*)(zr + 1024) = pack4(v_);
            bf16_t* lo = LO + (size_t)m * 2048 + c4; *(u32x2*)lo = pack4(ew_); *(u32x2*)(lo + 512) = pack4(ka_); *(u32x2*)(Y + (size_t)m * D_ + c4) = pack4(kk_);
            if ((ln_ & 15) == 0) BON[(size_t)m * 8 + h] = bs;
            cr = pr; ck = pk; cv = pv; pr = qr; pk = qk; pv = qv; wl = nwl; al = nal; vl = nvl; vf = nvf; } }
}
struct RwkvRegs { unsigned short vr[8], vx[8], vv[8], ve[8], va[8], vk[8]; };
__device__ __forceinline__ void rwkv_load_chunk(RwkvRegs& R, int n, int pw, int b, int col, const bf16_t* RKV, const bf16_t* LO, const bf16_t* Y) {
#pragma unroll
    for (int i = 0; i < 8; ++i) { const int tt = pw + 4 * i, m = b * T_ + 32 * n + tt; const bf16_t* zr = RKV + (size_t)m * RKV_LD; const bf16_t* lo = LO + (size_t)m * 2048;
        R.vr[i] = zr[col]; R.vx[i] = zr[512 + col]; R.vv[i] = zr[1024 + col]; R.ve[i] = lo[col]; R.va[i] = lo[512 + col]; R.vk[i] = Y[(size_t)m * D_ + col]; }
}
__device__ __forceinline__ void rwkv_write_chunk(LAS float* L, const RwkvRegs& R, int n, int pw, int lane) {
    LAS float* st = L + (n & 1) * 12288;
#pragma unroll
    for (int i = 0; i < 8; ++i) { const int tt = pw + 4 * i; LAS float* q = st + tt * 64 + lane;
        q[0] = bf2f(R.vr[i]); q[2048] = __expf(-bf2f(R.ve[i])); q[4096] = bf2f(R.vx[i]); q[6144] = bf2f(R.vk[i]); q[8192] = bf2f(R.va[i]); q[10240] = bf2f(R.vv[i]); }
}
__device__ __forceinline__ void rwkv_store_chunk(const LAS float* L, int n, int pw, int lane, int b, int col, bf16_t* YR, int half) {
    const LAS float* sY = L + 24576 + (n & 1) * 2048;
#pragma unroll
    for (int i = 0; i < 8; ++i) { const int tt = pw + 4 * i, m = b * T_ + 32 * n + tt; if ((lane >> 4) == half) YR[(size_t)m * 2048 + 1536 + col] = f2bf(sY[tt * 64 + lane]); }
}
__device__ __forceinline__ void rwkv_scan(const Ctx& c, const Params& p, int o, int nblk) {
    const bf16_t* RKV = (const bf16_t*)(c.ws + WS_RKV); const bf16_t* LO = (const bf16_t*)(c.ws + WS_LO); bf16_t* Y = (bf16_t*)(c.ws + WS_AB);
    LAS float* L = (LAS float*)(c.lds);
    const bool producer = c.wave >= 4;
    for (int item = c.bid; item < 128; item += nblk) {
        const int bh = item >> 2, half = item & 3, b = bh >> 3, h = bh & 7; const int col = h * 64 + c.lane;
        if (producer) {
            const int pw = c.wave - 4;
            RwkvRegs R;
            rwkv_load_chunk(R, 0, pw, b, col, RKV, LO, Y); rwkv_write_chunk(L, R, 0, pw, c.lane);
            rwkv_load_chunk(R, 1, pw, b, col, RKV, LO, Y);
            for (int n = 0; n < 256; ++n) {
                LDS_BARRIER();
                if (n + 1 < 256) rwkv_write_chunk(L, R, n + 1, pw, c.lane);
                if (n + 2 < 256) rwkv_load_chunk(R, n + 2, pw, b, col, RKV, LO, Y);
                if (n >= 1) rwkv_store_chunk(L, n - 1, pw, c.lane, b, col, (bf16_t*)LO, half);
            }
            LDS_BARRIER();
            rwkv_store_chunk(L, 255, pw, c.lane, b, col, (bf16_t*)LO, half);
        } else {
            f32x2 s2[2];
            s2[0] = (f32x2){0.f, 0.f}; s2[1] = (f32x2){0.f, 0.f};
            const int row = 16 * half + 4 * c.wave + (c.lane >> 4), kq = c.lane & 15;
            for (int n = 0; n < 256; ++n) {
                LDS_BARRIER();
                const LAS float* st = L + (n & 1) * 12288 + 4 * kq; const LAS float* sV = L + (n & 1) * 12288 + 10240 + row; LAS float* sY = L + 24576 + (n & 1) * 2048 + row;
                float yreg[32];
#pragma unroll
                for (int tt = 0; tt < 32; ++tt) { const LAS float* q4 = st + tt * 64;
                    const f32x4 rr = *(const LAS f32x4*)(q4), wd = *(const LAS f32x4*)(q4 + 2048), kx = *(const LAS f32x4*)(q4 + 4096), kk = *(const LAS f32x4*)(q4 + 6144), ka = *(const LAS f32x4*)(q4 + 8192);
                    const float vv = sV[tt * 64];
#define P2(v4, i) ((f32x2){v4[2 * (i)], v4[2 * (i) + 1]})
                    const f32x2 pa = s2[0] * P2(kk, 0) + s2[1] * P2(kk, 1);
                    float px_ = sum16_dpp(pa.x + pa.y); asm volatile("" : "+v"(px_)); const float sa = -px_;
                    s2[0] = s2[0] * P2(wd, 0) + (P2(ka, 0) * sa + P2(kx, 0) * vv); s2[1] = s2[1] * P2(wd, 1) + (P2(ka, 1) * sa + P2(kx, 1) * vv);
                    const f32x2 ya = s2[0] * P2(rr, 0) + s2[1] * P2(rr, 1);
#undef P2
                    float yx_ = sum16_dpp(ya.x + ya.y); asm volatile("" : "+v"(yx_));
                    yreg[tt] = yx_; }
                if (kq == 0) {
#pragma unroll
                    for (int tt = 0; tt < 32; ++tt) sY[tt * 64] = yreg[tt]; }
            }
            LDS_BARRIER();
        }
        LDS_BARRIER();
    }
}
__device__ __forceinline__ void rwkv_post(const Ctx& c, const Params& p, int o) {
    const bf16_t* RKV = (const bf16_t*)(c.ws + WS_RKV); const bf16_t* LO = (const bf16_t*)(c.ws + WS_LO); bf16_t* Y = (bf16_t*)(c.ws + WS_AB);
    const float* lnw = p.in[c.zo + 23] + (size_t)o * 512; const float* lnb = p.in[c.zo + 24] + (size_t)o * 512; const float* BON = (const float*)(c.ws + WS_LA);
    const int h = c.lane >> 3, c8 = h * 64 + 8 * (c.lane & 7);
    float lw[8], lb[8];
#pragma unroll
    for (int i = 0; i < 8; ++i) { lw[i] = lnw[c8 + i]; lb[i] = lnb[c8 + i]; }
    for (int m = c.gw; m < M_; m += c.ngw) { const bf16_t* lo = LO + (size_t)m * 2048;
        float y[8], v[8], g[8]; unpack8(*(const u32x4*)(lo + 1536 + c8), y); unpack8(*(const u32x4*)(RKV + (size_t)m * RKV_LD + 1024 + c8), v); unpack8(*(const u32x4*)(lo + 1024 + c8), g);
        const float bon = BON[(size_t)m * 8 + h];
        float s1 = 0.f;
#pragma unroll
        for (int i = 0; i < 8; ++i) s1 += y[i];
        const float mean = sum8_dpp(s1) * (1.f / 64.f); float s2 = 0.f;
#pragma unroll
        for (int i = 0; i < 8; ++i) { y[i] -= mean; s2 += y[i] * y[i]; }
        const float rs = rsqrtf(sum8_dpp(s2) * (1.f / 64.f) + 64e-5f); float out[8];
#pragma unroll
        for (int i = 0; i < 8; ++i) out[i] = (y[i] * rs * lw[i] + lb[i] + bon * v[i]) * g[i];
        *(u32x4*)(Y + (size_t)m * D_ + c8) = pack8(out); }
}

__device__ __forceinline__ void mla_prep(const Ctx& c, const Params& p, int o) {
    bf16_t* QR = (bf16_t*)(c.ws + WS_QR); const bf16_t* KVR = (const bf16_t*)(c.ws + WS_KVR); const bf16_t* KR = (const bf16_t*)(c.ws + WS_KR); const float* RS = (const float*)(c.ws + WS_RS);
    bf16_t* KH = (bf16_t*)(c.ws + WS_KH); bf16_t* VT = (bf16_t*)(c.ws + WS_VT);
    const float* qln = p.in[c.zo + 33] + (size_t)o * 96; const float* kln = p.in[c.zo + 34] + (size_t)o * 96; const int* pos = (const int*)p.in[c.zo + 1];
    LAS bf16_t* sVT = (LAS bf16_t*)c.lds;
    const int head = c.lane >> 3, sub = c.lane & 7;
    float gqn[8], gkn[8], gq1[2], gq2[2], gk1[2], gk2[2];
#pragma unroll
    for (int i = 0; i < 8; ++i) { gqn[i] = qln[8 * sub + i]; gkn[i] = kln[8 * sub + i]; }
#pragma unroll
    for (int j = 0; j < 2; ++j) { gq1[j] = qln[64 + 2 * sub + j]; gq2[j] = qln[80 + 2 * sub + j]; gk1[j] = kln[64 + 2 * sub + j]; gk2[j] = kln[80 + 2 * sub + j]; }
    const float QSCALE = 0.10206207261596577f * 1.4426950408889634f;
    const float invf = exp2f(-(float)(2 * (c.lane & 15)) * (13.287712379549449f / 32.f));
    for (int tile = c.bid; tile < 512; tile += c.G) { const int m0 = tile * 64;
#pragma unroll 2
        for (int q = 0; q < 8; ++q) { const int tt = c.wave * 8 + q, m = m0 + tt; const float rsq = RS[2 * m], rskv = RS[2 * m + 1];
            float sn_, cs_; sincosf((float)pos[m] * invf, &sn_, &cs_);
            float cs[2], sn[2];
#pragma unroll
            for (int j = 0; j < 2; ++j) { cs[j] = __shfl(cs_, 2 * sub + j); sn[j] = __shfl(sn_, 2 * sub + j); }
            { bf16_t* qp = QR + (size_t)m * 768 + head * 96; float v[8]; unpack8(*(const u32x4*)(qp + 8 * sub), v);
              const unsigned r1 = *(const unsigned*)(qp + 64 + 2 * sub), r2 = *(const unsigned*)(qp + 80 + 2 * sub);
              float x1[2] = {asf(r1 << 16) * rsq, asf(r1 & 0xffff0000u) * rsq}, x2[2] = {asf(r2 << 16) * rsq, asf(r2 & 0xffff0000u) * rsq};
              float ss = x1[0] * x1[0] + x1[1] * x1[1] + x2[0] * x2[0] + x2[1] * x2[1];
#pragma unroll
              for (int i = 0; i < 8; ++i) { v[i] *= rsq; ss += v[i] * v[i]; }
              const float rn = rsqrtf(sum8_dpp(ss) * (1.f / 96.f) + 1e-6f) ;
#pragma unroll
              for (int i = 0; i < 8; ++i) v[i] = v[i] * rn * gqn[i] * QSCALE;
              float o1[2], o2[2];
#pragma unroll
              for (int j = 0; j < 2; ++j) { const float a = x1[j] * rn * gq1[j], bq = x2[j] * rn * gq2[j]; o1[j] = (a * cs[j] - bq * sn[j]) * QSCALE; o2[j] = (bq * cs[j] + a * sn[j]) * QSCALE; }
              *(u32x4*)(qp + 8 * sub) = pack8(v); *(unsigned*)(qp + 64 + 2 * sub) = pk2(o1[0], o1[1]); *(unsigned*)(qp + 80 + 2 * sub) = pk2(o2[0], o2[1]); }
            { const bf16_t* kp = KVR + (size_t)m * 1024 + head * 128; float v[8]; unpack8(*(const u32x4*)(kp + 8 * sub), v);
              const unsigned r1 = *(const unsigned*)(KR + (size_t)m * 32 + 2 * sub), r2 = *(const unsigned*)(KR + (size_t)m * 32 + 16 + 2 * sub);
              float x1[2] = {asf(r1 << 16), asf(r1 & 0xffff0000u)}, x2[2] = {asf(r2 << 16), asf(r2 & 0xffff0000u)};
              float ss = x1[0] * x1[0] + x1[1] * x1[1] + x2[0] * x2[0] + x2[1] * x2[1];
#pragma unroll
              for (int i = 0; i < 8; ++i) { v[i] *= rskv; ss += v[i] * v[i]; }
              const float rn = rsqrtf(sum8_dpp(ss) * (1.f / 96.f) + 1e-6f);
#pragma unroll
              for (int i = 0; i < 8; ++i) v[i] = v[i] * rn * gkn[i];
              float o1[2], o2[2];
#pragma unroll
              for (int j = 0; j < 2; ++j) { const float a = x1[j] * rn * gk1[j], bq = x2[j] * rn * gk2[j]; o1[j] = a * cs[j] - bq * sn[j]; o2[j] = bq * cs[j] + a * sn[j]; }
              bf16_t* ko = KH + (size_t)m * 768 + head * 96;
              *(u32x4*)(ko + 8 * sub) = pack8(v); *(unsigned*)(ko + 64 + 2 * sub) = pk2(o1[0], o1[1]); *(unsigned*)(ko + 80 + 2 * sub) = pk2(o2[0], o2[1]);
              float vv[8]; unpack8(*(const u32x4*)(kp + 64 + 8 * sub), vv);
#pragma unroll
              for (int i = 0; i < 8; ++i) sVT[(head * 64 + 8 * sub + i) * 72 + tt] = f2bf(vv[i] * rskv); } }
        __syncthreads();
        { const int row = c.tid; const int b = m0 / T_, t0 = m0 & (T_ - 1); bf16_t* dst = VT + ((size_t)(b * 8) * 64 + row) * T_ + t0;
#pragma unroll
          for (int i = 0; i < 8; ++i) *(u32x4*)(dst + 8 * i) = *(const LAS u32x4*)(sVT + row * 72 + 8 * i); }
        __syncthreads();
    }
}

__device__ __forceinline__ void attn_phase(const Ctx& c, const Params& p, int o, int first, int cidx) {
    const bf16_t* QH = (const bf16_t*)(c.ws + WS_QR); const bf16_t* KH = (const bf16_t*)(c.ws + WS_KH); const bf16_t* VT = (const bf16_t*)(c.ws + WS_VT); bf16_t* Y = (bf16_t*)(c.ws + WS_AB);
    const int l31 = c.lane & 31, hh = c.lane >> 5;
    if (c.bid < first) return;
    unsigned* cnt = (unsigned*)(c.ws + WS_CTL) + 64 * o + 16 * cidx;
    LAS bf16_t* sK = (LAS bf16_t*)(c.lds);
    LAS bf16_t* sVt = (LAS bf16_t*)(c.lds + 26624);
    LAS unsigned* sU = (LAS unsigned*)(c.lds + 26624 + 18432);
    const int k0row = c.tid / 12, k0ch = c.tid % 12; const int k1p = c.tid + 512, k1row = k1p / 12, k1ch = k1p % 12; const bool k1on = c.tid < 256;
    const int vrow = c.tid >> 3, vch = c.tid & 7;
    for (;;) {
        if (c.tid == 0) sU[0] = atomicAdd(cnt, 1u);
        __syncthreads();
        const unsigned uu = sU[0];
        __syncthreads();
        if (uu >= 1024u) break;
        const int bh = uu & 31, b = bh >> 3, h = bh & 7; const int qblk = 31 - (int)(uu >> 5); const int q0 = qblk * 256, qs = q0 + 32 * c.wave;
        bf16x8 qf[6]; { const bf16_t* qp = QH + (size_t)(b * T_ + qs + l31) * 768 + h * 96 + 8 * hh;
#pragma unroll
            for (int ks = 0; ks < 6; ++ks) qf[ks] = *(const bf16x8*)(qp + 16 * ks); }
        f32x16 o0 = {}, o1 = {}; float mrun = -INFINITY, lrun = 0.f;
        const int ntile = 4 * (qblk + 1);
        const bf16_t* kg = KH + (size_t)(b * T_) * 768 + h * 96; const bf16_t* vg = VT + (size_t)bh * 64 * T_;
        u32x4 rk0, rk1 = {}, rv;
        rk0 = *(const u32x4*)(kg + (size_t)k0row * 768 + 8 * k0ch); if (k1on) rk1 = *(const u32x4*)(kg + (size_t)k1row * 768 + 8 * k1ch); rv = *(const u32x4*)(vg + (size_t)vrow * T_ + 8 * vch);
        *(LAS u32x4*)(sK + k0row * 104 + 8 * k0ch) = rk0; if (k1on) *(LAS u32x4*)(sK + k1row * 104 + 8 * k1ch) = rk1; *(LAS u32x4*)(sVt + vrow * 72 + 8 * vch) = rv;
        __syncthreads();
        for (int kt = 0; kt < ntile; ++kt) { const int kv0 = kt * 64; const int buf = kt & 1;
            if (kt + 1 < ntile) { const int kn = kv0 + 64;
                rk0 = *(const u32x4*)(kg + (size_t)(kn + k0row) * 768 + 8 * k0ch); if (k1on) rk1 = *(const u32x4*)(kg + (size_t)(kn + k1row) * 768 + 8 * k1ch); rv = *(const u32x4*)(vg + (size_t)vrow * T_ + kn + 8 * vch); }
            if (kv0 <= qs + 31) {
                const LAS bf16_t* kb = sK + buf * 6656 + l31 * 104 + 8 * hh; const LAS bf16_t* vb = sVt + buf * 4608 + l31 * 72 + 4 * hh;
                f32x16 p0 = {}, p1 = {};
#pragma unroll
                for (int ks = 0; ks < 6; ++ks) { const bf16x8 k0 = *(const LAS bf16x8*)(kb + 16 * ks); const bf16x8 k1 = *(const LAS bf16x8*)(kb + 32 * 104 + 16 * ks);
                    p0 = __builtin_amdgcn_mfma_f32_32x32x16_bf16(k0, qf[ks], p0, 0, 0, 0); p1 = __builtin_amdgcn_mfma_f32_32x32x16_bf16(k1, qf[ks], p1, 0, 0, 0); }
                if (kv0 + 63 > qs) { const int q = qs + l31;
#pragma unroll
                    for (int r = 0; r < 16; ++r) { const int kv = kv0 + crow(r, hh); if (kv > q) p0[r] = -INFINITY; if (kv + 32 > q) p1[r] = -INFINITY; } }
                float mxa = fmaxf(fmaxf(p0[0], p1[0]), p0[1]), mxb = fmaxf(fmaxf(p1[1], p0[2]), p1[2]);
#pragma unroll
                for (int r = 3; r < 15; r += 2) { mxa = fmaxf(fmaxf(mxa, p0[r]), p1[r]); mxb = fmaxf(fmaxf(mxb, p0[r + 1]), p1[r + 1]); }
                float mx = fmaxf(fmaxf(mxa, mxb), fmaxf(p0[15], p1[15]));
                { auto rr = __builtin_amdgcn_permlane32_swap(asu(mx), asu(mx), false, false); mx = fmaxf(asf(rr[0]), asf(rr[1])); }
                const float mnew = fmaxf(mrun, mx);
                if (__any(mnew > mrun)) { const float alpha = __builtin_amdgcn_exp2f(mrun - mnew); lrun *= alpha; o0 = o0 * alpha; o1 = o1 * alpha; }
                mrun = mnew;
                f32x16 e0, e1;
#pragma unroll
                for (int r = 0; r < 16; ++r) { e0[r] = __builtin_amdgcn_exp2f(p0[r] - mnew); e1[r] = __builtin_amdgcn_exp2f(p1[r] - mnew); }
                p0 = e0; p1 = e1;
                { const f32x16 t = e0 + e1; lrun += ((t[0] + t[1]) + (t[2] + t[3])) + ((t[4] + t[5]) + (t[6] + t[7])) + ((t[8] + t[9]) + (t[10] + t[11])) + ((t[12] + t[13]) + (t[14] + t[15])); }
                const bf16x8 pf00 = pkfrag(p0, 0), pf01 = pkfrag(p0, 1), pf10 = pkfrag(p1, 0), pf11 = pkfrag(p1, 1);
#define PV_STEP(OACC, mm, ktt, ss, PF) do { OACC = __builtin_amdgcn_mfma_f32_32x32x16_bf16(ldA_perm(vb + (mm) * 32 * 72 + 32 * (ktt) + 16 * (ss)), PF, OACC, 0, 0, 0); } while (0)
                PV_STEP(o0, 0, 0, 0, pf00); PV_STEP(o0, 0, 0, 1, pf01); PV_STEP(o0, 0, 1, 0, pf10); PV_STEP(o0, 0, 1, 1, pf11);
                PV_STEP(o1, 1, 0, 0, pf00); PV_STEP(o1, 1, 0, 1, pf01); PV_STEP(o1, 1, 1, 0, pf10); PV_STEP(o1, 1, 1, 1, pf11);
#undef PV_STEP
            }
            if (kt + 1 < ntile) { const int nb = buf ^ 1;
                *(LAS u32x4*)(sK + nb * 6656 + k0row * 104 + 8 * k0ch) = rk0; if (k1on) *(LAS u32x4*)(sK + nb * 6656 + k1row * 104 + 8 * k1ch) = rk1; *(LAS u32x4*)(sVt + nb * 4608 + vrow * 72 + 8 * vch) = rv; }
            __syncthreads();
        }
        float l; { auto rr = __builtin_amdgcn_permlane32_swap(asu(lrun), asu(lrun), false, false); l = asf(rr[0]) + asf(rr[1]); }
        const float inv = 1.f / l;
        bf16_t* yo = Y + (size_t)(b * T_ + qs + l31) * D_ + 512 + h * 64;
#pragma unroll
        for (int r = 0; r < 16; ++r) { yo[crow(r, hh)] = f2bf(o0[r] * inv); yo[32 + crow(r, hh)] = f2bf(o1[r] * inv); }
    }
}

#define XB_TMO      128
#define XB_XCNT(j)  (256  + 64 * (j))
#define XB_XSUB(j)  (1280 + 64 * (j))
#define XB_XGEN(j)  (2304 + 64 * (j))
#define XB_TOP      3328
#define XB_TOPGEN   3392
#define XCD_BAR_WORDS 3456
#define XB_SPIN_CAP (1u << 22)
__device__ __forceinline__ unsigned xb_ld(unsigned* p)              { return __hip_atomic_load(p, __ATOMIC_RELAXED, __HIP_MEMORY_SCOPE_AGENT); }
__device__ __forceinline__ unsigned xb_add(unsigned* p, unsigned v) { return __hip_atomic_fetch_add(p, v, __ATOMIC_RELAXED, __HIP_MEMORY_SCOPE_AGENT); }
__device__ __forceinline__ unsigned xb_xcc_id() { return (unsigned)__builtin_amdgcn_s_getreg((3 << 11) | 20) & 0xFu; }
#define XB_SPIN(cond, bar) do { unsigned _sp = 0; while (cond) { __builtin_amdgcn_s_sleep(1); \
    if ((++_sp & 255u) == 0u) { if (xb_ld(&(bar)[XB_TMO])) break; if (_sp > XB_SPIN_CAP) { atomicAdd(&(bar)[XB_TMO], 1u); break; } } } } while (0)
struct XcdBarrier { unsigned* bar; unsigned x; volatile LAS unsigned* st; };
__device__ __forceinline__ XcdBarrier xcd_barrier_post(unsigned* bar, volatile LAS unsigned* st) {
    XcdBarrier b; b.bar = bar; b.x = xb_xcc_id(); b.st = st;
    if (threadIdx.x == 0) (void)xb_add(&bar[XB_XCNT(b.x)], 1u);
    return b;
}
__device__ __forceinline__ void xcd_barrier_complete(unsigned* bar, unsigned x, unsigned& nloc, unsigned& nx) {
    const unsigned G = gridDim.x * gridDim.y * gridDim.z;
    unsigned sum, cnt, mine, sp = 0u;
    for (;;) {
        sum = 0u; cnt = 0u; mine = 0u;
#pragma unroll
        for (unsigned j = 0; j < 16; ++j) { const unsigned c = xb_ld(&bar[XB_XCNT(j)]); sum += c; cnt += (c > 0u) ? 1u : 0u; mine = (j == x) ? c : mine; }
        if (sum == G) break;
        __builtin_amdgcn_s_sleep(1);
        if ((++sp & 255u) == 0u) { if (xb_ld(&bar[XB_TMO])) break; if (sp > XB_SPIN_CAP) { atomicAdd(&bar[XB_TMO], 1u); break; } }
    }
    nloc = mine > 0u ? mine : 1u; nx = cnt > 0u ? cnt : 1u;
}
__device__ __forceinline__ void xcd_barrier(const XcdBarrier& b, int wave_s) {
    asm volatile("s_waitcnt vmcnt(0)" ::: "memory");
    __syncthreads();
    int l0_; asm volatile("v_mbcnt_lo_u32_b32 %0, -1, 0\n\tv_mbcnt_hi_u32_b32 %0, -1, %0" : "=v"(l0_));
    if (wave_s == 0 && l0_ == 0) {
        unsigned* bar = b.bar; asm volatile("" : "+s"(bar));
        __builtin_amdgcn_s_waitcnt(0);
        unsigned nloc = b.st[0], nx = b.st[1];
        if (nloc == 0u) { xcd_barrier_complete(bar, b.x, nloc, nx); b.st[0] = nloc; b.st[1] = nx; }
        const unsigned old = xb_add(&bar[XB_XSUB(b.x)], 1u);
        const unsigned gen = old / nloc;
        if (old + 1u == (gen + 1u) * nloc) {
            __builtin_amdgcn_fence(__ATOMIC_RELEASE, "agent");
            asm volatile("s_waitcnt vmcnt(0)" ::: "memory");
            const unsigned og = xb_add(&bar[XB_TOP], 1u);
            const unsigned tg = og / nx;
            if (og + 1u == (tg + 1u) * nx) xb_add(&bar[XB_TOPGEN], 1u);
            else XB_SPIN(xb_ld(&bar[XB_TOPGEN]) == tg, bar);
            __builtin_amdgcn_fence(__ATOMIC_ACQUIRE, "agent");
            xb_add(&bar[XB_XGEN(b.x)], 1u);
            asm volatile("s_waitcnt vmcnt(0)" ::: "memory");
        } else {
            XB_SPIN(xb_ld(&bar[XB_XGEN(b.x)]) == gen, bar);
            __builtin_amdgcn_fence(__ATOMIC_ACQUIRE, "agent");
            asm volatile("s_waitcnt vmcnt(0)" ::: "memory");
        }
    }
    __syncthreads();
}

__global__ void __launch_bounds__(512, 2) fwd_kernel(Params p) {
    extern __shared__ __attribute__((aligned(16))) unsigned char lds_raw[];
    const int wave_s = __builtin_amdgcn_readfirstlane((int)threadIdx.x >> 6);
    const int only = p.only;
#if !MULTI_LAUNCH
    cg::grid_group grid = cg::this_grid();
    { volatile LAS unsigned* misc_ = (volatile LAS unsigned*)((LAS unsigned char*)lds_raw + 131072); if (threadIdx.x < 64) misc_[threadIdx.x] = 0u; }
    __syncthreads();
    (void)xcd_barrier_post((unsigned*)(p.ws + WS_CTL) + 4096, (volatile LAS unsigned*)((LAS unsigned char*)lds_raw + 131072));
#endif
    for (int ph = 0; ph < 44; ++ph) {
        if (only >= 0 && only != ph) continue;
        int zo_ = 0; asm volatile("" : "+s"(zo_));
        int wv_ = wave_s, bid_ = blockIdx.x, G_ = gridDim.x; asm volatile("" : "+s"(wv_), "+s"(bid_), "+s"(G_));
        Ctx c; c.lds = (LAS unsigned char*)lds_raw + zo_;
        { int l_; asm volatile("v_mbcnt_lo_u32_b32 %0, -1, 0\n\tv_mbcnt_hi_u32_b32 %0, -1, %0" : "=v"(l_)); c.lane = l_; c.tid = wv_ * 64 + l_; }
        c.wave = wv_; c.bid = bid_; c.G = G_; c.gw = c.bid * 8 + c.wave; c.ngw = c.G * 8; c.zo = zo_;
        int L, k; if (ph < 10) { L = 0; k = ph; } else if (ph < 22) { L = 1; k = ph - 10; } else if (ph < 32) { L = 2; k = ph - 22; } else { L = 3; k = ph - 32; }
        const uintptr_t wsu_ = (uintptr_t)(*(unsigned char* const*)((const char*)&p.ws + zo_)), outu_ = (uintptr_t)(*(float* const*)((const char*)&p.out + zo_));
        unsigned wlo_ = (unsigned)(wsu_ & 0xffffffffu), whi_ = (unsigned)(wsu_ >> 32), olo_ = (unsigned)(outu_ & 0xffffffffu), ohi_ = (unsigned)(outu_ >> 32);
        wlo_ = (unsigned)__builtin_amdgcn_readfirstlane((int)wlo_); whi_ = (unsigned)__builtin_amdgcn_readfirstlane((int)whi_); olo_ = (unsigned)__builtin_amdgcn_readfirstlane((int)olo_); ohi_ = (unsigned)__builtin_amdgcn_readfirstlane((int)ohi_);
        asm volatile("" : "+s"(wlo_), "+s"(whi_), "+s"(olo_), "+s"(ohi_));
        unsigned char* ws = (unsigned char*)(((uintptr_t)whi_ << 32) | (uintptr_t)wlo_); c.ws = ws; float* xout = (float*)(((uintptr_t)ohi_ << 32) | (uintptr_t)olo_);
        bf16_t* AB = (bf16_t*)(ws + WS_AB); bf16_t* Zb = (bf16_t*)(ws + WS_Z);
        const bf16_t* W_GU = (const bf16_t*)(ws + WS_WB + WB_GU); const bf16_t* W_DN = (const bf16_t*)(ws + WS_WB + WB_DN);
        const bf16_t* W_IN = (const bf16_t*)(ws + WS_WB + WB_IN); const bf16_t* W_OUT = (const bf16_t*)(ws + WS_WB + WB_OUT);
        const bf16_t* W_LORA = (const bf16_t*)(ws + WS_WB + WB_LORA); const bf16_t* W_UQ = (const bf16_t*)(ws + WS_WB + WB_UQ); const bf16_t* W_UKV = (const bf16_t*)(ws + WS_WB + WB_UKV);
        const bool odd = (L & 1) != 0; const int e = L >> 1, o = L >> 1;
        const int kt = odd ? k - 8 : k - 6;
        if (k == 0) {
            const float* xcur = (L == 0) ? p.in[zo_] : xout;
            if (PM & 1) { if (odd) convert_odd(c, p, L); else convert_even(c, p, L); }
            if (PM & 2) rms_rows(c, xcur, p.in[2 + zo_] + (size_t)L * D_, AB, L == 0 ? xout : nullptr);
        } else if (kt == 0) { if (PM & 1024) run_gemm(c, AB, D_, W_OUT, D_, D_, pg8::EpiResid{xout, D_});
        } else if (kt == 1) { if (PM & 2) rms_rows(c, xout, p.in[3 + zo_] + (size_t)L * D_, AB, nullptr);
        } else if (kt == 2) { if (PM & 2048) run_gemm(c, AB, D_, W_GU, 2 * DFF, D_, pg8::EpiSwiglu{Zb, DFF});
        } else if (kt == 3) { if (PM & 1024) run_gemm(c, Zb, DFF, W_DN, D_, DFF, pg8::EpiResid{xout, D_});
        } else if (!odd) {
            if (k == 1) { if (PM & 4) run_gemm(c, AB, D_, W_IN, 4096, D_, pg8::EpiBf16{Zb, ZLD_E, ZLD_E}); }
            else if (k == 2) { if (PM & 8) halo_copy(c, p, e); }
            else if (k == 3) { if (PM & 8) even_prep(c, p, e); }
            else if (k == 4) { if (PM & 16) gdn_scan(c, p, e); }
            else { if (PM & 16) gdn_post(c, p, e); }
        } else {
            if (k == 1) { if (PM & 4) run_gemm(c, AB, D_, W_IN, ZLD_O, D_, pg8::EpiSplit{(bf16_t*)(ws + WS_RKV), RKV_LD, 1536, (bf16_t*)(ws + WS_Z2), Z2_LD, 1536 + Z2_LD}); }
            else if (k == 2) { if (PM & 32) { odd_prep_a(c, p, o); rwkv_bnd_copy(c, p); } }
            else if (k == 3) { if (PM & 4) { run_gemm(c, (const bf16_t*)(ws + WS_LA), 384, W_LORA, o ? 2048 : 1536, 384, pg8::EpiBf16{(bf16_t*)(ws + WS_LO), 2048, 2048});
                       asm volatile("" : "+v"(c.tid));
                       run_gemm(c, (const bf16_t*)(ws + WS_Z2) + 256, Z2_LD, W_UQ, 768, 512, pg8::EpiBf16{(bf16_t*)(ws + WS_QR), 768, 768});
                       asm volatile("" : "+v"(c.tid));
                       run_gemm(c, (const bf16_t*)(ws + WS_Z2) + 768, Z2_LD, W_UKV, 1024, 256, pg8::EpiBf16{(bf16_t*)(ws + WS_KVR), 1024, 1024}); } }
            else if (k == 4) { if (PM & 256) mla_prep(c, p, o); }
            else if (k == 5) { if (PM & 256) rwkv_prep(c, p, o); }
            else if (k == 6) { if (c.bid < SCAN_BLOCKS) { if (PM & 64) rwkv_scan(c, p, o, SCAN_BLOCKS); } if (PM & 512) attn_phase(c, p, o, 0, 0); }
            else { if (PM & 128) rwkv_post(c, p, o); }
        }
#if !MULTI_LAUNCH
        if (ph == 0) grid.sync(); else if (ph != 43) { XcdBarrier xb; xb.bar = (unsigned*)(ws + WS_CTL) + 4096; xb.x = xb_xcc_id(); xb.st = (volatile LAS unsigned*)((LAS unsigned char*)lds_raw + 131072); xcd_barrier(xb, wave_s); }
#endif
    }
}

constexpr int N_PHASES = 44;

extern "C" void kernel_launch(void* const* d_in, const int* in_sizes, int n_in, void* d_out, int out_size, void* d_ws, size_t ws_size, hipStream_t stream) {
    static int grid = 0;
    if (grid == 0) {
        if (n_in != 36 || ws_size < WS_NEED) { fprintf(stderr, "kernel_launch: unexpected inputs (n_in %d, ws %zu)\n", n_in, ws_size); grid = -1; return; }
        int dev = 0, cus = 0, per_cu = 0;
        hipGetDevice(&dev); hipDeviceGetAttribute(&cus, hipDeviceAttributeMultiprocessorCount, dev);
        hipFuncSetAttribute((const void*)fwd_kernel, hipFuncAttributeMaxDynamicSharedMemorySize, LDS_BYTES);
        hipOccupancyMaxActiveBlocksPerMultiprocessor(&per_cu, (const void*)fwd_kernel, 512, LDS_BYTES);
        (void)hipGetLastError();
        if (per_cu < 1) per_cu = 1;
        grid = cus * 1;
        if (grid <= 0) grid = 256;
    }
    if (grid < 0) return;
    (void)hipMemsetAsync(d_ws, 0, 65536, stream);
    Params prm{};
    for (int i = 0; i < 36; ++i) prm.in[i] = (const float*)d_in[i];
    prm.out = (float*)d_out; prm.ws = (unsigned char*)d_ws; prm.only = -1; prm.pad = 0;
#if MULTI_LAUNCH
    for (int ph = 0; ph < N_PHASES; ++ph) { prm.only = ph; hipLaunchKernelGGL(fwd_kernel, dim3(grid), dim3(512), LDS_BYTES, stream, prm); }
#else
    void* args[] = {&prm};
    hipError_t e = hipLaunchCooperativeKernel((const void*)fwd_kernel, dim3(grid), dim3(512), args, LDS_BYTES, stream);
    if (e != hipSuccess) fprintf(stderr, "cooperative launch failed: %s (grid %d)\n", hipGetErrorString(e), grid);
#endif
}
```

```cpp
#include <hip/hip_runtime.h>
#include <hip/hip_cooperative_groups.h>
#include <cstdint>
#include <cstdio>
namespace cg = cooperative_groups;

#ifndef MULTI_LAUNCH
#define MULTI_LAUNCH 0
#endif

#ifndef PHASE_MASK
#define PHASE_MASK 0xFFFF
#endif
constexpr int PM = PHASE_MASK;
#ifndef DUP_MASK
#define DUP_MASK 0
#endif
constexpr int DM = DUP_MASK;
#define LAS __attribute__((address_space(3)))
typedef unsigned short bf16_t;
typedef short bf16x8 __attribute__((ext_vector_type(8)));
typedef short s16x4 __attribute__((ext_vector_type(4)));
typedef float f32x4 __attribute__((ext_vector_type(4)));
typedef float f32x2 __attribute__((ext_vector_type(2)));
typedef float f32x16 __attribute__((ext_vector_type(16)));
typedef unsigned u32x4 __attribute__((ext_vector_type(4)));
typedef unsigned u32x2 __attribute__((ext_vector_type(2)));
typedef __bf16 bf16x2_t __attribute__((ext_vector_type(2)));

constexpr int T_ = 8192, M_ = 32768, D_ = 1024, DFF = 2816;
constexpr int ZLD_E = 3856, ZLD_O = 2816;
constexpr size_t MiB = 1u << 20;
constexpr size_t WS_WB = 1 * MiB, WS_AB = 33 * MiB, WS_VF = 97 * MiB, WS_Z = 129 * MiB;
constexpr size_t WS_U = 370 * MiB, WS_WN = 418 * MiB, WS_GC = 466 * MiB, WS_HALO = 468 * MiB, WS_GCB = 476 * MiB;
constexpr size_t WS_CTL = 0;
constexpr size_t WS_RKV = 129 * MiB, WS_Z2 = 225 * MiB, WS_KH = 225 * MiB, WS_VT = 273 * MiB;
constexpr size_t WS_LA = 305 * MiB, WS_LO = 329 * MiB, WS_KR = 457 * MiB, WS_RS = 459 * MiB;
constexpr size_t WS_QR = 460 * MiB, WS_KVR = 33 * MiB;
constexpr size_t WS_BND = 508 * MiB;
constexpr size_t WS_NEED = 511 * MiB;
constexpr int RKV_LD = 1536, Z2_LD = 1280, SCAN_BLOCKS = 128;
constexpr size_t WB_GU = 0, WB_DN = 11534336, WB_IN = 17301504, WB_OUT = 25690112, WB_LORA = 27787264, WB_UQ = 29360128, WB_UKV = 30146560;
constexpr int LDS_BYTES = 135168;

__device__ __forceinline__ float asf(unsigned u) { return __builtin_bit_cast(float, u); }
__device__ __forceinline__ unsigned asu(float f) { return __builtin_bit_cast(unsigned, f); }
__device__ __forceinline__ float bf2f(bf16_t b) { return asf((unsigned)b << 16); }
__device__ __forceinline__ unsigned pk2(float lo, float hi) { f32x2 v = {lo, hi}; bf16x2_t b = __builtin_convertvector(v, bf16x2_t); return __builtin_bit_cast(unsigned, b); }
__device__ __forceinline__ bf16_t f2bf(float f) { return (bf16_t)(pk2(f, 0.f) & 0xffffu); }
__device__ __forceinline__ void unpack8(u32x4 v, float* f) {
    f[0] = asf(v.x << 16); f[1] = asf(v.x & 0xffff0000u); f[2] = asf(v.y << 16); f[3] = asf(v.y & 0xffff0000u);
    f[4] = asf(v.z << 16); f[5] = asf(v.z & 0xffff0000u); f[6] = asf(v.w << 16); f[7] = asf(v.w & 0xffff0000u);
}
__device__ __forceinline__ u32x4 pack8(const float* f) { u32x4 o; o.x = pk2(f[0], f[1]); o.y = pk2(f[2], f[3]); o.z = pk2(f[4], f[5]); o.w = pk2(f[6], f[7]); return o; }
__device__ __forceinline__ float sigmoidf_(float x) { return __builtin_amdgcn_rcpf(1.f + __expf(-x)); }
__device__ __forceinline__ float siluf_(float x) { return x * __builtin_amdgcn_rcpf(1.f + __expf(-x)); }
__device__ __forceinline__ float softplusf_(float x) { return x > 20.f ? x : log1pf(__expf(x)); }
__device__ __forceinline__ int crow(int r, int hi) { return (r & 3) + 8 * (r >> 2) + 4 * hi; }
__device__ __forceinline__ float wsum(float v) {
#pragma unroll
    for (int o = 32; o > 0; o >>= 1) v += __shfl_xor(v, o);
    return v;
}
template <int CTRL> __device__ __forceinline__ float dppf(float v) { return __builtin_bit_cast(float, __builtin_amdgcn_update_dpp(0, __builtin_bit_cast(int, v), CTRL, 0xF, 0xF, true)); }
__device__ __forceinline__ float half32_sum(float v) {
    v += dppf<0x128>(v); v += dppf<0x124>(v); v += dppf<0x122>(v); v += dppf<0x121>(v);
    auto r = __builtin_amdgcn_permlane16_swap(asu(v), asu(v), false, false);
    return asf(r[0]) + asf(r[1]);
}
__device__ __forceinline__ float wave_sum_dpp(float v) { v = half32_sum(v); auto r = __builtin_amdgcn_permlane32_swap(asu(v), asu(v), false, false); return asf(r[0]) + asf(r[1]); }
__device__ __forceinline__ float sum8_dpp(float v) { v += dppf<0xB1>(v); v += dppf<0x4E>(v); v += dppf<0x141>(v); return v; }
__device__ __forceinline__ float sum16_dpp(float v) { v += dppf<0xB1>(v); v += dppf<0x4E>(v); v += dppf<0x141>(v); v += dppf<0x140>(v); return v; }
__device__ __forceinline__ bf16x8 pkfrag(const f32x16& v, int s) {
    u32x4 o; o.x = pk2(v[8 * s + 0], v[8 * s + 1]); o.y = pk2(v[8 * s + 2], v[8 * s + 3]); o.z = pk2(v[8 * s + 4], v[8 * s + 5]); o.w = pk2(v[8 * s + 6], v[8 * s + 7]);
    return __builtin_bit_cast(bf16x8, o);
}
__device__ __forceinline__ bf16x8 ldA_perm(const LAS bf16_t* p) { s16x4 a = *(const LAS s16x4*)p; s16x4 b = *(const LAS s16x4*)(p + 8); return (bf16x8){a[0], a[1], a[2], a[3], b[0], b[1], b[2], b[3]}; }
#define LDS_WAIT() asm volatile("s_waitcnt lgkmcnt(0)" ::: "memory")
#define LDS_BARRIER() do { asm volatile("s_waitcnt lgkmcnt(0)" ::: "memory"); __builtin_amdgcn_s_barrier(); asm volatile("" ::: "memory"); } while (0)

namespace pg8 {
#define PG8_LAS __attribute__((address_space(3)))
constexpr int BM = 256, BK = 64, HALF = 128, HTB = HALF * BK * 2, STAGE_BYTES = 8 * HTB, NXCD = 8, WGM = 8;
__host__ __device__ __forceinline__ int lds_byte(int r, int c) { const int st = (r >> 4) * 2 + (c >> 5), rr = r & 15, cc = c & 31, ob = rr * 64 + cc * 2; return st * 1024 + (ob ^ (((ob >> 9) & 1) << 5)); }
__host__ __device__ __forceinline__ void stage_rc(int b, int& R, int& C) { const int st = b / 1024, sb = b % 1024, swz = sb ^ (((sb >> 9) & 1) << 5); R = (st >> 1) * 16 + swz / 64; C = (st & 1) * 32 + (swz % 64) / 2; }
__host__ __device__ __forceinline__ int perm32(int rho) { const int n = rho >> 4, i = rho & 15; return 8 * (i >> 2) + 4 * n + (i & 3); }
struct Unit { int pm, pn; };
struct Gemm { const bf16_t* A; const bf16_t* Bt; int M, N, K, lda; };
struct StaticOrder {
    int nM, nN, nwg, G, c;
    __host__ __device__ void init(int M, int N, int G_, int c_) { nM = M / BM; nN = N / BM; nwg = nM * nN; G = G_; c = c_; }
    __host__ __device__ bool next(int i, Unit& u) const {
        const long L = (long)i * G + c; if (L >= nwg) return false;
        int wgid = (int)L; { const int q = nwg / NXCD, r = nwg % NXCD, xcd = wgid % NXCD, off = wgid / NXCD; wgid = (xcd < r ? xcd * (q + 1) : r * (q + 1) + (xcd - r) * q) + off; }
        const int nig = WGM * nN, gid = wgid / nig, fm = gid * WGM, gsz = (nM - fm) < WGM ? (nM - fm) : WGM;
        u.pm = fm + ((wgid % nig) % gsz); u.pn = (wgid % nig) / gsz; return true;
    }
    __device__ __forceinline__ void a_ready(const Unit&) const {}
    __device__ __forceinline__ void done(const Unit&) const {}
};
struct EpiBf16 {
    static constexpr bool PERM = true;
    bf16_t* O; int ldc; int ncols;
    __device__ __forceinline__ void operator()(const f32x4 (&acc)[2][2][4][2], const Unit& u, int wr, int wc, int fr, int fq) const {
        const int row0 = u.pm * BM + wr * 64 + fr; const int col0 = u.pn * BM + wc * 32 + 8 * fq;
#pragma unroll
        for (int ai = 0; ai < 2; ++ai)
#pragma unroll
            for (int m = 0; m < 4; ++m) { bf16_t* rowp = O + (size_t)(row0 + ai * HALF + m * 16) * ldc + col0;
#pragma unroll
                for (int bj = 0; bj < 2; ++bj) { if (col0 + bj * HALF < ncols) { const f32x4 v0 = acc[ai][bj][m][0], v1 = acc[ai][bj][m][1];
                    u32x4 w; w.x = pk2(v0[0], v0[1]); w.y = pk2(v0[2], v0[3]); w.z = pk2(v1[0], v1[1]); w.w = pk2(v1[2], v1[3]);
                    *(u32x4*)(rowp + bj * HALF) = w; } } }
    }
};
struct EpiSplit {
    static constexpr bool PERM = true;
    bf16_t* O1; int ld1; int split; bf16_t* O2; int ld2; int ncols;
    __device__ __forceinline__ void operator()(const f32x4 (&acc)[2][2][4][2], const Unit& u, int wr, int wc, int fr, int fq) const {
        const int row0 = u.pm * BM + wr * 64 + fr; const int col0 = u.pn * BM + wc * 32 + 8 * fq;
#pragma unroll
        for (int bj = 0; bj < 2; ++bj) { const int cg = col0 + bj * HALF; if (cg < ncols) { bf16_t* base = (cg < split) ? O1 + cg : O2 + (cg - split); const int ld = (cg < split) ? ld1 : ld2;
#pragma unroll
            for (int ai = 0; ai < 2; ++ai)
#pragma unroll
                for (int m = 0; m < 4; ++m) { const f32x4 v0 = acc[ai][bj][m][0], v1 = acc[ai][bj][m][1];
                    u32x4 w; w.x = pk2(v0[0], v0[1]); w.y = pk2(v0[2], v0[3]); w.z = pk2(v1[0], v1[1]); w.w = pk2(v1[2], v1[3]);
                    *(u32x4*)(base + (size_t)(row0 + ai * HALF + m * 16) * ld) = w; } } }
    }
};
struct EpiSwiglu {
    static constexpr bool PERM = true;
    bf16_t* O; int ldc;
    __device__ __forceinline__ void operator()(const f32x4 (&acc)[2][2][4][2], const Unit& u, int wr, int wc, int fr, int fq) const {
        const int row0 = u.pm * BM + wr * 64 + fr; const int col0 = u.pn * HALF + wc * 32 + 8 * fq;
#pragma unroll
        for (int ai = 0; ai < 2; ++ai)
#pragma unroll
            for (int m = 0; m < 4; ++m) { bf16_t* rowp = O + (size_t)(row0 + ai * HALF + m * 16) * ldc + col0;
                float h[8];
#pragma unroll
                for (int n = 0; n < 2; ++n)
#pragma unroll
                    for (int i = 0; i < 4; ++i) { const float g = acc[ai][0][m][n][i], up = acc[ai][1][m][n][i]; h[4 * n + i] = siluf_(g) * up; }
                *(u32x4*)rowp = pack8(h); }
    }
};
struct EpiResid {
    static constexpr bool PERM = false;
    float* out; int ldc;
    __device__ __forceinline__ void operator()(const f32x4 (&acc)[2][2][4][2], const Unit& u, int wr, int wc, int fr, int fq) const {
        const int row0 = u.pm * BM + wr * 64 + fr; const int col0 = u.pn * BM + wc * 32 + 4 * fq;
#pragma unroll
        for (int ai = 0; ai < 2; ++ai)
#pragma unroll
            for (int m = 0; m < 4; ++m) { float* rowp = out + (size_t)(row0 + ai * HALF + m * 16) * ldc + col0;
#pragma unroll
                for (int bj = 0; bj < 2; ++bj)
#pragma unroll
                    for (int n = 0; n < 2; ++n) { f32x4* q = (f32x4*)(rowp + bj * HALF + n * 16); *q = *q + acc[ai][bj][m][n]; }
                asm volatile("" ::: "memory"); }
    }
};

template <class Epi, class Sched>
__device__ __forceinline__ void gemm_phase(PG8_LAS unsigned char* lds, const int tid, const Gemm g, const Sched& S, const Epi& E) {
    constexpr bool ALIGN_EPI = true;
    const int wid = __builtin_amdgcn_readfirstlane(tid >> 6), lane = tid & 63, wr = wid >> 2, wc = wid & 3, fr = lane & 15, fq = lane >> 4;
    const int K = g.K, nt = K / BK, lda = g.lda;
    unsigned voffA[2], voffB[2];
#pragma unroll
    for (int i = 0; i < 2; ++i) { int R, C; stage_rc(tid * 16 + i * 8192, R, C); const int Rb = Epi::PERM ? ((R & ~31) + perm32(R & 31)) : R;
        voffA[i] = (unsigned)(R * lda + C) * 2u; voffB[i] = (unsigned)(Rb * K + C) * 2u; }
    const size_t kstep = (size_t)(BK * 2);
    const size_t hstepA = (size_t)HALF * lda * 2, hstepB = (size_t)HALF * K * 2;
    const size_t tstepA = 2 * hstepA, tstepB = 2 * hstepB;
    const unsigned ldsw = (unsigned)wid * 1024u;
    const int aoff = lds_byte(wr * 64 + fr, fq * 8), boff = lds_byte(wc * 32 + fr, fq * 8);
#define PG8_SA(b, h) (((b) * 2 + (h)) * HTB)
#define PG8_SB(b, h) ((4 + (b) * 2 + (h)) * HTB)
#define PG8_STAGE(bufoff, gbase, voff) do { _Pragma("unroll") for (int _i = 0; _i < 2; ++_i) \
        __builtin_amdgcn_global_load_lds((const unsigned*)((const char*)(gbase) + (voff)[_i]), (PG8_LAS unsigned*)(lds + (bufoff) + ldsw + _i * 8192), 16, 0, 0); } while (0)
#define PG8_LDA(dst, b, h) do { _Pragma("unroll") for (int m = 0; m < 4; ++m) _Pragma("unroll") for (int k = 0; k < 2; ++k) dst[m][k] = *(const PG8_LAS bf16x8*)(lds + PG8_SA(b, h) + aoff + m * 2048 + k * 1024); } while (0)
#define PG8_LDB(dst, b, h) do { _Pragma("unroll") for (int n = 0; n < 2; ++n) _Pragma("unroll") for (int k = 0; k < 2; ++k) dst[n][k] = *(const PG8_LAS bf16x8*)(lds + PG8_SB(b, h) + boff + n * 2048 + k * 1024); } while (0)
#define PG8_MMA(ai, bj, At, Bt) do { __builtin_amdgcn_s_setprio(1); _Pragma("unroll") for (int m = 0; m < 4; ++m) _Pragma("unroll") for (int n = 0; n < 2; ++n) _Pragma("unroll") for (int k = 0; k < 2; ++k) \
        acc[ai][bj][m][n] = __builtin_amdgcn_mfma_f32_16x16x32_bf16(Bt[n][k], At[m][k], acc[ai][bj][m][n], 0, 0, 0); __builtin_amdgcn_s_setprio(0); } while (0)
#define PG8_WAIT_V(n) asm volatile("s_waitcnt vmcnt(" #n ")" ::: "memory")
#define PG8_WAIT_L(n) asm volatile("s_waitcnt lgkmcnt(" #n ")" ::: "memory")
#define PG8_BAR __builtin_amdgcn_s_barrier()
#define PG8_SCHED __builtin_amdgcn_sched_barrier(0)
    Unit cur, nxt; int ui = 0;
    if (!S.next(0, cur)) return;
    f32x4 acc[2][2][4][2];
#pragma unroll
    for (int a = 0; a < 2; ++a)
#pragma unroll
        for (int b = 0; b < 2; ++b)
#pragma unroll
            for (int m = 0; m < 4; ++m)
#pragma unroll
                for (int n = 0; n < 2; ++n) acc[a][b][m][n] = (f32x4){0.f, 0.f, 0.f, 0.f};
    bf16x8 At[4][2], B0[2][2], B1[2][2];
    const char* cA = (const char*)g.A + (size_t)cur.pm * tstepA; const char* cB = (const char*)g.Bt + (size_t)cur.pn * tstepB;
    S.a_ready(cur);
    PG8_STAGE(PG8_SB(0, 0), cB, voffB); PG8_STAGE(PG8_SB(0, 1), cB + hstepB, voffB); PG8_STAGE(PG8_SA(0, 0), cA, voffA); PG8_STAGE(PG8_SA(0, 1), cA + hstepA, voffA);
    if (wr == 1) PG8_BAR;
    PG8_WAIT_V(2); PG8_BAR;
    PG8_STAGE(PG8_SB(1, 0), cB + kstep, voffB); PG8_STAGE(PG8_SA(1, 0), cA + kstep, voffA); PG8_STAGE(PG8_SB(1, 1), cB + hstepB + kstep, voffB);
    PG8_WAIT_V(6); PG8_BAR;
    for (;;) {
        const bool has_next = S.next(ui + 1, nxt);
        const char* nA = has_next ? (const char*)g.A + (size_t)nxt.pm * tstepA : cA; const char* nB = has_next ? (const char*)g.Bt + (size_t)nxt.pn * tstepB : cB;
        for (int t = 0; t < nt; t += 2) {
            const bool last = (t == nt - 2);
            const char* a1 = cA + (size_t)(t + 1) * kstep;
            const char* a2 = last ? nA : cA + (size_t)(t + 2) * kstep; const char* b2 = last ? nB : cB + (size_t)(t + 2) * kstep;
            const char* a3 = a2 + kstep; const char* b3 = b2 + kstep;
            if (last && has_next) S.a_ready(nxt);
            PG8_LDB(B0, 0, 0); PG8_LDB(B1, 0, 1); PG8_SCHED; PG8_LDA(At, 0, 0); PG8_STAGE(PG8_SA(1, 1), a1 + hstepA, voffA);
            PG8_WAIT_V(8); PG8_WAIT_L(0); PG8_BAR; PG8_MMA(0, 0, At, B0); PG8_MMA(0, 1, At, B1); PG8_BAR; PG8_SCHED;
            PG8_LDA(At, 0, 1); PG8_STAGE(PG8_SB(0, 0), b2, voffB); PG8_STAGE(PG8_SB(0, 1), b2 + hstepB, voffB); PG8_STAGE(PG8_SA(0, 0), a2, voffA);
            PG8_WAIT_V(8); PG8_WAIT_L(0); PG8_BAR; PG8_MMA(1, 0, At, B0); PG8_MMA(1, 1, At, B1); PG8_BAR; PG8_SCHED;
            PG8_LDB(B0, 1, 0); PG8_LDB(B1, 1, 1); PG8_SCHED; PG8_LDA(At, 1, 0); PG8_STAGE(PG8_SA(0, 1), a2 + hstepA, voffA);
            PG8_WAIT_V(8); PG8_WAIT_L(0); PG8_BAR; PG8_MMA(0, 0, At, B0); PG8_MMA(0, 1, At, B1); PG8_BAR; PG8_SCHED;
            PG8_LDA(At, 1, 1); PG8_STAGE(PG8_SB(1, 0), b3, voffB); PG8_STAGE(PG8_SB(1, 1), b3 + hstepB, voffB); PG8_STAGE(PG8_SA(1, 0), a3, voffA);
            PG8_WAIT_V(8); PG8_WAIT_L(0); PG8_BAR; PG8_MMA(1, 0, At, B0); PG8_MMA(1, 1, At, B1); PG8_BAR; PG8_SCHED;
        }
        if constexpr (ALIGN_EPI) { if (wr == 0) PG8_BAR; }
        E(acc, cur, wr, wc, fr, fq); S.done(cur);
        if (!has_next) break;
#pragma unroll
        for (int a = 0; a < 2; ++a)
#pragma unroll
            for (int b = 0; b < 2; ++b)
#pragma unroll
                for (int m = 0; m < 4; ++m)
#pragma unroll
                    for (int n = 0; n < 2; ++n) acc[a][b][m][n] = (f32x4){0.f, 0.f, 0.f, 0.f};
        cur = nxt; cA = nA; cB = nB; ++ui;
        if constexpr (ALIGN_EPI) { if (wr == 1) PG8_BAR; }
    }
    PG8_WAIT_V(0);
    if constexpr (!ALIGN_EPI) { if (wr == 0) PG8_BAR; }
    PG8_BAR;
#undef PG8_SA
#undef PG8_SB
#undef PG8_STAGE
#undef PG8_LDA
#undef PG8_LDB
#undef PG8_MMA
#undef PG8_WAIT_V
#undef PG8_WAIT_L
#undef PG8_BAR
#undef PG8_SCHED
}
}

struct Params { const float* in[36]; float* out; unsigned char* ws; int only; int pad; };
struct Ctx { LAS unsigned char* lds; unsigned char* ws; int tid, lane, wave, bid, G, gw, ngw, zo; };

template <class Epi> __device__ __forceinline__ void run_gemm(const Ctx& c, const bf16_t* A, int lda, const bf16_t* Bt, int N, int K, const Epi& E) {
    pg8::Gemm g{A, Bt, M_, N, K, lda}; pg8::StaticOrder S; S.init(M_, N, c.G, c.bid);
    pg8::gemm_phase<Epi, pg8::StaticOrder>(c.lds, c.tid, g, S, E);
}

__device__ __forceinline__ void tr_item(const float* src, int ld, int kv, int nv, const float* ks, bf16_t* dst, int ldd, LAS float* scr, int lane) {
    const int n = lane & 31;
    if (kv >= 64 && nv >= 32 && !ks) {
        float tmp[32]; const float* sp = src + (size_t)(lane >> 5) * ld + n;
#pragma unroll
        for (int i = 0; i < 32; ++i) tmp[i] = sp[(size_t)(2 * i) * ld];
#pragma unroll
        for (int i = 0; i < 32; ++i) scr[(2 * i + (lane >> 5)) * 33 + n] = tmp[i];
    } else {
#pragma unroll 4
        for (int i = 0; i < 32; ++i) { const int kk = 2 * i + (lane >> 5); float v = 0.f; if (kk < kv && n < nv) { v = src[(size_t)kk * ld + n]; if (ks) v *= ks[kk]; } scr[kk * 33 + n] = v; }
    }
    LDS_WAIT(); asm volatile("" ::: "memory");
    const int c = lane & 7;
#pragma unroll
    for (int j = 0; j < 4; ++j) { const int nn = (lane >> 3) + 8 * j; const LAS float* s = scr + (8 * c) * 33 + nn;
        u32x4 o; o.x = pk2(s[0 * 33], s[1 * 33]); o.y = pk2(s[2 * 33], s[3 * 33]); o.z = pk2(s[4 * 33], s[5 * 33]); o.w = pk2(s[6 * 33], s[7 * 33]);
        *(u32x4*)(dst + (size_t)nn * ldd + 8 * c) = o; }
    LDS_WAIT(); asm volatile("" ::: "memory");
}
__device__ __forceinline__ void tr_job(const Ctx& c, const float* src, int ld, int K, int N, const float* ks, bf16_t* dst, int ldd, int Kpad, int Npad) {
    LAS float* scr = (LAS float*)(c.lds + c.wave * 8448);
    const int nnb = Npad / 32, items = (Kpad / 64) * nnb;
    for (int it = c.gw; it < items; it += c.ngw) { const int kb = it / nnb, nb = it % nnb, k0 = 64 * kb, n0 = 32 * nb;
        tr_item(src + (size_t)k0 * ld + n0, ld, K - k0, N - n0, ks ? ks + k0 : nullptr, dst + (size_t)n0 * ldd + k0, ldd, scr, c.lane); }
}
__device__ __forceinline__ void convert_common(const Ctx& c, const Params& p, int L, const float* wout_src) {
    bf16_t* WB = (bf16_t*)(c.ws + WS_WB);
    LAS float* scr = (LAS float*)(c.lds + c.wave * 8448);
    { const float* src = p.in[c.zo + 4] + (size_t)L * D_ * 2 * DFF; bf16_t* dst = (bf16_t*)((unsigned char*)WB + WB_GU);
      const int nnb = 2 * DFF / 32, items = (D_ / 64) * nnb;
      for (int it = c.gw; it < items; it += c.ngw) { const int kb = it / nnb, nb = it % nnb, k0 = 64 * kb, n0 = 32 * nb; const int t = n0 >> 8, w = n0 & 255;
          const int sc = (w < 128) ? 128 * t + w : DFF + 128 * t + (w - 128);
          tr_item(src + (size_t)k0 * (2 * DFF) + sc, 2 * DFF, 64, 32, nullptr, dst + (size_t)n0 * D_ + k0, D_, scr, c.lane); } }
    tr_job(c, p.in[c.zo + 5] + (size_t)L * DFF * D_, D_, DFF, D_, nullptr, (bf16_t*)((unsigned char*)WB + WB_DN), DFF, DFF, D_);
    tr_job(c, wout_src, D_, D_, D_, nullptr, (bf16_t*)((unsigned char*)WB + WB_OUT), D_, D_, D_);
}
__device__ __forceinline__ void convert_even(const Ctx& c, const Params& p, int L) {
    const int e = L >> 1;
    convert_common(c, p, L, p.in[c.zo + 12] + (size_t)e * D_ * D_);
    tr_job(c, p.in[c.zo + 6] + (size_t)e * D_ * 3852, 3852, D_, 3852, nullptr, (bf16_t*)(c.ws + WS_WB + WB_IN), D_, D_, 4096);
}
__device__ __forceinline__ void convert_odd(const Ctx& c, const Params& p, int L) {
    const int o = L >> 1;
    convert_common(c, p, L, p.in[c.zo + 35] + (size_t)o * D_ * D_);
    bf16_t* win = (bf16_t*)(c.ws + WS_WB + WB_IN);
    tr_job(c, p.in[c.zo + 13] + (size_t)o * D_ * 2592, 2592, D_, 2592, nullptr, win, D_, D_, 2592);
    tr_job(c, o ? p.in[c.zo + 25] + (size_t)(o - 1) * D_ * 32 : p.in[c.zo + 25], 32, D_, o ? 32 : 0, nullptr, win + (size_t)2592 * D_, D_, D_, 32);
    tr_job(c, p.in[c.zo + 25], 32, D_, 0, nullptr, win + (size_t)2624 * D_, D_, D_, 192);
    bf16_t* wl = (bf16_t*)(c.ws + WS_WB + WB_LORA);
    { LAS float* scr = (LAS float*)(c.lds + c.wave * 8448);
      const int items = 6 * 64;
      for (int it = c.gw; it < items; it += c.ngw) { const int kb = it / 64, nb = it % 64, n0 = 32 * nb, R = n0 >> 9, nn0 = n0 & 511;
          const float* src = p.in[c.zo + 16]; int kv = 0, ld = 512;
          if (R == 0 && kb == 0) { src = p.in[c.zo + 16] + (size_t)o * 64 * 512 + nn0; kv = 64; }
          else if (R == 1 && kb == 1) { src = p.in[c.zo + 18] + (size_t)o * 64 * 512 + nn0; kv = 64; }
          else if (R == 2 && (kb == 2 || kb == 3)) { src = p.in[c.zo + 19] + (size_t)o * 128 * 512 + (size_t)(kb - 2) * 64 * 512 + nn0; kv = 64; }
          else if (R == 3 && kb == 4 && o > 0) { src = p.in[c.zo + 28] + (size_t)(o - 1) * 32 * 512 + nn0; kv = 32; }
          tr_item(src, ld, kv, kv ? 32 : 0, nullptr, wl + (size_t)n0 * 384 + 64 * kb, 384, scr, c.lane); } }
    tr_job(c, p.in[c.zo + 31] + (size_t)o * 512 * 768, 768, 512, 768, p.in[c.zo + 29] + (size_t)o * 512, (bf16_t*)(c.ws + WS_WB + WB_UQ), 512, 512, 768);
    tr_job(c, p.in[c.zo + 32] + (size_t)o * 256 * 1024, 1024, 256, 1024, p.in[c.zo + 30] + (size_t)o * 256, (bf16_t*)(c.ws + WS_WB + WB_UKV), 256, 256, 1024);
}

__device__ __forceinline__ void rms_rows(const Ctx& c, const float* x, const float* gain, bf16_t* out, float* xcopy) {
    f32x4 gv[4];
#pragma unroll
    for (int j = 0; j < 4; ++j) gv[j] = ((const f32x4*)gain)[c.lane + 64 * j];
    for (int m = c.gw; m < M_; m += c.ngw) {
        const f32x4* xr = (const f32x4*)(x + (size_t)m * D_) + c.lane;
        f32x4 v[4]; float s = 0.f;
#pragma unroll
        for (int j = 0; j < 4; ++j) { v[j] = xr[64 * j]; s += (v[j].x * v[j].x + v[j].y * v[j].y) + (v[j].z * v[j].z + v[j].w * v[j].w); }
        if (xcopy) { f32x4* xc = (f32x4*)(xcopy + (size_t)m * D_) + c.lane;
#pragma unroll
            for (int j = 0; j < 4; ++j) xc[64 * j] = v[j]; }
        const float r = rsqrtf(wave_sum_dpp(s) * (1.f / D_) + 1e-6f);
        u32x2* o8 = (u32x2*)(out + (size_t)m * D_) + c.lane;
#pragma unroll
        for (int j = 0; j < 4; ++j) { u32x2 w; w.x = pk2(v[j].x * r * gv[j].x, v[j].y * r * gv[j].y); w.y = pk2(v[j].z * r * gv[j].z, v[j].w * r * gv[j].w); o8[64 * j] = w; }
    }
}

__device__ __forceinline__ void conv4_silu8(const bf16_t* zp, int t, const float* cw, float* y) {
#pragma unroll
    for (int i = 0; i < 8; ++i) y[i] = 0.f;
#pragma unroll
    for (int j = 0; j < 4; ++j) { const int dt = j - 3;
        if (t + dt >= 0) { float xv[8]; unpack8(*(const u32x4*)(zp + (long)dt * ZLD_E), xv);
            const f32x4 w0 = *(const f32x4*)(cw + j * 2304), w1 = *(const f32x4*)(cw + j * 2304 + 4);
            y[0] += w0.x * xv[0]; y[1] += w0.y * xv[1]; y[2] += w0.z * xv[2]; y[3] += w0.w * xv[3];
            y[4] += w1.x * xv[4]; y[5] += w1.y * xv[5]; y[6] += w1.z * xv[6]; y[7] += w1.w * xv[7]; } }
#pragma unroll
    for (int i = 0; i < 8; ++i) y[i] = siluf_(y[i]);
}
__device__ __forceinline__ void conv4h(const bf16_t* zc, int row, const bf16_t* hp, bool has_prev, const float* cw, float* y) {
#pragma unroll
    for (int i = 0; i < 8; ++i) y[i] = 0.f;
#pragma unroll
    for (int j = 0; j < 4; ++j) { const int rr = row - 3 + j;
        if (rr >= 0 || has_prev) { const bf16_t* src = (rr >= 0) ? zc + (size_t)rr * ZLD_E : hp + (3 + rr) * 384; float xv[8]; unpack8(*(const u32x4*)src, xv);
            const f32x4 w0 = *(const f32x4*)(cw + j * 2304), w1 = *(const f32x4*)(cw + j * 2304 + 4);
            y[0] += w0.x * xv[0]; y[1] += w0.y * xv[1]; y[2] += w0.z * xv[2]; y[3] += w0.w * xv[3];
            y[4] += w1.x * xv[4]; y[5] += w1.y * xv[5]; y[6] += w1.z * xv[6]; y[7] += w1.w * xv[7]; } }
#pragma unroll
    for (int i = 0; i < 8; ++i) y[i] = siluf_(y[i]);
}
__device__ __forceinline__ float sum16(float v) { v += __shfl_xor(v, 1); v += __shfl_xor(v, 2); v += __shfl_xor(v, 4); v += __shfl_xor(v, 8); return v; }

__device__ __forceinline__ void even_prep(const Ctx& c, const Params& p, int e) {
    const bf16_t* Z = (const bf16_t*)(c.ws + WS_Z); bf16_t* Y = (bf16_t*)(c.ws + WS_AB);
    bf16_t* U = (bf16_t*)(c.ws + WS_U); bf16_t* WN = (bf16_t*)(c.ws + WS_WN); float* GC = (float*)(c.ws + WS_GC);
    const float* conv_a = p.in[c.zo + 7] + (size_t)e * 3 * 256; const float* conv_qkv = p.in[c.zo + 8] + (size_t)e * 4 * 2304;
    { const long NT = (long)c.G * 512;
      for (long it = (long)c.bid * 512 + c.tid; it < (long)M_ * 32; it += NT) { const int m = (int)(it >> 5), c8 = (int)(it & 31) * 8, t = m & (T_ - 1);
          const bf16_t* zr = Z + (size_t)m * ZLD_E; float ab[8], acc[8];
          unpack8(*(const u32x4*)(zr + c8), ab);
#pragma unroll
          for (int i = 0; i < 8; ++i) acc[i] = 0.f;
#pragma unroll
          for (int j = 0; j < 3; ++j) { const int dt = j - 2; if (t + dt >= 0) { const bf16_t* zc = zr + (long)dt * ZLD_E; float ac[8], ah[8];
              unpack8(*(const u32x4*)(zc + 256 + c8), ac); unpack8(*(const u32x4*)(zc + 512 + c8), ah);
#pragma unroll
              for (int i = 0; i < 8; ++i) acc[i] += conv_a[j * 256 + c8 + i] * (ac[i] * ah[i]); } }
#pragma unroll
          for (int i = 0; i < 8; ++i) acc[i] *= ab[i];
          *(u32x4*)(Y + (size_t)m * D_ + c8) = pack8(acc); } }
    const bf16_t* HALO = (const bf16_t*)(c.ws + WS_HALO); const float* GCB = (const float*)(c.ws + WS_GCB);
    bf16_t* Zw = (bf16_t*)(c.ws + WS_Z);
    LAS bf16_t* KN = (LAS bf16_t*)(c.lds);
    LAS float* VB = (LAS float*)(c.lds + 17408);
    LAS float* KBG = (LAS float*)(c.lds + 17408 + 32768);
    LAS float* Lm = (LAS float*)(c.lds + 17408 + 65536);
    LAS float* sgc = (LAS float*)(c.lds + 17408 + 65536 + 16384);
    LAS float* sbeta = sgc + 64;
    LAS bf16_t* QS = (LAS bf16_t*)(c.lds + 17408 + 65536 + 16384 + 512);
    for (int item = c.bid; item < 3072; item += c.G) {
        int tid_i = c.tid; asm volatile("" : "+v"(tid_i)); const int lane_i = tid_i & 63;
        const int n = item & 127, bh = item >> 7, h = bh % 6, b = bh / 6; const int m0 = b * T_ + 64 * n;
        if (tid_i < 128) sgc[tid_i] = GCB[(size_t)item * 128 + tid_i];
        __syncthreads();
        const float glast = sgc[63];
        u32x4 qdp0 = {}, qdp1 = {}, kdp0 = {}, kdp1 = {};
#pragma unroll 1
        for (int rep = 0; rep < 2; ++rep) { const int vi = tid_i + 512 * rep, row = vi >> 4, c8 = (vi & 15) * 8;
            const bf16_t* zc = Z + (size_t)m0 * ZLD_E + 768 + h * 128 + c8; const bf16_t* hp = HALO + (size_t)(bh * 128 + n) * 1152 + c8; float y[8], yd[8];
            conv4h(zc, row, hp, n > 0, conv_qkv + h * 128 + c8, y);
            float ss = 0.f;
#pragma unroll
            for (int i = 0; i < 8; ++i) ss += y[i] * y[i];
            ss = sum16_dpp(ss); float rn = rsqrtf(ss + 1e-6f) * 0.08838834764831845f;
            const float eg = __expf(sgc[row]);
#pragma unroll
            for (int i = 0; i < 8; ++i) { y[i] *= rn; yd[i] = y[i] * eg; }
            *(LAS u32x4*)(QS + row * 136 + c8) = pack8(y); { const u32x4 t_ = pack8(yd); if (rep == 0) qdp0 = t_; else qdp1 = t_; }
            conv4h(zc + 768, row, hp + 128, n > 0, conv_qkv + 768 + h * 128 + c8, y);
            ss = 0.f;
#pragma unroll
            for (int i = 0; i < 8; ++i) ss += y[i] * y[i];
            ss = sum16_dpp(ss); rn = rsqrtf(ss + 1e-6f);
            const float bg = sbeta[row] * eg; const float ek = __expf(glast - sgc[row]);
#pragma unroll
            for (int i = 0; i < 8; ++i) { y[i] *= rn; KBG[row * 128 + c8 + i] = y[i] * bg; yd[i] = y[i] * ek; }
            *(LAS u32x4*)(KN + row * 136 + c8) = pack8(y); { const u32x4 t_ = pack8(yd); if (rep == 0) kdp0 = t_; else kdp1 = t_; }
            conv4h(zc + 1536, row, hp + 256, n > 0, conv_qkv + 1536 + h * 128 + c8, y);
            const float be = sbeta[row];
#pragma unroll
            for (int i = 0; i < 8; ++i) VB[row * 128 + c8 + i] = y[i] * be; }
        __syncthreads();
#pragma unroll
        for (int rep = 0; rep < 2; ++rep) { const int vi = tid_i + 512 * rep, row = vi >> 4, c8 = (vi & 15) * 8;
            bf16_t* zc = Zw + (size_t)(m0 + row) * ZLD_E + 768 + h * 128 + c8; *(u32x4*)zc = rep ? qdp1 : qdp0;
            const u32x4 kd_ = rep ? kdp1 : kdp0; bf16_t* kt_ = Zw + (size_t)(m0 + (c8 >> 1)) * ZLD_E + 768 + 768 + h * 128 + row;
            kt_[0] = (bf16_t)(kd_.x & 0xffffu); kt_[64] = (bf16_t)(kd_.x >> 16); kt_[ZLD_E] = (bf16_t)(kd_.y & 0xffffu); kt_[ZLD_E + 64] = (bf16_t)(kd_.y >> 16);
            kt_[2 * ZLD_E] = (bf16_t)(kd_.z & 0xffffu); kt_[2 * ZLD_E + 64] = (bf16_t)(kd_.z >> 16); kt_[3 * ZLD_E] = (bf16_t)(kd_.w & 0xffffu); kt_[3 * ZLD_E + 64] = (bf16_t)(kd_.w >> 16); }
        { const int l31 = lane_i & 31, hh = lane_i >> 5; const int w = c.wave & 3; const int ti = (w == 0 || w == 3) ? 0 : 1, tj = (w >= 2) ? 1 : 0; const bool isq = c.wave >= 4;
            bf16_t* qko = Zw + (size_t)m0 * ZLD_E + 768 + 1536 + h * 128;
            if (w == 3) {
#pragma unroll
                for (int r = 0; r < 16; ++r) { const int i = 32 * ti + crow(r, hh), j = 32 * tj + l31; if (isq) qko[(size_t)i * ZLD_E + j] = 0; else Lm[i * 64 + j] = 0.f; }
            } else { f32x16 acc = {}; const LAS bf16_t* Am = isq ? QS : KN;
#pragma unroll
                for (int ks = 0; ks < 8; ++ks) { const bf16x8 a = *(const LAS bf16x8*)(Am + (32 * ti + l31) * 136 + 16 * ks + 8 * hh); const bf16x8 bb = *(const LAS bf16x8*)(KN + (32 * tj + l31) * 136 + 16 * ks + 8 * hh);
                    acc = __builtin_amdgcn_mfma_f32_32x32x16_bf16(a, bb, acc, 0, 0, 0); }
                const int j = 32 * tj + l31; const float gj = sgc[j];
#pragma unroll
                for (int r = 0; r < 16; ++r) { const int i = 32 * ti + crow(r, hh); const float dec = __expf(fminf(sgc[i] - gj, 0.f));
                    if (isq) qko[(size_t)i * ZLD_E + j] = (i >= j) ? f2bf(acc[r] * dec) : (bf16_t)0;
                    else Lm[i * 64 + j] = (i > j) ? sbeta[i] * acc[r] * dec : 0.f; } } }
        __syncthreads();
        if (tid_i < 256) { const int cc = tid_i & 127; const LAS float* src = (tid_i < 128) ? VB : KBG; float x[64];
            int vz = 0; asm volatile("" : "+v"(vz)); const LAS float* Lv = Lm + vz;
#pragma unroll
            for (int i = 0; i < 64; ++i) x[i] = src[i * 128 + cc];
#pragma unroll
            for (int i = 1; i < 64; ++i) { const LAS f32x4* Lr = (const LAS f32x4*)(Lv + i * 64); float a0 = x[i], a1 = 0.f;
#pragma unroll
                for (int j4 = 0; j4 < (i + 3) / 4; ++j4) { const f32x4 l = Lr[j4];
                    if (4 * j4 + 0 < i) a0 -= l[0] * x[4 * j4 + 0];
                    if (4 * j4 + 1 < i) a1 -= l[1] * x[4 * j4 + 1];
                    if (4 * j4 + 2 < i) a0 -= l[2] * x[4 * j4 + 2];
                    if (4 * j4 + 3 < i) a1 -= l[3] * x[4 * j4 + 3]; }
                x[i] = a0 + a1; }
            LAS float* dstl = (tid_i < 128) ? VB : KBG; const float sg = (tid_i < 128) ? 1.f : -1.f;
#pragma unroll
            for (int i = 0; i < 64; ++i) dstl[i * 128 + cc] = x[i] * sg; }
        __syncthreads();
#pragma unroll 1
        for (int rep = 0; rep < 4; ++rep) { const int vi = tid_i + 512 * rep, row = vi >> 5, which = (vi >> 4) & 1, c8 = (vi & 15) * 8;
            const LAS float* sp = (which ? KBG : VB) + row * 128 + c8; float f[8];
#pragma unroll
            for (int i = 0; i < 8; ++i) f[i] = sp[i];
            bf16_t* dp = (which ? WN : U) + (size_t)(m0 + row) * 768 + h * 128 + c8;
            *(u32x4*)dp = pack8(f); }
        __syncthreads();
    }
}

__device__ __forceinline__ void halo_copy(const Ctx& c, const Params& p, int e) {
    const bf16_t* Z = (const bf16_t*)(c.ws + WS_Z); bf16_t* HALO = (bf16_t*)(c.ws + WS_HALO);
    const int NT = c.G * 512, total = 24 * 128 * 3 * 3 * 16;
    for (int it = c.bid * 512 + c.tid; it < total; it += NT) { const int c8 = (it & 15) * 8; int r_ = it >> 4; const int part = r_ % 3; r_ /= 3; const int r = r_ % 3; r_ /= 3; const int n = r_ & 127, bh = r_ >> 7;
        if (n == 0) continue; const int h = bh % 6, b = bh / 6;
        *(u32x4*)(HALO + ((size_t)(bh * 128 + n) * 3 + r) * 384 + part * 128 + c8) = *(const u32x4*)(Z + (size_t)(b * T_ + 64 * n - 3 + r) * ZLD_E + 768 + part * 768 + h * 128 + c8); }
    float* GCB = (float*)(c.ws + WS_GCB); float* GC = (float*)(c.ws + WS_GC);
    for (int item = c.gw; item < 3072; item += c.ngw) { const int n = item & 127, bh = item >> 7, h = bh % 6, b = bh / 6, t = c.lane;
        const bf16_t* zr = Z + (size_t)(b * T_ + 64 * n + t) * ZLD_E;
        const float braw = bf2f(zr[3840 + h]), araw = bf2f(zr[3846 + h]);
        const float beta = sigmoidf_(braw);
        float g = -__expf(p.in[c.zo + 9][e * 6 + h]) * softplusf_(araw + p.in[c.zo + 10][e * 6 + h]);
#pragma unroll
        for (int o = 1; o < 64; o <<= 1) { const float u = __shfl_up(g, o); if (t >= o) g += u; }
        GCB[(size_t)item * 128 + t] = g; GCB[(size_t)item * 128 + 64 + t] = beta; if (t == 63) GC[(size_t)bh * 128 + n] = __expf(g); }
}

__device__ __forceinline__ void gdn_scan(const Ctx& c, const Params& p, int e) {
    const bf16_t* Z = (const bf16_t*)(c.ws + WS_Z); bf16_t* Y = (bf16_t*)(c.ws + WS_AB);
    const bf16_t* U = (const bf16_t*)(c.ws + WS_U); const bf16_t* WNg = (const bf16_t*)(c.ws + WS_WN); const float* GC = (const float*)(c.ws + WS_GC);
    LAS bf16_t* QD = (LAS bf16_t*)(c.lds);
    LAS bf16_t* WNs = (LAS bf16_t*)(c.lds + 17408);
    LAS bf16_t* UT = (LAS bf16_t*)(c.lds + 34816);
    LAS bf16_t* KDT = (LAS bf16_t*)(c.lds + 52224);
    LAS bf16_t* QK = (LAS bf16_t*)(c.lds + 70656);
    LAS bf16_t* OTb = (LAS bf16_t*)(c.lds + 79872);
    const int l31 = c.lane & 31, hh = c.lane >> 5;
    const bool producer = c.wave >= 4; const int ptid = c.tid & 255;
    for (int item = c.bid; item < 48; item += c.G) {
        const int bh = item >> 1, dvh = item & 1, h = bh % 6, b = bh / 6;
        const int e0 = 64 * dvh + 32 * (c.wave & 1);
#define GDN_LOAD_TILES(nn) do { const size_t mb_ = (size_t)(b * T_ + 64 * (nn)); _Pragma("unroll") for (int k_ = 0; k_ < 4; ++k_) { const size_t rz_ = (mb_ + prow + 16 * k_) * ZLD_E + 768 + h * 128 + pc8; const size_t ru_ = (mb_ + prow + 16 * k_) * 768 + h * 128 + pc8; \
            tq[k_] = *(const u32x4*)(Z + rz_); { const int vi_ = pt_ + 256 * k_, d_ = vi_ >> 3; tk[k_] = *(const u32x4*)(Z + (mb_ + (d_ >> 1)) * ZLD_E + 768 + 768 + h * 128 + (d_ & 1) * 64 + (vi_ & 7) * 8); } tw[k_] = *(const u32x4*)(WNg + ru_); tu[k_] = *(const u32x4*)(U + ru_); } \
            _Pragma("unroll") for (int k_ = 0; k_ < 2; ++k_) tqk[k_] = *(const u32x4*)(Z + (mb_ + qrow + 32 * k_) * ZLD_E + 768 + 1536 + h * 128 + qc8); } while (0)
#define GDN_STORE_TILES() do { _Pragma("unroll") for (int k_ = 0; k_ < 4; ++k_) { const int row_ = prow + 16 * k_; *(LAS u32x4*)(QD + row_ * 136 + pc8) = tq[k_]; *(LAS u32x4*)(WNs + row_ * 136 + pc8) = tw[k_]; *(LAS u32x4*)(UT + row_ * 136 + pc8) = tu[k_]; \
            { const int vi_ = pt_ + 256 * k_; *(LAS u32x4*)(KDT + (vi_ >> 3) * 72 + (vi_ & 7) * 8) = tk[k_]; } } \
            _Pragma("unroll") for (int k_ = 0; k_ < 2; ++k_) *(LAS u32x4*)(QK + (qrow + 32 * k_) * 72 + qc8) = tqk[k_]; } while (0)
#define GDN_STORE_O(nn) do { const LAS bf16_t* ob_ = OTb + ((nn) & 1) * 4608; _Pragma("unroll") for (int k_ = 0; k_ < 2; ++k_) { const int vi_ = pt_ + 256 * k_, row_ = vi_ >> 3, c8_ = (vi_ & 7) * 8; \
            *(u32x4*)(Y + (size_t)(b * T_ + 64 * (nn) + row_) * D_ + 256 + h * 128 + 64 * dvh + c8_) = *(const LAS u32x4*)(ob_ + row_ * 72 + c8_); } } while (0)
        if (producer) {
            int pt_ = ptid; asm volatile("" : "+v"(pt_));
            u32x4 tq[4], tk[4], tw[4], tu[4], tqk[2];
            const int prow = pt_ >> 4, pc8 = (pt_ & 15) * 8;
            const int qrow = pt_ >> 3, qc8 = (pt_ & 7) * 8;
            GDN_LOAD_TILES(0); GDN_STORE_TILES();
            for (int n = 0; n < 128; ++n) {
                LDS_BARRIER();
                if (n + 1 < 128) GDN_LOAD_TILES(n + 1);
                if (n >= 1) GDN_STORE_O(n - 1);
                LDS_BARRIER();
                if (n + 1 < 128) GDN_STORE_TILES();
            }
            LDS_BARRIER();
            GDN_STORE_O(127);
        } else {
            f32x16 S[4];
#pragma unroll
            for (int i = 0; i < 4; ++i) S[i] = (f32x16){};
            float gtn = GC[(size_t)bh * 128];
            for (int n = 0; n < 128; ++n) {
                LDS_BARRIER();
                if (c.wave < 2) {
                const float gt = gtn; if (n + 1 < 128) gtn = GC[(size_t)bh * 128 + n + 1];
                f32x16 av[2];
#pragma unroll
                for (int tc = 0; tc < 2; ++tc)
#pragma unroll
                    for (int r = 0; r < 16; ++r) av[tc][r] = bf2f(UT[(32 * tc + crow(r, hh)) * 136 + e0 + l31]);
                f32x16 ao[2] = {(f32x16){}, (f32x16){}};
                bf16x8 fa[8], fb[8];
#define GDN_LDF_WQ(F, td_) do { _Pragma("unroll") for (int tc = 0; tc < 2; ++tc) _Pragma("unroll") for (int s_ = 0; s_ < 2; ++s_) { const int ko_ = 32 * (td_) + 16 * s_ + 4 * hh; \
                    F[tc * 2 + s_] = ldA_perm(WNs + (32 * tc + l31) * 136 + ko_); F[4 + tc * 2 + s_] = ldA_perm(QD + (32 * tc + l31) * 136 + ko_); } } while (0)
#define GDN_MMA_WQ(F, td_) do { const bf16x8 sb0_ = pkfrag(S[td_], 0), sb1_ = pkfrag(S[td_], 1); \
                    av[0] = __builtin_amdgcn_mfma_f32_32x32x16_bf16(F[0], sb0_, av[0], 0, 0, 0); ao[0] = __builtin_amdgcn_mfma_f32_32x32x16_bf16(F[4], sb0_, ao[0], 0, 0, 0); \
                    av[1] = __builtin_amdgcn_mfma_f32_32x32x16_bf16(F[2], sb0_, av[1], 0, 0, 0); ao[1] = __builtin_amdgcn_mfma_f32_32x32x16_bf16(F[6], sb0_, ao[1], 0, 0, 0); \
                    av[0] = __builtin_amdgcn_mfma_f32_32x32x16_bf16(F[1], sb1_, av[0], 0, 0, 0); ao[0] = __builtin_amdgcn_mfma_f32_32x32x16_bf16(F[5], sb1_, ao[0], 0, 0, 0); \
                    av[1] = __builtin_amdgcn_mfma_f32_32x32x16_bf16(F[3], sb1_, av[1], 0, 0, 0); ao[1] = __builtin_amdgcn_mfma_f32_32x32x16_bf16(F[7], sb1_, ao[1], 0, 0, 0); } while (0)
                GDN_LDF_WQ(fa, 0);
                GDN_LDF_WQ(fb, 1); GDN_MMA_WQ(fa, 0);
                GDN_LDF_WQ(fa, 2); GDN_MMA_WQ(fb, 1);
                GDN_LDF_WQ(fb, 3); GDN_MMA_WQ(fa, 2);
#pragma unroll
                for (int tc = 0; tc < 2; ++tc)
#pragma unroll
                    for (int ts = 0; ts < 2; ++ts)
#pragma unroll
                        for (int s_ = 0; s_ < 2; ++s_) fa[tc * 4 + ts * 2 + s_] = ldA_perm(QK + (32 * tc + l31) * 72 + 32 * ts + 16 * s_ + 4 * hh);
                GDN_MMA_WQ(fb, 3);
#undef GDN_LDF_WQ
#undef GDN_MMA_WQ
                bf16x8 Vb[2][2];
#pragma unroll
                for (int tc = 0; tc < 2; ++tc) { Vb[tc][0] = pkfrag(av[tc], 0); Vb[tc][1] = pkfrag(av[tc], 1); }
#define GDN_LDF_K(F, tdp_) do { _Pragma("unroll") for (int t2_ = 0; t2_ < 2; ++t2_) _Pragma("unroll") for (int tc = 0; tc < 2; ++tc) _Pragma("unroll") for (int s_ = 0; s_ < 2; ++s_) \
                    F[t2_ * 4 + tc * 2 + s_] = ldA_perm(KDT + (32 * (2 * (tdp_) + t2_) + l31) * 72 + 32 * tc + 16 * s_ + 4 * hh); } while (0)
#define GDN_MMA_K(F, tdp_) do { S[2 * (tdp_)] = S[2 * (tdp_)] * gt; S[2 * (tdp_) + 1] = S[2 * (tdp_) + 1] * gt; \
                    _Pragma("unroll") for (int tc = 0; tc < 2; ++tc) _Pragma("unroll") for (int s_ = 0; s_ < 2; ++s_) _Pragma("unroll") for (int t2_ = 0; t2_ < 2; ++t2_) \
                        S[2 * (tdp_) + t2_] = __builtin_amdgcn_mfma_f32_32x32x16_bf16(F[t2_ * 4 + tc * 2 + s_], Vb[tc][s_], S[2 * (tdp_) + t2_], 0, 0, 0); } while (0)
                GDN_LDF_K(fb, 0);
#pragma unroll
                for (int ts = 0; ts < 2; ++ts)
#pragma unroll
                    for (int s_ = 0; s_ < 2; ++s_)
#pragma unroll
                        for (int tc = 0; tc < 2; ++tc) ao[tc] = __builtin_amdgcn_mfma_f32_32x32x16_bf16(fa[tc * 4 + ts * 2 + s_], Vb[ts][s_], ao[tc], 0, 0, 0);
                GDN_LDF_K(fa, 1); GDN_MMA_K(fb, 0);
                GDN_MMA_K(fa, 1);
#undef GDN_LDF_K
#undef GDN_MMA_K
                LAS bf16_t* ob = OTb + (n & 1) * 4608;
#pragma unroll
                for (int tc = 0; tc < 2; ++tc)
#pragma unroll
                    for (int r = 0; r < 16; ++r) ob[(32 * tc + crow(r, hh)) * 72 + 32 * (c.wave & 1) + l31] = f2bf(ao[tc][r]);
                }
                LDS_BARRIER();
            }
            LDS_BARRIER();
        }
        __syncthreads();
#undef GDN_LOAD_TILES
#undef GDN_STORE_TILES
#undef GDN_STORE_O
    }
}
__device__ __forceinline__ void gdn_post(const Ctx& c, const Params& p, int e) {
    const bf16_t* Z = (const bf16_t*)(c.ws + WS_Z); bf16_t* Y = (bf16_t*)(c.ws + WS_AB); const float* onorm = p.in[c.zo + 11] + (size_t)e * 128;
    const int NT = c.G * 512, total = M_ * 24;
    for (int it = c.bid * 512 + c.tid; it < total; it += NT) { const int part = it & 3, h = (it >> 2) % 6, m = (it >> 2) / 6;
        bf16_t* yo = Y + (size_t)m * D_ + 256 + h * 128 + 32 * part; const bf16_t* zg = Z + (size_t)m * ZLD_E + 3072 + h * 128 + 32 * part; const float* on = onorm + 32 * part;
        float ov[32]; float ss = 0.f;
#pragma unroll
        for (int k = 0; k < 4; ++k) unpack8(*(const u32x4*)(yo + 8 * k), ov + 8 * k);
#pragma unroll
        for (int k = 0; k < 32; ++k) ss += ov[k] * ov[k];
        ss += __shfl_xor(ss, 1); ss += __shfl_xor(ss, 2);
        const float rn = rsqrtf(ss * (1.f / 128.f) + 1e-6f);
#pragma unroll
        for (int k = 0; k < 4; ++k) { float gz[8], out[8]; unpack8(*(const u32x4*)(zg + 8 * k), gz);
#pragma unroll
            for (int i = 0; i < 8; ++i) out[i] = ov[8 * k + i] * rn * on[8 * k + i] * siluf_(gz[i]);
            *(u32x4*)(yo + 8 * k) = pack8(out); } }
}

__device__ __forceinline__ float lerp_prev(const bf16_t* zp, int ld, int t, float mu) { const float z = bf2f(zp[0]); const float zq = (t > 0) ? bf2f(*(zp - ld)) : 0.f; return z + mu * (zq - z); }

__device__ __forceinline__ void odd_prep_a(const Ctx& c, const Params& p, int o) {
    const bf16_t* Z2 = (const bf16_t*)(c.ws + WS_Z2); bf16_t* LA = (bf16_t*)(c.ws + WS_LA); bf16_t* KR = (bf16_t*)(c.ws + WS_KR); float* RS = (float*)(c.ws + WS_RS);
    const float* mu = p.in[c.zo + 14] + (size_t)o * 1792; const float* vmu = o ? p.in[c.zo + 26] + (size_t)(o - 1) * 32 : p.in[c.zo + 26];
    if (c.bid == 0 && c.tid == 0) { unsigned* ctl = (unsigned*)(c.ws + WS_CTL); ctl[64 * o] = 0u; ctl[64 * o + 16] = 0u; }
    const int grp = c.lane; const int kind = grp < 8 ? 0 : grp < 16 ? 1 : grp < 32 ? 2 : grp < 36 ? 3 : 4;
    const int zc = (kind < 3) ? 8 * grp : 1056 + 8 * (grp - 32);
    float mv[8];
#pragma unroll
    for (int i = 0; i < 8; ++i) mv[i] = (kind < 3) ? mu[1536 + 8 * grp + i] : (kind == 3 ? vmu[8 * (grp - 32) + i] : 0.f);
    for (int m = c.gw; m < M_; m += c.ngw) { const int t = m & (T_ - 1); const bf16_t* zr = Z2 + (size_t)m * Z2_LD;
        if (grp < 48) { float out[8];
#pragma unroll
            for (int i = 0; i < 8; ++i) out[i] = 0.f;
            if (kind < 3 || (kind == 3 && o > 0)) { float cu[8], pv[8]; unpack8(*(const u32x4*)(zr + zc), cu);
                if (t > 0) unpack8(*(const u32x4*)(zr + zc - Z2_LD), pv); else {
#pragma unroll
                    for (int i = 0; i < 8; ++i) pv[i] = 0.f; }
#pragma unroll
                for (int i = 0; i < 8; ++i) { const float x = cu[i] + mv[i] * (pv[i] - cu[i]); out[i] = (kind == 0) ? tanhf(x) : (kind == 2 ? sigmoidf_(x) : x); } }
            *(u32x4*)(LA + (size_t)m * 384 + 8 * grp) = pack8(out); }
        if (c.lane < 32) KR[(size_t)m * 32 + c.lane] = zr[1024 + c.lane];
        float f[8]; unpack8(*(const u32x4*)(zr + 256 + 8 * c.lane), f); float s1 = 0.f;
#pragma unroll
        for (int i = 0; i < 8; ++i) s1 += f[i] * f[i];
        const u32x2 kvv = *(const u32x2*)(zr + 768 + 4 * c.lane);
        const float k0 = asf(kvv.x << 16), k1 = asf(kvv.x & 0xffff0000u), k2 = asf(kvv.y << 16), k3 = asf(kvv.y & 0xffff0000u);
        float s2 = (k0 * k0 + k1 * k1) + (k2 * k2 + k3 * k3);
        s1 = wave_sum_dpp(s1); s2 = wave_sum_dpp(s2);
        if (c.lane == 0) { RS[2 * m] = rsqrtf(s1 * (1.f / 512.f) + 1e-6f); RS[2 * m + 1] = rsqrtf(s2 * (1.f / 256.f) + 1e-6f); } }
}

__device__ __forceinline__ void rwkv_bnd_copy(const Ctx& c, const Params& p) {
    const bf16_t* RKV = (const bf16_t*)(c.ws + WS_RKV); bf16_t* BND = (bf16_t*)(c.ws + WS_BND);
    const int NT = c.G * 512, total = 1024 * 192;
    for (int it = c.bid * 512 + c.tid; it < total; it += NT) { const int rg = it / 192, c8 = (it % 192) * 8;
        if ((rg & 255) == 0) continue;
        *(u32x4*)(BND + (size_t)rg * 1536 + c8) = *(const u32x4*)(RKV + (size_t)(32 * rg - 1) * RKV_LD + c8); }
}
__device__ __forceinline__ void unpack4(u32x2 v, float* f) { f[0] = asf(v.x << 16); f[1] = asf(v.x & 0xffff0000u); f[2] = asf(v.y << 16); f[3] = asf(v.y & 0xffff0000u); }
__device__ __forceinline__ u32x2 pack4(const float* f) { u32x2 o; o.x = pk2(f[0], f[1]); o.y = pk2(f[2], f[3]); return o; }
__device__ __forceinline__ void rwkv_prep(const Ctx& c, const Params& p, int o) {
    bf16_t* RKV = (bf16_t*)(c.ws + WS_RKV); bf16_t* LO = (bf16_t*)(c.ws + WS_LO); bf16_t* VF = (bf16_t*)(c.ws + WS_VF); bf16_t* Y = (bf16_t*)(c.ws + WS_AB);
    const bf16_t* BND = (const bf16_t*)(c.ws + WS_BND); float* BON = (float*)(c.ws + WS_LA);
    const float* mu = p.in[c.zo + 14] + (size_t)o * 1792; const float* w0 = p.in[c.zo + 15] + (size_t)o * 512; const float* a0 = p.in[c.zo + 17] + (size_t)o * 512;
    const float* k_k = p.in[c.zo + 20] + (size_t)o * 512; const float* k_a = p.in[c.zo + 21] + (size_t)o * 512; const float* r_k = p.in[c.zo + 22] + (size_t)o * 512;
    const float* v0p = o ? p.in[c.zo + 27] + (size_t)(o - 1) * 512 : p.in[c.zo + 27];
    for (int item = c.gw; item < 2048; item += c.ngw) { const int rg = item >> 1, hf = item & 1, m0 = 32 * rg; const bool seq0 = (rg & 255) == 0;
        int ln_ = c.lane; asm volatile("" : "+v"(ln_));
        const int h = 4 * hf + (ln_ >> 4), c4 = h * 64 + 4 * (ln_ & 15);
        const f32x4 mur = *(const f32x4*)(mu + c4), muk = *(const f32x4*)(mu + 512 + c4), muv = *(const f32x4*)(mu + 1024 + c4), w0c = *(const f32x4*)(w0 + c4), a0c = *(const f32x4*)(a0 + c4);
        const f32x4 kkc = *(const f32x4*)(k_k + c4), kac = *(const f32x4*)(k_a + c4), v0c = *(const f32x4*)(v0p + c4), rkc = *(const f32x4*)(r_k + c4);
        u32x2 cr, ck, cv, pr, pk, pv, wl, al, vl = {}, vf = {};
        { const bf16_t* zr = RKV + (size_t)(m0 + 31) * RKV_LD + c4; cr = *(const u32x2*)zr; ck = *(const u32x2*)(zr + 512); cv = *(const u32x2*)(zr + 1024);
          const bf16_t* zq = zr - RKV_LD; pr = *(const u32x2*)zq; pk = *(const u32x2*)(zq + 512); pv = *(const u32x2*)(zq + 1024);
          const bf16_t* lo = LO + (size_t)(m0 + 31) * 2048 + c4; wl = *(const u32x2*)lo; al = *(const u32x2*)(lo + 512); if (o) { vl = *(const u32x2*)(lo + 1536); vf = *(const u32x2*)(VF + (size_t)(m0 + 31) * 512 + c4); } }
#pragma unroll 2
        for (int tt = 31; tt >= 0; --tt) { const int m = m0 + tt;
            u32x2 qr = {}, qk = {}, qv = {}, nwl = {}, nal = {}, nvl = {}, nvf = {};
            if (tt >= 2) { const bf16_t* zq = RKV + (size_t)(m - 2) * RKV_LD + c4; qr = *(const u32x2*)zq; qk = *(const u32x2*)(zq + 512); qv = *(const u32x2*)(zq + 1024); }
            else if (tt == 1 && !seq0) { const bf16_t* zq = BND + (size_t)rg * 1536 + c4; qr = *(const u32x2*)zq; qk = *(const u32x2*)(zq + 512); qv = *(const u32x2*)(zq + 1024); }
            if (tt >= 1) { const bf16_t* ln = LO + (size_t)(m - 1) * 2048 + c4; nwl = *(const u32x2*)ln; nal = *(const u32x2*)(ln + 512); if (o) { nvl = *(const u32x2*)(ln + 1536); nvf = *(const u32x2*)(VF + (size_t)(m - 1) * 512 + c4); } }
            const bool has_prev = (tt > 0) || !seq0;
            float fcr[4], fck[4], fcv[4], fpr[4], fpk[4], fpv[4], fwl[4], fal[4], fvl[4], fvf[4];
            unpack4(cr, fcr); unpack4(ck, fck); unpack4(cv, fcv); unpack4(pr, fpr); unpack4(pk, fpk); unpack4(pv, fpv); unpack4(wl, fwl); unpack4(al, fal); unpack4(vl, fvl); unpack4(vf, fvf);
            float r_[4], kx_[4], v_[4], ew_[4], ka_[4], kq_[4], a_[4]; float ss = 0.f, bs = 0.f;
#pragma unroll
            for (int j = 0; j < 4; ++j) { const float xr = has_prev ? fpr[j] : 0.f, xk = has_prev ? fpk[j] : 0.f, xv = has_prev ? fpv[j] : 0.f;
                r_[j] = fcr[j] + mur[j] * (xr - fcr[j]); const float kr = fck[j] + muk[j] * (xk - fck[j]); float v = fcv[j] + muv[j] * (xv - fcv[j]);
                const float wlog = -softplusf_(-(w0c[j] + fwl[j])) - 0.5f; ew_[j] = __expf(wlog);
                a_[j] = sigmoidf_(a0c[j] + fal[j]);
                kq_[j] = kr * kkc[j]; ss += kq_[j] * kq_[j];
                kx_[j] = kr * (1.f + (a_[j] - 1.f) * kac[j]);
                if (o) v = v + (fvf[j] - v) * sigmoidf_(v0c[j] + fvl[j]);
                v_[j] = v; bs += r_[j] * kx_[j] * rkc[j]; }
            ss = sum16_dpp(ss); bs = sum16_dpp(bs);
            const float rn = rsqrtf(ss + 1e-6f); float kk_[4];
#pragma unroll
            for (int j = 0; j < 4; ++j) { kk_[j] = kq_[j] * rn; ka_[j] = kk_[j] * a_[j]; }
            if (o == 0) *(u32x2*)(VF + (size_t)m * 512 + c4) = pack4(v_);
            bf16_t* zr = RKV + (size_t)m * RKV_LD + c4; *(u32x2*)zr = pack4(r_); *(u32x2*)(zr + 512) = pack4(kx_); *(u32x2*)(zr + 1024) = pack4(v_);
            bf16_t* lo = LO + (size_t)m * 2048 + c4; *(u32x2*)lo = pack4(ew_); *(u32x2*)(lo + 512) = pack4(ka_); *(u32x2*)(Y + (size_t)m * D_ + c4) = pack4(kk_);
            if ((ln_ & 15) == 0) BON[(size_t)m * 8 + h] = bs;
            cr = pr; ck = pk; cv = pv; pr = qr; pk = qk; pv = qv; wl = nwl; al = nal; vl = nvl; vf = nvf; } }
}
struct RwkvRegs { unsigned short vr[8], vx[8], vv[8], ve[8], va[8], vk[8]; };
__device__ __forceinline__ void rwkv_load_chunk(RwkvRegs& R, int n, int pw, int b, int col, const bf16_t* RKV, const bf16_t* LO, const bf16_t* Y) {
#pragma unroll
    for (int i = 0; i < 8; ++i) { const int tt = pw + 4 * i, m = b * T_ + 32 * n + tt; const bf16_t* zr = RKV + (size_t)m * RKV_LD; const bf16_t* lo = LO + (size_t)m * 2048;
        R.vr[i] = zr[col]; R.vx[i] = zr[512 + col]; R.vv[i] = zr[1024 + col]; R.ve[i] = lo[col]; R.va[i] = lo[512 + col]; R.vk[i] = Y[(size_t)m * D_ + col]; }
}
__device__ __forceinline__ void rwkv_write_chunk(LAS float* L, const RwkvRegs& R, int n, int pw, int lane) {
    LAS float* st = L + (n & 1) * 12288;
#pragma unroll
    for (int i = 0; i < 8; ++i) { const int tt = pw + 4 * i; LAS float* q = st + tt * 64 + lane;
        q[0] = bf2f(R.vr[i]); q[2048] = __expf(-bf2f(R.ve[i])); q[4096] = bf2f(R.vx[i]); q[6144] = bf2f(R.vk[i]); q[8192] = bf2f(R.va[i]); q[10240] = bf2f(R.vv[i]); }
}
__device__ __forceinline__ void rwkv_store_chunk(const LAS float* L, int n, int pw, int lane, int b, int col, bf16_t* YR, int half) {
    const LAS float* sY = L + 24576 + (n & 1) * 2048;
#pragma unroll
    for (int i = 0; i < 8; ++i) { const int tt = pw + 4 * i, m = b * T_ + 32 * n + tt; if ((lane >> 4) == half) YR[(size_t)m * 2048 + 1536 + col] = f2bf(sY[tt * 64 + lane]); }
}
__device__ __forceinline__ void rwkv_scan(const Ctx& c, const Params& p, int o, int nblk) {
    const bf16_t* RKV = (const bf16_t*)(c.ws + WS_RKV); const bf16_t* LO = (const bf16_t*)(c.ws + WS_LO); bf16_t* Y = (bf16_t*)(c.ws + WS_AB);
    LAS float* L = (LAS float*)(c.lds);
    const bool producer = c.wave >= 4;
    for (int item = c.bid; item < 128; item += nblk) {
        const int bh = item >> 2, half = item & 3, b = bh >> 3, h = bh & 7; const int col = h * 64 + c.lane;
        if (producer) {
            const int pw = c.wave - 4;
            RwkvRegs R;
            rwkv_load_chunk(R, 0, pw, b, col, RKV, LO, Y); rwkv_write_chunk(L, R, 0, pw, c.lane);
            rwkv_load_chunk(R, 1, pw, b, col, RKV, LO, Y);
            for (int n = 0; n < 256; ++n) {
                LDS_BARRIER();
                if (n + 1 < 256) rwkv_write_chunk(L, R, n + 1, pw, c.lane);
                if (n + 2 < 256) rwkv_load_chunk(R, n + 2, pw, b, col, RKV, LO, Y);
                if (n >= 1) rwkv_store_chunk(L, n - 1, pw, c.lane, b, col, (bf16_t*)LO, half);
            }
            LDS_BARRIER();
            rwkv_store_chunk(L, 255, pw, c.lane, b, col, (bf16_t*)LO, half);
        } else {
            f32x2 s2[2];
            s2[0] = (f32x2){0.f, 0.f}; s2[1] = (f32x2){0.f, 0.f};
            const int row = 16 * half + 4 * c.wave + (c.lane >> 4), kq = c.lane & 15;
            for (int n = 0; n < 256; ++n) {
                LDS_BARRIER();
                const LAS float* st = L + (n & 1) * 12288 + 4 * kq; const LAS float* sV = L + (n & 1) * 12288 + 10240 + row; LAS float* sY = L + 24576 + (n & 1) * 2048 + row;
                float yreg[32];
#pragma unroll
                for (int tt = 0; tt < 32; ++tt) { const LAS float* q4 = st + tt * 64;
                    const f32x4 rr = *(const LAS f32x4*)(q4), wd = *(const LAS f32x4*)(q4 + 2048), kx = *(const LAS f32x4*)(q4 + 4096), kk = *(const LAS f32x4*)(q4 + 6144), ka = *(const LAS f32x4*)(q4 + 8192);
                    const float vv = sV[tt * 64];
#define P2(v4, i) ((f32x2){v4[2 * (i)], v4[2 * (i) + 1]})
                    const f32x2 pa = s2[0] * P2(kk, 0) + s2[1] * P2(kk, 1);
                    float px_ = sum16_dpp(pa.x + pa.y); asm volatile("" : "+v"(px_)); const float sa = -px_;
                    s2[0] = s2[0] * P2(wd, 0) + (P2(ka, 0) * sa + P2(kx, 0) * vv); s2[1] = s2[1] * P2(wd, 1) + (P2(ka, 1) * sa + P2(kx, 1) * vv);
                    const f32x2 ya = s2[0] * P2(rr, 0) + s2[1] * P2(rr, 1);
#undef P2
                    float yx_ = sum16_dpp(ya.x + ya.y); asm volatile("" : "+v"(yx_));
                    yreg[tt] = yx_; }
                if (kq == 0) {
#pragma unroll
                    for (int tt = 0; tt < 32; ++tt) sY[tt * 64] = yreg[tt]; }
            }
            LDS_BARRIER();
        }
        LDS_BARRIER();
    }
}
__device__ __forceinline__ void rwkv_post(const Ctx& c, const Params& p, int o) {
    const bf16_t* RKV = (const bf16_t*)(c.ws + WS_RKV); const bf16_t* LO = (const bf16_t*)(c.ws + WS_LO); bf16_t* Y = (bf16_t*)(c.ws + WS_AB);
    const float* lnw = p.in[c.zo + 23] + (size_t)o * 512; const float* lnb = p.in[c.zo + 24] + (size_t)o * 512; const float* BON = (const float*)(c.ws + WS_LA);
    const int h = c.lane >> 3, c8 = h * 64 + 8 * (c.lane & 7);
    float lw[8], lb[8];
#pragma unroll
    for (int i = 0; i < 8; ++i) { lw[i] = lnw[c8 + i]; lb[i] = lnb[c8 + i]; }
    for (int m = c.gw; m < M_; m += c.ngw) { const bf16_t* lo = LO + (size_t)m * 2048;
        float y[8], v[8], g[8]; unpack8(*(const u32x4*)(lo + 1536 + c8), y); unpack8(*(const u32x4*)(RKV + (size_t)m * RKV_LD + 1024 + c8), v); unpack8(*(const u32x4*)(lo + 1024 + c8), g);
        const float bon = BON[(size_t)m * 8 + h];
        float s1 = 0.f;
#pragma unroll
        for (int i = 0; i < 8; ++i) s1 += y[i];
        const float mean = sum8_dpp(s1) * (1.f / 64.f); float s2 = 0.f;
#pragma unroll
        for (int i = 0; i < 8; ++i) { y[i] -= mean; s2 += y[i] * y[i]; }
        const float rs = rsqrtf(sum8_dpp(s2) * (1.f / 64.f) + 64e-5f); float out[8];
#pragma unroll
        for (int i = 0; i < 8; ++i) out[i] = (y[i] * rs * lw[i] + lb[i] + bon * v[i]) * g[i];
        *(u32x4*)(Y + (size_t)m * D_ + c8) = pack8(out); }
}

__device__ __forceinline__ void mla_prep(const Ctx& c, const Params& p, int o) {
    bf16_t* QR = (bf16_t*)(c.ws + WS_QR); const bf16_t* KVR = (const bf16_t*)(c.ws + WS_KVR); const bf16_t* KR = (const bf16_t*)(c.ws + WS_KR); const float* RS = (const float*)(c.ws + WS_RS);
    bf16_t* KH = (bf16_t*)(c.ws + WS_KH); bf16_t* VT = (bf16_t*)(c.ws + WS_VT);
    const float* qln = p.in[c.zo + 33] + (size_t)o * 96; const float* kln = p.in[c.zo + 34] + (size_t)o * 96; const int* pos = (const int*)p.in[c.zo + 1];
    LAS bf16_t* sVT = (LAS bf16_t*)c.lds;
    const int head = c.lane >> 3, sub = c.lane & 7;
    float gqn[8], gkn[8], gq1[2], gq2[2], gk1[2], gk2[2];
#pragma unroll
    for (int i = 0; i < 8; ++i) { gqn[i] = qln[8 * sub + i]; gkn[i] = kln[8 * sub + i]; }
#pragma unroll
    for (int j = 0; j < 2; ++j) { gq1[j] = qln[64 + 2 * sub + j]; gq2[j] = qln[80 + 2 * sub + j]; gk1[j] = kln[64 + 2 * sub + j]; gk2[j] = kln[80 + 2 * sub + j]; }
    const float QSCALE = 0.10206207261596577f * 1.4426950408889634f;
    const float invf = exp2f(-(float)(2 * (c.lane & 15)) * (13.287712379549449f / 32.f));
    for (int tile = c.bid; tile < 512; tile += c.G) { const int m0 = tile * 64;
#pragma unroll 2
        for (int q = 0; q < 8; ++q) { const int tt = c.wave * 8 + q, m = m0 + tt; const float rsq = RS[2 * m], rskv = RS[2 * m + 1];
            float sn_, cs_; sincosf((float)pos[m] * invf, &sn_, &cs_);
            float cs[2], sn[2];
#pragma unroll
            for (int j = 0; j < 2; ++j) { cs[j] = __shfl(cs_, 2 * sub + j); sn[j] = __shfl(sn_, 2 * sub + j); }
            { bf16_t* qp = QR + (size_t)m * 768 + head * 96; float v[8]; unpack8(*(const u32x4*)(qp + 8 * sub), v);
              const unsigned r1 = *(const unsigned*)(qp + 64 + 2 * sub), r2 = *(const unsigned*)(qp + 80 + 2 * sub);
              float x1[2] = {asf(r1 << 16) * rsq, asf(r1 & 0xffff0000u) * rsq}, x2[2] = {asf(r2 << 16) * rsq, asf(r2 & 0xffff0000u) * rsq};
              float ss = x1[0] * x1[0] + x1[1] * x1[1] + x2[0] * x2[0] + x2[1] * x2[1];
#pragma unroll
              for (int i = 0; i < 8; ++i) { v[i] *= rsq; ss += v[i] * v[i]; }
              const float rn = rsqrtf(sum8_dpp(ss) * (1.f / 96.f) + 1e-6f) ;
#pragma unroll
              for (int i = 0; i < 8; ++i) v[i] = v[i] * rn * gqn[i] * QSCALE;
              float o1[2], o2[2];
#pragma unroll
              for (int j = 0; j < 2; ++j) { const float a = x1[j] * rn * gq1[j], bq = x2[j] * rn * gq2[j]; o1[j] = (a * cs[j] - bq * sn[j]) * QSCALE; o2[j] = (bq * cs[j] + a * sn[j]) * QSCALE; }
              *(u32x4*)(qp + 8 * sub) = pack8(v); *(unsigned*)(qp + 64 + 2 * sub) = pk2(o1[0], o1[1]); *(unsigned*)(qp + 80 + 2 * sub) = pk2(o2[0], o2[1]); }
            { const bf16_t* kp = KVR + (size_t)m * 1024 + head * 128; float v[8]; unpack8(*(const u32x4*)(kp + 8 * sub), v);
              const unsigned r1 = *(const unsigned*)(KR + (size_t)m * 32 + 2 * sub), r2 = *(const unsigned*)(KR + (size_t)m * 32 + 16 + 2 * sub);
              float x1[2] = {asf(r1 << 16), asf(r1 & 0xffff0000u)}, x2[2] = {asf(r2 << 16), asf(r2 & 0xffff0000u)};
              float ss = x1[0] * x1[0] + x1[1] * x1[1] + x2[0] * x2[0] + x2[1] * x2[1];
#pragma unroll
              for (int i = 0; i < 8; ++i) { v[i] *= rskv; ss += v[i] * v[i]; }
              const float rn = rsqrtf(sum8_dpp(ss) * (1.f / 96.f) + 1e-6f);
#pragma unroll
              for (int i = 0; i < 8; ++i) v[i] = v[i] * rn * gkn[i];
              float o1[2], o2[2];
#pragma unroll
              for (int j = 0; j < 2; ++j) { const float a = x1[j] * rn * gk1[j], bq = x2[j] * rn * gk2[j]; o1[j] = a * cs[j] - bq * sn[j]; o2[j] = bq * cs[j] + a * sn[j]; }
              bf16_t* ko = KH + (size_t)m * 768 + head * 96;
              *(u32x4*)(ko + 8 * sub) = pack8(v); *(unsigned*)(ko + 64 + 2 * sub) = pk2(o1[0], o1[1]); *(unsigned*)(ko + 80 + 2 * sub) = pk2(o2[0], o2[1]);
              float vv[8]; unpack8(*(const u32x4*)(kp + 64 + 8 * sub), vv);
#pragma unroll
              for (int i = 0; i < 8; ++i) sVT[(head * 64 + 8 * sub + i) * 72 + tt] = f2bf(vv[i] * rskv); } }
        __syncthreads();
        { const int row = c.tid; const int b = m0 / T_, t0 = m0 & (T_ - 1); bf16_t* dst = VT + ((size_t)(b * 8) * 64 + row) * T_ + t0;
#pragma unroll
          for (int i = 0; i < 8; ++i) *(u32x4*)(dst + 8 * i) = *(const LAS u32x4*)(sVT + row * 72 + 8 * i); }
        __syncthreads();
    }
}

__device__ __forceinline__ void attn_phase(const Ctx& c, const Params& p, int o, int first, int cidx) {
    const bf16_t* QH = (const bf16_t*)(c.ws + WS_QR); const bf16_t* KH = (const bf16_t*)(c.ws + WS_KH); const bf16_t* VT = (const bf16_t*)(c.ws + WS_VT); bf16_t* Y = (bf16_t*)(c.ws + WS_AB);
    const int l31 = c.lane & 31, hh = c.lane >> 5;
    if (c.bid < first) return;
    unsigned* cnt = (unsigned*)(c.ws + WS_CTL) + 64 * o + 16 * cidx;
    LAS bf16_t* sK = (LAS bf16_t*)(c.lds);
    LAS bf16_t* sVt = (LAS bf16_t*)(c.lds + 26624);
    LAS unsigned* sU = (LAS unsigned*)(c.lds + 26624 + 18432);
    const int k0row = c.tid / 12, k0ch = c.tid % 12; const int k1p = c.tid + 512, k1row = k1p / 12, k1ch = k1p % 12; const bool k1on = c.tid < 256;
    const int vrow = c.tid >> 3, vch = c.tid & 7;
    for (;;) {
        if (c.tid == 0) sU[0] = atomicAdd(cnt, 1u);
        __syncthreads();
        const unsigned uu = sU[0];
        __syncthreads();
        if (uu >= 1024u) break;
        const int bh = uu & 31, b = bh >> 3, h = bh & 7; const int qblk = 31 - (int)(uu >> 5); const int q0 = qblk * 256, qs = q0 + 32 * c.wave;
        bf16x8 qf[6]; { const bf16_t* qp = QH + (size_t)(b * T_ + qs + l31) * 768 + h * 96 + 8 * hh;
#pragma unroll
            for (int ks = 0; ks < 6; ++ks) qf[ks] = *(const bf16x8*)(qp + 16 * ks); }
        f32x16 o0 = {}, o1 = {}; float mrun = -INFINITY, lrun = 0.f;
        const int ntile = 4 * (qblk + 1);
        const bf16_t* kg = KH + (size_t)(b * T_) * 768 + h * 96; const bf16_t* vg = VT + (size_t)bh * 64 * T_;
        u32x4 rk0, rk1 = {}, rv;
        rk0 = *(const u32x4*)(kg + (size_t)k0row * 768 + 8 * k0ch); if (k1on) rk1 = *(const u32x4*)(kg + (size_t)k1row * 768 + 8 * k1ch); rv = *(const u32x4*)(vg + (size_t)vrow * T_ + 8 * vch);
        *(LAS u32x4*)(sK + k0row * 104 + 8 * k0ch) = rk0; if (k1on) *(LAS u32x4*)(sK + k1row * 104 + 8 * k1ch) = rk1; *(LAS u32x4*)(sVt + vrow * 72 + 8 * vch) = rv;
        __syncthreads();
        for (int kt = 0; kt < ntile; ++kt) { const int kv0 = kt * 64; const int buf = kt & 1;
            if (kt + 1 < ntile) { const int kn = kv0 + 64;
                rk0 = *(const u32x4*)(kg + (size_t)(kn + k0row) * 768 + 8 * k0ch); if (k1on) rk1 = *(const u32x4*)(kg + (size_t)(kn + k1row) * 768 + 8 * k1ch); rv = *(const u32x4*)(vg + (size_t)vrow * T_ + kn + 8 * vch); }
            if (kv0 <= qs + 31) {
                const LAS bf16_t* kb = sK + buf * 6656 + l31 * 104 + 8 * hh; const LAS bf16_t* vb = sVt + buf * 4608 + l31 * 72 + 4 * hh;
                f32x16 p0 = {}, p1 = {};
#pragma unroll
                for (int ks = 0; ks < 6; ++ks) { const bf16x8 k0 = *(const LAS bf16x8*)(kb + 16 * ks); const bf16x8 k1 = *(const LAS bf16x8*)(kb + 32 * 104 + 16 * ks);
                    p0 = __builtin_amdgcn_mfma_f32_32x32x16_bf16(k0, qf[ks], p0, 0, 0, 0); p1 = __builtin_amdgcn_mfma_f32_32x32x16_bf16(k1, qf[ks], p1, 0, 0, 0); }
                if (kv0 + 63 > qs) { const int q = qs + l31;
#pragma unroll
                    for (int r = 0; r < 16; ++r) { const int kv = kv0 + crow(r, hh); if (kv > q) p0[r] = -INFINITY; if (kv + 32 > q) p1[r] = -INFINITY; } }
                float mxa = fmaxf(fmaxf(p0[0], p1[0]), p0[1]), mxb = fmaxf(fmaxf(p1[1], p0[2]), p1[2]);
#pragma unroll
                for (int r = 3; r < 15; r += 2) { mxa = fmaxf(fmaxf(mxa, p0[r]), p1[r]); mxb = fmaxf(fmaxf(mxb, p0[r + 1]), p1[r + 1]); }
                float mx = fmaxf(fmaxf(mxa, mxb), fmaxf(p0[15], p1[15]));
                { auto rr = __builtin_amdgcn_permlane32_swap(asu(mx), asu(mx), false, false); mx = fmaxf(asf(rr[0]), asf(rr[1])); }
                const float mnew = fmaxf(mrun, mx);
                if (__any(mnew > mrun)) { const float alpha = __builtin_amdgcn_exp2f(mrun - mnew); lrun *= alpha; o0 = o0 * alpha; o1 = o1 * alpha; }
                mrun = mnew;
                f32x16 e0, e1;
#pragma unroll
                for (int r = 0; r < 16; ++r) { e0[r] = __builtin_amdgcn_exp2f(p0[r] - mnew); e1[r] = __builtin_amdgcn_exp2f(p1[r] - mnew); }
                p0 = e0; p1 = e1;
                { const f32x16 t = e0 + e1; lrun += ((t[0] + t[1]) + (t[2] + t[3])) + ((t[4] + t[5]) + (t[6] + t[7])) + ((t[8] + t[9]) + (t[10] + t[11])) + ((t[12] + t[13]) + (t[14] + t[15])); }
                const bf16x8 pf00 = pkfrag(p0, 0), pf01 = pkfrag(p0, 1), pf10 = pkfrag(p1, 0), pf11 = pkfrag(p1, 1);
#define PV_STEP(OACC, mm, ktt, ss, PF) do { OACC = __builtin_amdgcn_mfma_f32_32x32x16_bf16(ldA_perm(vb + (mm) * 32 * 72 + 32 * (ktt) + 16 * (ss)), PF, OACC, 0, 0, 0); } while (0)
                PV_STEP(o0, 0, 0, 0, pf00); PV_STEP(o0, 0, 0, 1, pf01); PV_STEP(o0, 0, 1, 0, pf10); PV_STEP(o0, 0, 1, 1, pf11);
                PV_STEP(o1, 1, 0, 0, pf00); PV_STEP(o1, 1, 0, 1, pf01); PV_STEP(o1, 1, 1, 0, pf10); PV_STEP(o1, 1, 1, 1, pf11);
#undef PV_STEP
            }
            if (kt + 1 < ntile) { const int nb = buf ^ 1;
                *(LAS u32x4*)(sK + nb * 6656 + k0row * 104 + 8 * k0ch) = rk0; if (k1on) *(LAS u32x4*)(sK + nb * 6656 + k1row * 104 + 8 * k1ch) = rk1; *(LAS u32x4*)(sVt + nb * 4608 + vrow * 72 + 8 * vch) = rv; }
            __syncthreads();
        }
        float l; { auto rr = __builtin_amdgcn_permlane32_swap(asu(lrun), asu(lrun), false, false); l = asf(rr[0]) + asf(rr[1]); }
        const float inv = 1.f / l;
        bf16_t* yo = Y + (size_t)(b * T_ + qs + l31) * D_ + 512 + h * 64;
#pragma unroll
        for (int r = 0; r < 16; ++r) { yo[crow(r, hh)] = f2bf(o0[r] * inv); yo[32 + crow(r, hh)] = f2bf(o1[r] * inv); }
    }
}

#define XB_TMO      128
#define XB_XCNT(j)  (256  + 64 * (j))
#define XB_XSUB(j)  (1280 + 64 * (j))
#define XB_XGEN(j)  (2304 + 64 * (j))
#define XB_TOP      3328
#define XB_TOPGEN   3392
#define XCD_BAR_WORDS 3456
#define XB_SPIN_CAP (1u << 22)
__device__ __forceinline__ unsigned xb_ld(unsigned* p)              { return __hip_atomic_load(p, __ATOMIC_RELAXED, __HIP_MEMORY_SCOPE_AGENT); }
__device__ __forceinline__ unsigned xb_add(unsigned* p, unsigned v) { return __hip_atomic_fetch_add(p, v, __ATOMIC_RELAXED, __HIP_MEMORY_SCOPE_AGENT); }
__device__ __forceinline__ unsigned xb_xcc_id() { return (unsigned)__builtin_amdgcn_s_getreg((3 << 11) | 20) & 0xFu; }
#define XB_SPIN(cond, bar) do { unsigned _sp = 0; while (cond) { __builtin_amdgcn_s_sleep(1); \
    if ((++_sp & 255u) == 0u) { if (xb_ld(&(bar)[XB_TMO])) break; if (_sp > XB_SPIN_CAP) { atomicAdd(&(bar)[XB_TMO], 1u); break; } } } } while (0)
struct XcdBarrier { unsigned* bar; unsigned x; volatile LAS unsigned* st; };
__device__ __forceinline__ XcdBarrier xcd_barrier_post(unsigned* bar, volatile LAS unsigned* st) {
    XcdBarrier b; b.bar = bar; b.x = xb_xcc_id(); b.st = st;
    if (threadIdx.x == 0) (void)xb_add(&bar[XB_XCNT(b.x)], 1u);
    return b;
}
__device__ __forceinline__ void xcd_barrier_complete(unsigned* bar, unsigned x, unsigned& nloc, unsigned& nx) {
    const unsigned G = gridDim.x * gridDim.y * gridDim.z;
    unsigned sum, cnt, mine, sp = 0u;
    for (;;) {
        sum = 0u; cnt = 0u; mine = 0u;
#pragma unroll
        for (unsigned j = 0; j < 16; ++j) { const unsigned c = xb_ld(&bar[XB_XCNT(j)]); sum += c; cnt += (c > 0u) ? 1u : 0u; mine = (j == x) ? c : mine; }
        if (sum == G) break;
        __builtin_amdgcn_s_sleep(1);
        if ((++sp & 255u) == 0u) { if (xb_ld(&bar[XB_TMO])) break; if (sp > XB_SPIN_CAP) { atomicAdd(&bar[XB_TMO], 1u); break; } }
    }
    nloc = mine > 0u ? mine : 1u; nx = cnt > 0u ? cnt : 1u;
}
__device__ __forceinline__ void xcd_barrier(const XcdBarrier& b, int wave_s) {
    asm volatile("s_waitcnt vmcnt(0)" ::: "memory");
    __syncthreads();
    int l0_; asm volatile("v_mbcnt_lo_u32_b32 %0, -1, 0\n\tv_mbcnt_hi_u32_b32 %0, -1, %0" : "=v"(l0_));
    if (wave_s == 0 && l0_ == 0) {
        unsigned* bar = b.bar; asm volatile("" : "+s"(bar));
        __builtin_amdgcn_s_waitcnt(0);
        unsigned nloc = b.st[0], nx = b.st[1];
        if (nloc == 0u) { xcd_barrier_complete(bar, b.x, nloc, nx); b.st[0] = nloc; b.st[1] = nx; }
        const unsigned old = xb_add(&bar[XB_XSUB(b.x)], 1u);
        const unsigned gen = old / nloc;
        if (old + 1u == (gen + 1u) * nloc) {
            __builtin_amdgcn_fence(__ATOMIC_RELEASE, "agent");
            asm volatile("s_waitcnt vmcnt(0)" ::: "memory");
            const unsigned og = xb_add(&bar[XB_TOP], 1u);
            const unsigned tg = og / nx;
            if (og + 1u == (tg + 1u) * nx) xb_add(&bar[XB_TOPGEN], 1u);
            else XB_SPIN(xb_ld(&bar[XB_TOPGEN]) == tg, bar);
            __builtin_amdgcn_fence(__ATOMIC_ACQUIRE, "agent");
            xb_add(&bar[XB_XGEN(b.x)], 1u);
            asm volatile("s_waitcnt vmcnt(0)" ::: "memory");
        } else {
            XB_SPIN(xb_ld(&bar[XB_XGEN(b.x)]) == gen, bar);
            __builtin_amdgcn_fence(__ATOMIC_ACQUIRE, "agent");
            asm volatile("s_waitcnt vmcnt(0)" ::: "memory");
        }
    }
    __syncthreads();
}

__global__ void __launch_bounds__(512, 2) fwd_kernel(Params p) {
    extern __shared__ __attribute__((aligned(16))) unsigned char lds_raw[];
    const int wave_s = __builtin_amdgcn_readfirstlane((int)threadIdx.x >> 6);
    const int only = p.only;
#if !MULTI_LAUNCH
    cg::grid_group grid = cg::this_grid();
    { volatile LAS unsigned* misc_ = (volatile LAS unsigned*)((LAS unsigned char*)lds_raw + 131072); if (threadIdx.x < 64) misc_[threadIdx.x] = 0u; }
    __syncthreads();
    (void)xcd_barrier_post((unsigned*)(p.ws + WS_CTL) + 4096, (volatile LAS unsigned*)((LAS unsigned char*)lds_raw + 131072));
#endif
    for (int ph = 0; ph < 44; ++ph) {
        if (only >= 0 && only != ph) continue;
        int zo_ = 0; asm volatile("" : "+s"(zo_));
        int wv_ = wave_s, bid_ = blockIdx.x, G_ = gridDim.x; asm volatile("" : "+s"(wv_), "+s"(bid_), "+s"(G_));
        Ctx c; c.lds = (LAS unsigned char*)lds_raw + zo_;
        { int l_; asm volatile("v_mbcnt_lo_u32_b32 %0, -1, 0\n\tv_mbcnt_hi_u32_b32 %0, -1, %0" : "=v"(l_)); c.lane = l_; c.tid = wv_ * 64 + l_; }
        c.wave = wv_; c.bid = bid_; c.G = G_; c.gw = c.bid * 8 + c.wave; c.ngw = c.G * 8; c.zo = zo_;
        int L, k; if (ph < 10) { L = 0; k = ph; } else if (ph < 22) { L = 1; k = ph - 10; } else if (ph < 32) { L = 2; k = ph - 22; } else { L = 3; k = ph - 32; }
        const uintptr_t wsu_ = (uintptr_t)(*(unsigned char* const*)((const char*)&p.ws + zo_)), outu_ = (uintptr_t)(*(float* const*)((const char*)&p.out + zo_));
        unsigned wlo_ = (unsigned)(wsu_ & 0xffffffffu), whi_ = (unsigned)(wsu_ >> 32), olo_ = (unsigned)(outu_ & 0xffffffffu), ohi_ = (unsigned)(outu_ >> 32);
        wlo_ = (unsigned)__builtin_amdgcn_readfirstlane((int)wlo_); whi_ = (unsigned)__builtin_amdgcn_readfirstlane((int)whi_); olo_ = (unsigned)__builtin_amdgcn_readfirstlane((int)olo_); ohi_ = (unsigned)__builtin_amdgcn_readfirstlane((int)ohi_);
        asm volatile("" : "+s"(wlo_), "+s"(whi_), "+s"(olo_), "+s"(ohi_));
        unsigned char* ws = (unsigned char*)(((uintptr_t)whi_ << 32) | (uintptr_t)wlo_); c.ws = ws; float* xout = (float*)(((uintptr_t)ohi_ << 32) | (uintptr_t)olo_);
        bf16_t* AB = (bf16_t*)(ws + WS_AB); bf16_t* Zb = (bf16_t*)(ws + WS_Z);
        const bf16_t* W_GU = (const bf16_t*)(ws + WS_WB + WB_GU); const bf16_t* W_DN = (const bf16_t*)(ws + WS_WB + WB_DN);
        const bf16_t* W_IN = (const bf16_t*)(ws + WS_WB + WB_IN); const bf16_t* W_OUT = (const bf16_t*)(ws + WS_WB + WB_OUT);
        const bf16_t* W_LORA = (const bf16_t*)(ws + WS_WB + WB_LORA); const bf16_t* W_UQ = (const bf16_t*)(ws + WS_WB + WB_UQ); const bf16_t* W_UKV = (const bf16_t*)(ws + WS_WB + WB_UKV);
        const bool odd = (L & 1) != 0; const int e = L >> 1, o = L >> 1;
        const int kt = odd ? k - 8 : k - 6;
        if (k == 0) {
            const float* xcur = (L == 0) ? p.in[zo_] : xout;
            if (PM & 1) { if (odd) convert_odd(c, p, L); else convert_even(c, p, L); }
            if (PM & 2) rms_rows(c, xcur, p.in[2 + zo_] + (size_t)L * D_, AB, L == 0 ? xout : nullptr);
        } else if (kt == 0) { if (PM & 1024) run_gemm(c, AB, D_, W_OUT, D_, D_, pg8::EpiResid{xout, D_});
        } else if (kt == 1) { if (PM & 2) rms_rows(c, xout, p.in[3 + zo_] + (size_t)L * D_, AB, nullptr);
        } else if (kt == 2) { if (PM & 2048) run_gemm(c, AB, D_, W_GU, 2 * DFF, D_, pg8::EpiSwiglu{Zb, DFF});
        } else if (kt == 3) { if (PM & 1024) run_gemm(c, Zb, DFF, W_DN, D_, DFF, pg8::EpiResid{xout, D_});
        } else if (!odd) {
            if (k == 1) { if (PM & 4) run_gemm(c, AB, D_, W_IN, 4096, D_, pg8::EpiBf16{Zb, ZLD_E, ZLD_E}); }
            else if (k == 2) { if (PM & 8) halo_copy(c, p, e); }
            else if (k == 3) { if (PM & 8) even_prep(c, p, e); }
            else if (k == 4) { if (PM & 16) gdn_scan(c, p, e); }
            else { if (PM & 16) gdn_post(c, p, e); }
        } else {
            if (k == 1) { if (PM & 4) run_gemm(c, AB, D_, W_IN, ZLD_O, D_, pg8::EpiSplit{(bf16_t*)(ws + WS_RKV), RKV_LD, 1536, (bf16_t*)(ws + WS_Z2), Z2_LD, 1536 + Z2_LD}); }
            else if (k == 2) { if (PM & 32) { odd_prep_a(c, p, o); rwkv_bnd_copy(c, p); } }
            else if (k == 3) { if (PM & 4) { run_gemm(c, (const bf16_t*)(ws + WS_LA), 384, W_LORA, o ? 2048 : 1536, 384, pg8::EpiBf16{(bf16_t*)(ws + WS_LO), 2048, 2048});
                       asm volatile("" : "+v"(c.tid));
                       run_gemm(c, (const bf16_t*)(ws + WS_Z2) + 256, Z2_LD, W_UQ, 768, 512, pg8::EpiBf16{(bf16_t*)(ws + WS_QR), 768, 768});
                       asm volatile("" : "+v"(c.tid));
                       run_gemm(c, (const bf16_t*)(ws + WS_Z2) + 768, Z2_LD, W_UKV, 1024, 256, pg8::EpiBf16{(bf16_t*)(ws + WS_KVR), 1024, 1024}); } }
            else if (k == 4) { if (PM & 256) mla_prep(c, p, o); }
            else if (k == 5) { if (PM & 256) rwkv_prep(c, p, o); }
            else if (k == 6) { if (c.bid < SCAN_BLOCKS) { if (PM & 64) rwkv_scan(c, p, o, SCAN_BLOCKS); } if (PM & 512) attn_phase(c, p, o, 0, 0); }
            else { if (PM & 128) rwkv_post(c, p, o); }
        }
#if !MULTI_LAUNCH
        if (ph == 0 && only == -2) grid.sync();
        else if (ph != 43) { XcdBarrier xb; xb.bar = (unsigned*)(ws + WS_CTL) + 4096; xb.x = xb_xcc_id(); xb.st = (volatile LAS unsigned*)((LAS unsigned char*)lds_raw + 131072); xcd_barrier(xb, wave_s); }
#endif
    }
}

constexpr int N_PHASES = 44;

extern "C" void kernel_launch(void* const* d_in, const int* in_sizes, int n_in, void* d_out, int out_size, void* d_ws, size_t ws_size, hipStream_t stream) {
    static int grid = 0;
    if (grid == 0) {
        if (n_in != 36 || ws_size < WS_NEED) { fprintf(stderr, "kernel_launch: unexpected inputs (n_in %d, ws %zu)\n", n_in, ws_size); grid = -1; return; }
        int dev = 0, cus = 0, per_cu = 0;
        hipGetDevice(&dev); hipDeviceGetAttribute(&cus, hipDeviceAttributeMultiprocessorCount, dev);
        hipFuncSetAttribute((const void*)fwd_kernel, hipFuncAttributeMaxDynamicSharedMemorySize, LDS_BYTES);
        hipOccupancyMaxActiveBlocksPerMultiprocessor(&per_cu, (const void*)fwd_kernel, 512, LDS_BYTES);
        (void)hipGetLastError();
        if (per_cu < 1) per_cu = 1;
        grid = cus * 1;
        if (grid <= 0) grid = 256;
    }
    if (grid < 0) return;
    (void)hipMemsetAsync(d_ws, 0, 65536, stream);
    Params prm{};
    for (int i = 0; i < 36; ++i) prm.in[i] = (const float*)d_in[i];
    prm.out = (float*)d_out; prm.ws = (unsigned char*)d_ws; prm.only = -1; prm.pad = 0;
#if MULTI_LAUNCH
    for (int ph = 0; ph < N_PHASES; ++ph) { prm.only = ph; hipLaunchKernelGGL(fwd_kernel, dim3(grid), dim3(512), LDS_BYTES, stream, prm); }
#else
    void* args[] = {&prm};
    hipError_t e = hipLaunchCooperativeKernel((const void*)fwd_kernel, dim3(grid), dim3(512), args, LDS_BYTES, stream);
    if (e != hipSuccess) fprintf(stderr, "cooperative launch failed: %s (grid %d)\n", hipGetErrorString(e), grid);
#endif
}
```

```cpp
#include <hip/hip_runtime.h>
#include <hip/hip_cooperative_groups.h>
#include <cstdint>
#include <cstdio>
namespace cg = cooperative_groups;

#ifndef MULTI_LAUNCH
#define MULTI_LAUNCH 0
#endif

#ifndef PHASE_MASK
#define PHASE_MASK 0xFFFF
#endif
constexpr int PM = PHASE_MASK;
#ifndef DUP_MASK
#define DUP_MASK 0
#endif
constexpr int DM = DUP_MASK;
#define LAS __attribute__((address_space(3)))
typedef unsigned short bf16_t;
typedef short bf16x8 __attribute__((ext_vector_type(8)));
typedef short s16x4 __attribute__((ext_vector_type(4)));
typedef float f32x4 __attribute__((ext_vector_type(4)));
typedef float f32x2 __attribute__((ext_vector_type(2)));
typedef float f32x16 __attribute__((ext_vector_type(16)));
typedef unsigned u32x4 __attribute__((ext_vector_type(4)));
typedef unsigned u32x2 __attribute__((ext_vector_type(2)));
typedef __bf16 bf16x2_t __attribute__((ext_vector_type(2)));

constexpr int T_ = 8192, M_ = 32768, D_ = 1024, DFF = 2816;
constexpr int ZLD_E = 3856, ZLD_O = 2816;
constexpr size_t MiB = 1u << 20;
constexpr size_t WS_WB = 1 * MiB, WS_AB = 33 * MiB, WS_VF = 97 * MiB, WS_Z = 129 * MiB;
constexpr size_t WS_U = 370 * MiB, WS_WN = 418 * MiB, WS_GC = 466 * MiB, WS_HALO = 468 * MiB, WS_GCB = 476 * MiB;
constexpr size_t WS_CTL = 0;
constexpr size_t WS_RKV = 129 * MiB, WS_Z2 = 225 * MiB, WS_KH = 225 * MiB, WS_VT = 273 * MiB;
constexpr size_t WS_LA = 305 * MiB, WS_LO = 329 * MiB, WS_KR = 457 * MiB, WS_RS = 459 * MiB;
constexpr size_t WS_QR = 460 * MiB, WS_KVR = 33 * MiB;
constexpr size_t WS_BND = 508 * MiB;
constexpr size_t WS_NEED = 511 * MiB;
constexpr int RKV_LD = 1536, Z2_LD = 1280, SCAN_BLOCKS = 128;
constexpr size_t WB_GU = 0, WB_DN = 11534336, WB_IN = 17301504, WB_OUT = 25690112, WB_LORA = 27787264, WB_UQ = 29360128, WB_UKV = 30146560;
constexpr int LDS_BYTES = 135168;

__device__ __forceinline__ float asf(unsigned u) { return __builtin_bit_cast(float, u); }
__device__ __forceinline__ unsigned asu(float f) { return __builtin_bit_cast(unsigned, f); }
__device__ __forceinline__ float bf2f(bf16_t b) { return asf((unsigned)b << 16); }
__device__ __forceinline__ unsigned pk2(float lo, float hi) { f32x2 v = {lo, hi}; bf16x2_t b = __builtin_convertvector(v, bf16x2_t); return __builtin_bit_cast(unsigned, b); }
__device__ __forceinline__ bf16_t f2bf(float f) { return (bf16_t)(pk2(f, 0.f) & 0xffffu); }
__device__ __forceinline__ void unpack8(u32x4 v, float* f) {
    f[0] = asf(v.x << 16); f[1] = asf(v.x & 0xffff0000u); f[2] = asf(v.y << 16); f[3] = asf(v.y & 0xffff0000u);
    f[4] = asf(v.z << 16); f[5] = asf(v.z & 0xffff0000u); f[6] = asf(v.w << 16); f[7] = asf(v.w & 0xffff0000u);
}
__device__ __forceinline__ u32x4 pack8(const float* f) { u32x4 o; o.x = pk2(f[0], f[1]); o.y = pk2(f[2], f[3]); o.z = pk2(f[4], f[5]); o.w = pk2(f[6], f[7]); return o; }
__device__ __forceinline__ float sigmoidf_(float x) { return __builtin_amdgcn_rcpf(1.f + __expf(-x)); }
__device__ __forceinline__ float siluf_(float x) { return x * __builtin_amdgcn_rcpf(1.f + __expf(-x)); }
__device__ __forceinline__ float softplusf_(float x) { return fmaxf(x, 0.f) + __logf(1.f + __expf(-fabsf(x))); }
__device__ __forceinline__ int crow(int r, int hi) { return (r & 3) + 8 * (r >> 2) + 4 * hi; }
__device__ __forceinline__ float wsum(float v) {
#pragma unroll
    for (int o = 32; o > 0; o >>= 1) v += __shfl_xor(v, o);
    return v;
}
template <int CTRL> __device__ __forceinline__ float dppf(float v) { return __builtin_bit_cast(float, __builtin_amdgcn_update_dpp(0, __builtin_bit_cast(int, v), CTRL, 0xF, 0xF, true)); }
__device__ __forceinline__ float half32_sum(float v) {
    v += dppf<0x128>(v); v += dppf<0x124>(v); v += dppf<0x122>(v); v += dppf<0x121>(v);
    auto r = __builtin_amdgcn_permlane16_swap(asu(v), asu(v), false, false);
    return asf(r[0]) + asf(r[1]);
}
__device__ __forceinline__ float wave_sum_dpp(float v) { v = half32_sum(v); auto r = __builtin_amdgcn_permlane32_swap(asu(v), asu(v), false, false); return asf(r[0]) + asf(r[1]); }
__device__ __forceinline__ float sum8_dpp(float v) { v += dppf<0xB1>(v); v += dppf<0x4E>(v); v += dppf<0x141>(v); return v; }
__device__ __forceinline__ float sum16_dpp(float v) { v += dppf<0xB1>(v); v += dppf<0x4E>(v); v += dppf<0x141>(v); v += dppf<0x140>(v); return v; }
__device__ __forceinline__ bf16x8 pkfrag(const f32x16& v, int s) {
    u32x4 o; o.x = pk2(v[8 * s + 0], v[8 * s + 1]); o.y = pk2(v[8 * s + 2], v[8 * s + 3]); o.z = pk2(v[8 * s + 4], v[8 * s + 5]); o.w = pk2(v[8 * s + 6], v[8 * s + 7]);
    return __builtin_bit_cast(bf16x8, o);
}
__device__ __forceinline__ bf16x8 ldA_perm(const LAS bf16_t* p) { s16x4 a = *(const LAS s16x4*)p; s16x4 b = *(const LAS s16x4*)(p + 8); return (bf16x8){a[0], a[1], a[2], a[3], b[0], b[1], b[2], b[3]}; }
#define LDS_WAIT() asm volatile("s_waitcnt lgkmcnt(0)" ::: "memory")
#define LDS_BARRIER() do { asm volatile("s_waitcnt lgkmcnt(0)" ::: "memory"); __builtin_amdgcn_s_barrier(); asm volatile("" ::: "memory"); } while (0)

namespace pg8 {
#define PG8_LAS __attribute__((address_space(3)))
constexpr int BM = 256, BK = 64, HALF = 128, HTB = HALF * BK * 2, STAGE_BYTES = 8 * HTB, NXCD = 8, WGM = 8;
__host__ __device__ __forceinline__ int lds_byte(int r, int c) { const int st = (r >> 4) * 2 + (c >> 5), rr = r & 15, cc = c & 31, ob = rr * 64 + cc * 2; return st * 1024 + (ob ^ (((ob >> 9) & 1) << 5)); }
__host__ __device__ __forceinline__ void stage_rc(int b, int& R, int& C) { const int st = b / 1024, sb = b % 1024, swz = sb ^ (((sb >> 9) & 1) << 5); R = (st >> 1) * 16 + swz / 64; C = (st & 1) * 32 + (swz % 64) / 2; }
__host__ __device__ __forceinline__ int perm32(int rho) { const int n = rho >> 4, i = rho & 15; return 8 * (i >> 2) + 4 * n + (i & 3); }
struct Unit { int pm, pn; };
struct Gemm { const bf16_t* A; const bf16_t* Bt; int M, N, K, lda; };
struct StaticOrder {
    int nM, nN, nwg, G, c;
    __host__ __device__ void init(int M, int N, int G_, int c_) { nM = M / BM; nN = N / BM; nwg = nM * nN; G = G_; c = c_; }
    __host__ __device__ bool next(int i, Unit& u) const {
        const long L = (long)i * G + c; if (L >= nwg) return false;
        int wgid = (int)L; { const int q = nwg / NXCD, r = nwg % NXCD, xcd = wgid % NXCD, off = wgid / NXCD; wgid = (xcd < r ? xcd * (q + 1) : r * (q + 1) + (xcd - r) * q) + off; }
        const int nig = WGM * nN, gid = wgid / nig, fm = gid * WGM, gsz = (nM - fm) < WGM ? (nM - fm) : WGM;
        u.pm = fm + ((wgid % nig) % gsz); u.pn = (wgid % nig) / gsz; return true;
    }
    __device__ __forceinline__ void a_ready(const Unit&) const {}
    __device__ __forceinline__ void done(const Unit&) const {}
};
struct EpiBf16 {
    static constexpr bool PERM = true;
    bf16_t* O; int ldc; int ncols;
    __device__ __forceinline__ void operator()(const f32x4 (&acc)[2][2][4][2], const Unit& u, int wr, int wc, int fr, int fq) const {
        const int row0 = u.pm * BM + wr * 64 + fr; const int col0 = u.pn * BM + wc * 32 + 8 * fq;
#pragma unroll
        for (int ai = 0; ai < 2; ++ai)
#pragma unroll
            for (int m = 0; m < 4; ++m) { bf16_t* rowp = O + (size_t)(row0 + ai * HALF + m * 16) * ldc + col0;
#pragma unroll
                for (int bj = 0; bj < 2; ++bj) { if (col0 + bj * HALF < ncols) { const f32x4 v0 = acc[ai][bj][m][0], v1 = acc[ai][bj][m][1];
                    u32x4 w; w.x = pk2(v0[0], v0[1]); w.y = pk2(v0[2], v0[3]); w.z = pk2(v1[0], v1[1]); w.w = pk2(v1[2], v1[3]);
                    *(u32x4*)(rowp + bj * HALF) = w; } } }
    }
};
struct EpiSplit {
    static constexpr bool PERM = true;
    bf16_t* O1; int ld1; int split; bf16_t* O2; int ld2; int ncols;
    __device__ __forceinline__ void operator()(const f32x4 (&acc)[2][2][4][2], const Unit& u, int wr, int wc, int fr, int fq) const {
        const int row0 = u.pm * BM + wr * 64 + fr; const int col0 = u.pn * BM + wc * 32 + 8 * fq;
#pragma unroll
        for (int bj = 0; bj < 2; ++bj) { const int cg = col0 + bj * HALF; if (cg < ncols) { bf16_t* base = (cg < split) ? O1 + cg : O2 + (cg - split); const int ld = (cg < split) ? ld1 : ld2;
#pragma unroll
            for (int ai = 0; ai < 2; ++ai)
#pragma unroll
                for (int m = 0; m < 4; ++m) { const f32x4 v0 = acc[ai][bj][m][0], v1 = acc[ai][bj][m][1];
                    u32x4 w; w.x = pk2(v0[0], v0[1]); w.y = pk2(v0[2], v0[3]); w.z = pk2(v1[0], v1[1]); w.w = pk2(v1[2], v1[3]);
                    *(u32x4*)(base + (size_t)(row0 + ai * HALF + m * 16) * ld) = w; } } }
    }
};
struct EpiSwiglu {
    static constexpr bool PERM = true;
    bf16_t* O; int ldc;
    __device__ __forceinline__ void operator()(const f32x4 (&acc)[2][2][4][2], const Unit& u, int wr, int wc, int fr, int fq) const {
        const int row0 = u.pm * BM + wr * 64 + fr; const int col0 = u.pn * HALF + wc * 32 + 8 * fq;
#pragma unroll
        for (int ai = 0; ai < 2; ++ai)
#pragma unroll
            for (int m = 0; m < 4; ++m) { bf16_t* rowp = O + (size_t)(row0 + ai * HALF + m * 16) * ldc + col0;
                float h[8];
#pragma unroll
                for (int n = 0; n < 2; ++n)
#pragma unroll
                    for (int i = 0; i < 4; ++i) { const float g = acc[ai][0][m][n][i], up = acc[ai][1][m][n][i]; h[4 * n + i] = siluf_(g) * up; }
                *(u32x4*)rowp = pack8(h); }
    }
};
struct EpiResid {
    static constexpr bool PERM = false;
    float* out; int ldc;
    __device__ __forceinline__ void operator()(const f32x4 (&acc)[2][2][4][2], const Unit& u, int wr, int wc, int fr, int fq) const {
        const int row0 = u.pm * BM + wr * 64 + fr; const int col0 = u.pn * BM + wc * 32 + 4 * fq;
#pragma unroll
        for (int ai = 0; ai < 2; ++ai)
#pragma unroll
            for (int m = 0; m < 4; ++m) { float* rowp = out + (size_t)(row0 + ai * HALF + m * 16) * ldc + col0;
#pragma unroll
                for (int bj = 0; bj < 2; ++bj)
#pragma unroll
                    for (int n = 0; n < 2; ++n) { f32x4* q = (f32x4*)(rowp + bj * HALF + n * 16); *q = *q + acc[ai][bj][m][n]; }
                asm volatile("" ::: "memory"); }
    }
};

template <class Epi, class Sched>
__device__ __forceinline__ void gemm_phase(PG8_LAS unsigned char* lds, const int tid, const Gemm g, const Sched& S, const Epi& E) {
    constexpr bool ALIGN_EPI = true;
    const int wid = __builtin_amdgcn_readfirstlane(tid >> 6), lane = tid & 63, wr = wid >> 2, wc = wid & 3, fr = lane & 15, fq = lane >> 4;
    const int K = g.K, nt = K / BK, lda = g.lda;
    unsigned voffA[2], voffB[2];
#pragma unroll
    for (int i = 0; i < 2; ++i) { int R, C; stage_rc(tid * 16 + i * 8192, R, C); const int Rb = Epi::PERM ? ((R & ~31) + perm32(R & 31)) : R;
        voffA[i] = (unsigned)(R * lda + C) * 2u; voffB[i] = (unsigned)(Rb * K + C) * 2u; }
    const size_t kstep = (size_t)(BK * 2);
    const size_t hstepA = (size_t)HALF * lda * 2, hstepB = (size_t)HALF * K * 2;
    const size_t tstepA = 2 * hstepA, tstepB = 2 * hstepB;
    const unsigned ldsw = (unsigned)wid * 1024u;
    const int aoff = lds_byte(wr * 64 + fr, fq * 8), boff = lds_byte(wc * 32 + fr, fq * 8);
#define PG8_SA(b, h) (((b) * 2 + (h)) * HTB)
#define PG8_SB(b, h) ((4 + (b) * 2 + (h)) * HTB)
#define PG8_STAGE(bufoff, gbase, voff) do { _Pragma("unroll") for (int _i = 0; _i < 2; ++_i) \
        __builtin_amdgcn_global_load_lds((const unsigned*)((const char*)(gbase) + (voff)[_i]), (PG8_LAS unsigned*)(lds + (bufoff) + ldsw + _i * 8192), 16, 0, 0); } while (0)
#define PG8_LDA(dst, b, h) do { _Pragma("unroll") for (int m = 0; m < 4; ++m) _Pragma("unroll") for (int k = 0; k < 2; ++k) dst[m][k] = *(const PG8_LAS bf16x8*)(lds + PG8_SA(b, h) + aoff + m * 2048 + k * 1024); } while (0)
#define PG8_LDB(dst, b, h) do { _Pragma("unroll") for (int n = 0; n < 2; ++n) _Pragma("unroll") for (int k = 0; k < 2; ++k) dst[n][k] = *(const PG8_LAS bf16x8*)(lds + PG8_SB(b, h) + boff + n * 2048 + k * 1024); } while (0)
#define PG8_MMA(ai, bj, At, Bt) do { __builtin_amdgcn_s_setprio(1); _Pragma("unroll") for (int m = 0; m < 4; ++m) _Pragma("unroll") for (int n = 0; n < 2; ++n) _Pragma("unroll") for (int k = 0; k < 2; ++k) \
        acc[ai][bj][m][n] = __builtin_amdgcn_mfma_f32_16x16x32_bf16(Bt[n][k], At[m][k], acc[ai][bj][m][n], 0, 0, 0); __builtin_amdgcn_s_setprio(0); } while (0)
#define PG8_WAIT_V(n) asm volatile("s_waitcnt vmcnt(" #n ")" ::: "memory")
#define PG8_WAIT_L(n) asm volatile("s_waitcnt lgkmcnt(" #n ")" ::: "memory")
#define PG8_BAR __builtin_amdgcn_s_barrier()
#define PG8_SCHED __builtin_amdgcn_sched_barrier(0)
    Unit cur, nxt; int ui = 0;
    if (!S.next(0, cur)) return;
    f32x4 acc[2][2][4][2];
#pragma unroll
    for (int a = 0; a < 2; ++a)
#pragma unroll
        for (int b = 0; b < 2; ++b)
#pragma unroll
            for (int m = 0; m < 4; ++m)
#pragma unroll
                for (int n = 0; n < 2; ++n) acc[a][b][m][n] = (f32x4){0.f, 0.f, 0.f, 0.f};
    bf16x8 At[4][2], B0[2][2], B1[2][2];
    const char* cA = (const char*)g.A + (size_t)cur.pm * tstepA; const char* cB = (const char*)g.Bt + (size_t)cur.pn * tstepB;
    S.a_ready(cur);
    PG8_STAGE(PG8_SB(0, 0), cB, voffB); PG8_STAGE(PG8_SB(0, 1), cB + hstepB, voffB); PG8_STAGE(PG8_SA(0, 0), cA, voffA); PG8_STAGE(PG8_SA(0, 1), cA + hstepA, voffA);
    if (wr == 1) PG8_BAR;
    PG8_WAIT_V(2); PG8_BAR;
    PG8_STAGE(PG8_SB(1, 0), cB + kstep, voffB); PG8_STAGE(PG8_SA(1, 0), cA + kstep, voffA); PG8_STAGE(PG8_SB(1, 1), cB + hstepB + kstep, voffB);
    PG8_WAIT_V(6); PG8_BAR;
    for (;;) {
        const bool has_next = S.next(ui + 1, nxt);
        const char* nA = has_next ? (const char*)g.A + (size_t)nxt.pm * tstepA : cA; const char* nB = has_next ? (const char*)g.Bt + (size_t)nxt.pn * tstepB : cB;
        for (int t = 0; t < nt; t += 2) {
            const bool last = (t == nt - 2);
            const char* a1 = cA + (size_t)(t + 1) * kstep;
            const char* a2 = last ? nA : cA + (size_t)(t + 2) * kstep; const char* b2 = last ? nB : cB + (size_t)(t + 2) * kstep;
            const char* a3 = a2 + kstep; const char* b3 = b2 + kstep;
            if (last && has_next) S.a_ready(nxt);
            PG8_LDB(B0, 0, 0); PG8_LDB(B1, 0, 1); PG8_SCHED; PG8_LDA(At, 0, 0); PG8_STAGE(PG8_SA(1, 1), a1 + hstepA, voffA);
            PG8_WAIT_V(8); PG8_WAIT_L(0); PG8_BAR; PG8_MMA(0, 0, At, B0); PG8_MMA(0, 1, At, B1); PG8_BAR; PG8_SCHED;
            PG8_LDA(At, 0, 1); PG8_STAGE(PG8_SB(0, 0), b2, voffB); PG8_STAGE(PG8_SB(0, 1), b2 + hstepB, voffB); PG8_STAGE(PG8_SA(0, 0), a2, voffA);
            PG8_WAIT_V(8); PG8_WAIT_L(0); PG8_BAR; PG8_MMA(1, 0, At, B0); PG8_MMA(1, 1, At, B1); PG8_BAR; PG8_SCHED;
            PG8_LDB(B0, 1, 0); PG8_LDB(B1, 1, 1); PG8_SCHED; PG8_LDA(At, 1, 0); PG8_STAGE(PG8_SA(0, 1), a2 + hstepA, voffA);
            PG8_WAIT_V(8); PG8_WAIT_L(0); PG8_BAR; PG8_MMA(0, 0, At, B0); PG8_MMA(0, 1, At, B1); PG8_BAR; PG8_SCHED;
            PG8_LDA(At, 1, 1); PG8_STAGE(PG8_SB(1, 0), b3, voffB); PG8_STAGE(PG8_SB(1, 1), b3 + hstepB, voffB); PG8_STAGE(PG8_SA(1, 0), a3, voffA);
            PG8_WAIT_V(8); PG8_WAIT_L(0); PG8_BAR; PG8_MMA(1, 0, At, B0); PG8_MMA(1, 1, At, B1); PG8_BAR; PG8_SCHED;
        }
        if constexpr (ALIGN_EPI) { if (wr == 0) PG8_BAR; }
        E(acc, cur, wr, wc, fr, fq); S.done(cur);
        if (!has_next) break;
#pragma unroll
        for (int a = 0; a < 2; ++a)
#pragma unroll
            for (int b = 0; b < 2; ++b)
#pragma unroll
                for (int m = 0; m < 4; ++m)
#pragma unroll
                    for (int n = 0; n < 2; ++n) acc[a][b][m][n] = (f32x4){0.f, 0.f, 0.f, 0.f};
        cur = nxt; cA = nA; cB = nB; ++ui;
        if constexpr (ALIGN_EPI) { if (wr == 1) PG8_BAR; }
    }
    PG8_WAIT_V(0);
    if constexpr (!ALIGN_EPI) { if (wr == 0) PG8_BAR; }
    PG8_BAR;
#undef PG8_SA
#undef PG8_SB
#undef PG8_STAGE
#undef PG8_LDA
#undef PG8_LDB
#undef PG8_MMA
#undef PG8_WAIT_V
#undef PG8_WAIT_L
#undef PG8_BAR
#undef PG8_SCHED
}
}

struct Params { const float* in[36]; float* out; unsigned char* ws; int only; int pad; };
struct Ctx { LAS unsigned char* lds; unsigned char* ws; int tid, lane, wave, bid, G, gw, ngw, zo; };

template <class Epi> __device__ __forceinline__ void run_gemm(const Ctx& c, const bf16_t* A, int lda, const bf16_t* Bt, int N, int K, const Epi& E) {
    pg8::Gemm g{A, Bt, M_, N, K, lda}; pg8::StaticOrder S; S.init(M_, N, c.G, c.bid);
    pg8::gemm_phase<Epi, pg8::StaticOrder>(c.lds, c.tid, g, S, E);
}

__device__ __forceinline__ void tr_item(const float* src, int ld, int kv, int nv, const float* ks, bf16_t* dst, int ldd, LAS float* scr, int lane) {
    const int n = lane & 31;
    if (kv >= 64 && nv >= 32 && !ks) {
        float tmp[32]; const float* sp = src + (size_t)(lane >> 5) * ld + n;
#pragma unroll
        for (int i = 0; i < 32; ++i) tmp[i] = sp[(size_t)(2 * i) * ld];
#pragma unroll
        for (int i = 0; i < 32; ++i) scr[(2 * i + (lane >> 5)) * 33 + n] = tmp[i];
    } else {
#pragma unroll 4
        for (int i = 0; i < 32; ++i) { const int kk = 2 * i + (lane >> 5); float v = 0.f; if (kk < kv && n < nv) { v = src[(size_t)kk * ld + n]; if (ks) v *= ks[kk]; } scr[kk * 33 + n] = v; }
    }
    LDS_WAIT(); asm volatile("" ::: "memory");
    const int c = lane & 7;
#pragma unroll
    for (int j = 0; j < 4; ++j) { const int nn = (lane >> 3) + 8 * j; const LAS float* s = scr + (8 * c) * 33 + nn;
        u32x4 o; o.x = pk2(s[0 * 33], s[1 * 33]); o.y = pk2(s[2 * 33], s[3 * 33]); o.z = pk2(s[4 * 33], s[5 * 33]); o.w = pk2(s[6 * 33], s[7 * 33]);
        *(u32x4*)(dst + (size_t)nn * ldd + 8 * c) = o; }
    LDS_WAIT(); asm volatile("" ::: "memory");
}
__device__ __forceinline__ void tr_job(const Ctx& c, const float* src, int ld, int K, int N, const float* ks, bf16_t* dst, int ldd, int Kpad, int Npad) {
    LAS float* scr = (LAS float*)(c.lds + c.wave * 8448);
    const int nnb = Npad / 32, items = (Kpad / 64) * nnb;
    for (int it = c.gw; it < items; it += c.ngw) { const int kb = it / nnb, nb = it % nnb, k0 = 64 * kb, n0 = 32 * nb;
        tr_item(src + (size_t)k0 * ld + n0, ld, K - k0, N - n0, ks ? ks + k0 : nullptr, dst + (size_t)n0 * ldd + k0, ldd, scr, c.lane); }
}
__device__ __forceinline__ void convert_common(const Ctx& c, const Params& p, int L, const float* wout_src) {
    bf16_t* WB = (bf16_t*)(c.ws + WS_WB);
    LAS float* scr = (LAS float*)(c.lds + c.wave * 8448);
    { const float* src = p.in[c.zo + 4] + (size_t)L * D_ * 2 * DFF; bf16_t* dst = (bf16_t*)((unsigned char*)WB + WB_GU);
      const int nnb = 2 * DFF / 32, items = (D_ / 64) * nnb;
      for (int it = c.gw; it < items; it += c.ngw) { const int kb = it / nnb, nb = it % nnb, k0 = 64 * kb, n0 = 32 * nb; const int t = n0 >> 8, w = n0 & 255;
          const int sc = (w < 128) ? 128 * t + w : DFF + 128 * t + (w - 128);
          tr_item(src + (size_t)k0 * (2 * DFF) + sc, 2 * DFF, 64, 32, nullptr, dst + (size_t)n0 * D_ + k0, D_, scr, c.lane); } }
    tr_job(c, p.in[c.zo + 5] + (size_t)L * DFF * D_, D_, DFF, D_, nullptr, (bf16_t*)((unsigned char*)WB + WB_DN), DFF, DFF, D_);
    tr_job(c, wout_src, D_, D_, D_, nullptr, (bf16_t*)((unsigned char*)WB + WB_OUT), D_, D_, D_);
}
__device__ __forceinline__ void convert_even(const Ctx& c, const Params& p, int L) {
    const int e = L >> 1;
    convert_common(c, p, L, p.in[c.zo + 12] + (size_t)e * D_ * D_);
    tr_job(c, p.in[c.zo + 6] + (size_t)e * D_ * 3852, 3852, D_, 3852, nullptr, (bf16_t*)(c.ws + WS_WB + WB_IN), D_, D_, 4096);
}
__device__ __forceinline__ void convert_odd(const Ctx& c, const Params& p, int L) {
    const int o = L >> 1;
    convert_common(c, p, L, p.in[c.zo + 35] + (size_t)o * D_ * D_);
    bf16_t* win = (bf16_t*)(c.ws + WS_WB + WB_IN);
    tr_job(c, p.in[c.zo + 13] + (size_t)o * D_ * 2592, 2592, D_, 2592, nullptr, win, D_, D_, 2592);
    tr_job(c, o ? p.in[c.zo + 25] + (size_t)(o - 1) * D_ * 32 : p.in[c.zo + 25], 32, D_, o ? 32 : 0, nullptr, win + (size_t)2592 * D_, D_, D_, 32);
    tr_job(c, p.in[c.zo + 25], 32, D_, 0, nullptr, win + (size_t)2624 * D_, D_, D_, 192);
    bf16_t* wl = (bf16_t*)(c.ws + WS_WB + WB_LORA);
    { LAS float* scr = (LAS float*)(c.lds + c.wave * 8448);
      const int items = 6 * 64;
      for (int it = c.gw; it < items; it += c.ngw) { const int kb = it / 64, nb = it % 64, n0 = 32 * nb, R = n0 >> 9, nn0 = n0 & 511;
          const float* src = p.in[c.zo + 16]; int kv = 0, ld = 512;
          if (R == 0 && kb == 0) { src = p.in[c.zo + 16] + (size_t)o * 64 * 512 + nn0; kv = 64; }
          else if (R == 1 && kb == 1) { src = p.in[c.zo + 18] + (size_t)o * 64 * 512 + nn0; kv = 64; }
          else if (R == 2 && (kb == 2 || kb == 3)) { src = p.in[c.zo + 19] + (size_t)o * 128 * 512 + (size_t)(kb - 2) * 64 * 512 + nn0; kv = 64; }
          else if (R == 3 && kb == 4 && o > 0) { src = p.in[c.zo + 28] + (size_t)(o - 1) * 32 * 512 + nn0; kv = 32; }
          tr_item(src, ld, kv, kv ? 32 : 0, nullptr, wl + (size_t)n0 * 384 + 64 * kb, 384, scr, c.lane); } }
    tr_job(c, p.in[c.zo + 31] + (size_t)o * 512 * 768, 768, 512, 768, p.in[c.zo + 29] + (size_t)o * 512, (bf16_t*)(c.ws + WS_WB + WB_UQ), 512, 512, 768);
    tr_job(c, p.in[c.zo + 32] + (size_t)o * 256 * 1024, 1024, 256, 1024, p.in[c.zo + 30] + (size_t)o * 256, (bf16_t*)(c.ws + WS_WB + WB_UKV), 256, 256, 1024);
}

__device__ __forceinline__ void rms_rows(const Ctx& c, const float* x, const float* gain, bf16_t* out, float* xcopy) {
    f32x4 gv[4];
#pragma unroll
    for (int j = 0; j < 4; ++j) gv[j] = ((const f32x4*)gain)[c.lane + 64 * j];
    for (int m = c.gw; m < M_; m += c.ngw) {
        const f32x4* xr = (const f32x4*)(x + (size_t)m * D_) + c.lane;
        f32x4 v[4]; float s = 0.f;
#pragma unroll
        for (int j = 0; j < 4; ++j) { v[j] = xr[64 * j]; s += (v[j].x * v[j].x + v[j].y * v[j].y) + (v[j].z * v[j].z + v[j].w * v[j].w); }
        if (xcopy) { f32x4* xc = (f32x4*)(xcopy + (size_t)m * D_) + c.lane;
#pragma unroll
            for (int j = 0; j < 4; ++j) xc[64 * j] = v[j]; }
        const float r = rsqrtf(wave_sum_dpp(s) * (1.f / D_) + 1e-6f);
        u32x2* o8 = (u32x2*)(out + (size_t)m * D_) + c.lane;
#pragma unroll
        for (int j = 0; j < 4; ++j) { u32x2 w; w.x = pk2(v[j].x * r * gv[j].x, v[j].y * r * gv[j].y); w.y = pk2(v[j].z * r * gv[j].z, v[j].w * r * gv[j].w); o8[64 * j] = w; }
    }
}

__device__ __forceinline__ void conv4_silu8(const bf16_t* zp, int t, const float* cw, float* y) {
#pragma unroll
    for (int i = 0; i < 8; ++i) y[i] = 0.f;
#pragma unroll
    for (int j = 0; j < 4; ++j) { const int dt = j - 3;
        if (t + dt >= 0) { float xv[8]; unpack8(*(const u32x4*)(zp + (long)dt * ZLD_E), xv);
            const f32x4 w0 = *(const f32x4*)(cw + j * 2304), w1 = *(const f32x4*)(cw + j * 2304 + 4);
            y[0] += w0.x * xv[0]; y[1] += w0.y * xv[1]; y[2] += w0.z * xv[2]; y[3] += w0.w * xv[3];
            y[4] += w1.x * xv[4]; y[5] += w1.y * xv[5]; y[6] += w1.z * xv[6]; y[7] += w1.w * xv[7]; } }
#pragma unroll
    for (int i = 0; i < 8; ++i) y[i] = siluf_(y[i]);
}
__device__ __forceinline__ void conv4h(const bf16_t* zc, int row, const bf16_t* hp, bool has_prev, const float* cw, float* y) {
#pragma unroll
    for (int i = 0; i < 8; ++i) y[i] = 0.f;
#pragma unroll
    for (int j = 0; j < 4; ++j) { const int rr = row - 3 + j;
        if (rr >= 0 || has_prev) { const bf16_t* src = (rr >= 0) ? zc + (size_t)rr * ZLD_E : hp + (3 + rr) * 384; float xv[8]; unpack8(*(const u32x4*)src, xv);
            const f32x4 w0 = *(const f32x4*)(cw + j * 2304), w1 = *(const f32x4*)(cw + j * 2304 + 4);
            y[0] += w0.x * xv[0]; y[1] += w0.y * xv[1]; y[2] += w0.z * xv[2]; y[3] += w0.w * xv[3];
            y[4] += w1.x * xv[4]; y[5] += w1.y * xv[5]; y[6] += w1.z * xv[6]; y[7] += w1.w * xv[7]; } }
#pragma unroll
    for (int i = 0; i < 8; ++i) y[i] = siluf_(y[i]);
}
__device__ __forceinline__ float sum16(float v) { v += __shfl_xor(v, 1); v += __shfl_xor(v, 2); v += __shfl_xor(v, 4); v += __shfl_xor(v, 8); return v; }

__device__ __forceinline__ void even_prep(const Ctx& c, const Params& p, int e) {
    const bf16_t* Z = (const bf16_t*)(c.ws + WS_Z); bf16_t* Y = (bf16_t*)(c.ws + WS_AB);
    bf16_t* U = (bf16_t*)(c.ws + WS_U); bf16_t* WN = (bf16_t*)(c.ws + WS_WN); float* GC = (float*)(c.ws + WS_GC);
    const float* conv_a = p.in[c.zo + 7] + (size_t)e * 3 * 256; const float* conv_qkv = p.in[c.zo + 8] + (size_t)e * 4 * 2304;
    { const long NT = (long)c.G * 512;
      for (long it = (long)c.bid * 512 + c.tid; it < (long)M_ * 32; it += NT) { const int m = (int)(it >> 5), c8 = (int)(it & 31) * 8, t = m & (T_ - 1);
          const bf16_t* zr = Z + (size_t)m * ZLD_E; float ab[8], acc[8];
          unpack8(*(const u32x4*)(zr + c8), ab);
#pragma unroll
          for (int i = 0; i < 8; ++i) acc[i] = 0.f;
#pragma unroll
          for (int j = 0; j < 3; ++j) { const int dt = j - 2; if (t + dt >= 0) { const bf16_t* zc = zr + (long)dt * ZLD_E; float ac[8], ah[8];
              unpack8(*(const u32x4*)(zc + 256 + c8), ac); unpack8(*(const u32x4*)(zc + 512 + c8), ah);
#pragma unroll
              for (int i = 0; i < 8; ++i) acc[i] += conv_a[j * 256 + c8 + i] * (ac[i] * ah[i]); } }
#pragma unroll
          for (int i = 0; i < 8; ++i) acc[i] *= ab[i];
          *(u32x4*)(Y + (size_t)m * D_ + c8) = pack8(acc); } }
    const bf16_t* HALO = (const bf16_t*)(c.ws + WS_HALO); const float* GCB = (const float*)(c.ws + WS_GCB);
    bf16_t* Zw = (bf16_t*)(c.ws + WS_Z);
    LAS bf16_t* KN = (LAS bf16_t*)(c.lds);
    LAS float* VB = (LAS float*)(c.lds + 17408);
    LAS float* KBG = (LAS float*)(c.lds + 17408 + 32768);
    LAS float* Lm = (LAS float*)(c.lds + 17408 + 65536);
    LAS float* sgc = (LAS float*)(c.lds + 17408 + 65536 + 16384);
    LAS float* sbeta = sgc + 64;
    LAS bf16_t* QS = (LAS bf16_t*)(c.lds + 17408 + 65536 + 16384 + 512);
    for (int item = c.bid; item < 3072; item += c.G) {
        int tid_i = c.tid; asm volatile("" : "+v"(tid_i)); const int lane_i = tid_i & 63;
        const int n = item & 127, bh = item >> 7, h = bh % 6, b = bh / 6; const int m0 = b * T_ + 64 * n;
        if (tid_i < 128) sgc[tid_i] = GCB[(size_t)item * 128 + tid_i];
        __syncthreads();
        const float glast = sgc[63];
        u32x4 qdp0 = {}, qdp1 = {}, kdp0 = {}, kdp1 = {};
#pragma unroll 1
        for (int rep = 0; rep < 2; ++rep) { const int vi = tid_i + 512 * rep, row = vi >> 4, c8 = (vi & 15) * 8;
            const bf16_t* zc = Z + (size_t)m0 * ZLD_E + 768 + h * 128 + c8; const bf16_t* hp = HALO + (size_t)(bh * 128 + n) * 1152 + c8; float y[8], yd[8];
            conv4h(zc, row, hp, n > 0, conv_qkv + h * 128 + c8, y);
            float ss = 0.f;
#pragma unroll
            for (int i = 0; i < 8; ++i) ss += y[i] * y[i];
            ss = sum16_dpp(ss); float rn = rsqrtf(ss + 1e-6f) * 0.08838834764831845f;
            const float eg = __expf(sgc[row]);
#pragma unroll
            for (int i = 0; i < 8; ++i) { y[i] *= rn; yd[i] = y[i] * eg; }
            *(LAS u32x4*)(QS + row * 136 + c8) = pack8(y); { const u32x4 t_ = pack8(yd); if (rep == 0) qdp0 = t_; else qdp1 = t_; }
            conv4h(zc + 768, row, hp + 128, n > 0, conv_qkv + 768 + h * 128 + c8, y);
            ss = 0.f;
#pragma unroll
            for (int i = 0; i < 8; ++i) ss += y[i] * y[i];
            ss = sum16_dpp(ss); rn = rsqrtf(ss + 1e-6f);
            const float bg = sbeta[row] * eg; const float ek = __expf(glast - sgc[row]);
#pragma unroll
            for (int i = 0; i < 8; ++i) { y[i] *= rn; KBG[row * 128 + c8 + i] = y[i] * bg; yd[i] = y[i] * ek; }
            *(LAS u32x4*)(KN + row * 136 + c8) = pack8(y); { const u32x4 t_ = pack8(yd); if (rep == 0) kdp0 = t_; else kdp1 = t_; }
            conv4h(zc + 1536, row, hp + 256, n > 0, conv_qkv + 1536 + h * 128 + c8, y);
            const float be = sbeta[row];
#pragma unroll
            for (int i = 0; i < 8; ++i) VB[row * 128 + c8 + i] = y[i] * be; }
        __syncthreads();
#pragma unroll
        for (int rep = 0; rep < 2; ++rep) { const int vi = tid_i + 512 * rep, row = vi >> 4, c8 = (vi & 15) * 8;
            bf16_t* zc = Zw + (size_t)(m0 + row) * ZLD_E + 768 + h * 128 + c8; *(u32x4*)zc = rep ? qdp1 : qdp0;
            const u32x4 kd_ = rep ? kdp1 : kdp0; bf16_t* kt_ = Zw + (size_t)(m0 + (c8 >> 1)) * ZLD_E + 768 + 768 + h * 128 + row;
            kt_[0] = (bf16_t)(kd_.x & 0xffffu); kt_[64] = (bf16_t)(kd_.x >> 16); kt_[ZLD_E] = (bf16_t)(kd_.y & 0xffffu); kt_[ZLD_E + 64] = (bf16_t)(kd_.y >> 16);
            kt_[2 * ZLD_E] = (bf16_t)(kd_.z & 0xffffu); kt_[2 * ZLD_E + 64] = (bf16_t)(kd_.z >> 16); kt_[3 * ZLD_E] = (bf16_t)(kd_.w & 0xffffu); kt_[3 * ZLD_E + 64] = (bf16_t)(kd_.w >> 16); }
        { const int l31 = lane_i & 31, hh = lane_i >> 5; const int w = c.wave & 3; const int ti = (w == 0 || w == 3) ? 0 : 1, tj = (w >= 2) ? 1 : 0; const bool isq = c.wave >= 4;
            bf16_t* qko = Zw + (size_t)m0 * ZLD_E + 768 + 1536 + h * 128;
            if (w == 3) {
#pragma unroll
                for (int r = 0; r < 16; ++r) { const int i = 32 * ti + crow(r, hh), j = 32 * tj + l31; if (isq) qko[(size_t)i * ZLD_E + j] = 0; else Lm[i * 64 + j] = 0.f; }
            } else { f32x16 acc = {}; const LAS bf16_t* Am = isq ? QS : KN;
#pragma unroll
                for (int ks = 0; ks < 8; ++ks) { const bf16x8 a = *(const LAS bf16x8*)(Am + (32 * ti + l31) * 136 + 16 * ks + 8 * hh); const bf16x8 bb = *(const LAS bf16x8*)(KN + (32 * tj + l31) * 136 + 16 * ks + 8 * hh);
                    acc = __builtin_amdgcn_mfma_f32_32x32x16_bf16(a, bb, acc, 0, 0, 0); }
                const int j = 32 * tj + l31; const float gj = sgc[j];
#pragma unroll
                for (int r = 0; r < 16; ++r) { const int i = 32 * ti + crow(r, hh); const float dec = __expf(fminf(sgc[i] - gj, 0.f));
                    if (isq) qko[(size_t)i * ZLD_E + j] = (i >= j) ? f2bf(acc[r] * dec) : (bf16_t)0;
                    else Lm[i * 64 + j] = (i > j) ? sbeta[i] * acc[r] * dec : 0.f; } } }
        __syncthreads();
        if (tid_i < 256) { const int cc = tid_i & 127; const LAS float* src = (tid_i < 128) ? VB : KBG; float x[64];
            int vz = 0; asm volatile("" : "+v"(vz)); const LAS float* Lv = Lm + vz;
#pragma unroll
            for (int i = 0; i < 64; ++i) x[i] = src[i * 128 + cc];
#pragma unroll
            for (int i = 1; i < 64; ++i) { const LAS f32x4* Lr = (const LAS f32x4*)(Lv + i * 64); float a0 = x[i], a1 = 0.f;
#pragma unroll
                for (int j4 = 0; j4 < (i + 3) / 4; ++j4) { const f32x4 l = Lr[j4];
                    if (4 * j4 + 0 < i) a0 -= l[0] * x[4 * j4 + 0];
                    if (4 * j4 + 1 < i) a1 -= l[1] * x[4 * j4 + 1];
                    if (4 * j4 + 2 < i) a0 -= l[2] * x[4 * j4 + 2];
                    if (4 * j4 + 3 < i) a1 -= l[3] * x[4 * j4 + 3]; }
                x[i] = a0 + a1; }
            LAS float* dstl = (tid_i < 128) ? VB : KBG; const float sg = (tid_i < 128) ? 1.f : -1.f;
#pragma unroll
            for (int i = 0; i < 64; ++i) dstl[i * 128 + cc] = x[i] * sg; }
        __syncthreads();
#pragma unroll 1
        for (int rep = 0; rep < 4; ++rep) { const int vi = tid_i + 512 * rep, row = vi >> 5, which = (vi >> 4) & 1, c8 = (vi & 15) * 8;
            const LAS float* sp = (which ? KBG : VB) + row * 128 + c8; float f[8];
#pragma unroll
            for (int i = 0; i < 8; ++i) f[i] = sp[i];
            bf16_t* dp = (which ? WN : U) + (size_t)(m0 + row) * 768 + h * 128 + c8;
            *(u32x4*)dp = pack8(f); }
        __syncthreads();
    }
}

__device__ __forceinline__ void halo_copy(const Ctx& c, const Params& p, int e) {
    const bf16_t* Z = (const bf16_t*)(c.ws + WS_Z); bf16_t* HALO = (bf16_t*)(c.ws + WS_HALO);
    const int NT = c.G * 512, total = 24 * 128 * 3 * 3 * 16;
    for (int it = c.bid * 512 + c.tid; it < total; it += NT) { const int c8 = (it & 15) * 8; int r_ = it >> 4; const int part = r_ % 3; r_ /= 3; const int r = r_ % 3; r_ /= 3; const int n = r_ & 127, bh = r_ >> 7;
        if (n == 0) continue; const int h = bh % 6, b = bh / 6;
        *(u32x4*)(HALO + ((size_t)(bh * 128 + n) * 3 + r) * 384 + part * 128 + c8) = *(const u32x4*)(Z + (size_t)(b * T_ + 64 * n - 3 + r) * ZLD_E + 768 + part * 768 + h * 128 + c8); }
    float* GCB = (float*)(c.ws + WS_GCB); float* GC = (float*)(c.ws + WS_GC);
    for (int item = c.gw; item < 3072; item += c.ngw) { const int n = item & 127, bh = item >> 7, h = bh % 6, b = bh / 6, t = c.lane;
        const bf16_t* zr = Z + (size_t)(b * T_ + 64 * n + t) * ZLD_E;
        const float braw = bf2f(zr[3840 + h]), araw = bf2f(zr[3846 + h]);
        const float beta = sigmoidf_(braw);
        float g = -__expf(p.in[c.zo + 9][e * 6 + h]) * softplusf_(araw + p.in[c.zo + 10][e * 6 + h]);
#pragma unroll
        for (int o = 1; o < 64; o <<= 1) { const float u = __shfl_up(g, o); if (t >= o) g += u; }
        GCB[(size_t)item * 128 + t] = g; GCB[(size_t)item * 128 + 64 + t] = beta; if (t == 63) GC[(size_t)bh * 128 + n] = __expf(g); }
}

__device__ __forceinline__ void gdn_scan(const Ctx& c, const Params& p, int e) {
    const bf16_t* Z = (const bf16_t*)(c.ws + WS_Z); bf16_t* Y = (bf16_t*)(c.ws + WS_AB);
    const bf16_t* U = (const bf16_t*)(c.ws + WS_U); const bf16_t* WNg = (const bf16_t*)(c.ws + WS_WN); const float* GC = (const float*)(c.ws + WS_GC);
    LAS bf16_t* QD = (LAS bf16_t*)(c.lds);
    LAS bf16_t* WNs = (LAS bf16_t*)(c.lds + 17408);
    LAS bf16_t* UT = (LAS bf16_t*)(c.lds + 34816);
    LAS bf16_t* KDT = (LAS bf16_t*)(c.lds + 52224);
    LAS bf16_t* QK = (LAS bf16_t*)(c.lds + 70656);
    LAS bf16_t* OTb = (LAS bf16_t*)(c.lds + 79872);
    const int l31 = c.lane & 31, hh = c.lane >> 5;
    const bool producer = c.wave >= 4; const int ptid = c.tid & 255;
    for (int item = c.bid; item < 48; item += c.G) {
        const int bh = item >> 1, dvh = item & 1, h = bh % 6, b = bh / 6;
        const int e0 = 64 * dvh + 32 * (c.wave & 1);
#define GDN_LOAD_TILES(nn) do { const size_t mb_ = (size_t)(b * T_ + 64 * (nn)); _Pragma("unroll") for (int k_ = 0; k_ < 4; ++k_) { const size_t rz_ = (mb_ + prow + 16 * k_) * ZLD_E + 768 + h * 128 + pc8; const size_t ru_ = (mb_ + prow + 16 * k_) * 768 + h * 128 + pc8; \
            tq[k_] = *(const u32x4*)(Z + rz_); { const int vi_ = pt_ + 256 * k_, d_ = vi_ >> 3; tk[k_] = *(const u32x4*)(Z + (mb_ + (d_ >> 1)) * ZLD_E + 768 + 768 + h * 128 + (d_ & 1) * 64 + (vi_ & 7) * 8); } tw[k_] = *(const u32x4*)(WNg + ru_); tu[k_] = *(const u32x4*)(U + ru_); } \
            _Pragma("unroll") for (int k_ = 0; k_ < 2; ++k_) tqk[k_] = *(const u32x4*)(Z + (mb_ + qrow + 32 * k_) * ZLD_E + 768 + 1536 + h * 128 + qc8); } while (0)
#define GDN_STORE_TILES() do { _Pragma("unroll") for (int k_ = 0; k_ < 4; ++k_) { const int row_ = prow + 16 * k_; *(LAS u32x4*)(QD + row_ * 136 + pc8) = tq[k_]; *(LAS u32x4*)(WNs + row_ * 136 + pc8) = tw[k_]; *(LAS u32x4*)(UT + row_ * 136 + pc8) = tu[k_]; \
            { const int vi_ = pt_ + 256 * k_; *(LAS u32x4*)(KDT + (vi_ >> 3) * 72 + (vi_ & 7) * 8) = tk[k_]; } } \
            _Pragma("unroll") for (int k_ = 0; k_ < 2; ++k_) *(LAS u32x4*)(QK + (qrow + 32 * k_) * 72 + qc8) = tqk[k_]; } while (0)
#define GDN_STORE_O(nn) do { const LAS bf16_t* ob_ = OTb + ((nn) & 1) * 4608; _Pragma("unroll") for (int k_ = 0; k_ < 2; ++k_) { const int vi_ = pt_ + 256 * k_, row_ = vi_ >> 3, c8_ = (vi_ & 7) * 8; \
            *(u32x4*)(Y + (size_t)(b * T_ + 64 * (nn) + row_) * D_ + 256 + h * 128 + 64 * dvh + c8_) = *(const LAS u32x4*)(ob_ + row_ * 72 + c8_); } } while (0)
        if (producer) {
            int pt_ = ptid; asm volatile("" : "+v"(pt_));
            u32x4 tq[4], tk[4], tw[4], tu[4], tqk[2];
            const int prow = pt_ >> 4, pc8 = (pt_ & 15) * 8;
            const int qrow = pt_ >> 3, qc8 = (pt_ & 7) * 8;
            GDN_LOAD_TILES(0); GDN_STORE_TILES();
            for (int n = 0; n < 128; ++n) {
                LDS_BARRIER();
                if (n + 1 < 128) GDN_LOAD_TILES(n + 1);
                if (n >= 1) GDN_STORE_O(n - 1);
                LDS_BARRIER();
                if (n + 1 < 128) GDN_STORE_TILES();
            }
            LDS_BARRIER();
            GDN_STORE_O(127);
        } else {
            f32x16 S[4];
#pragma unroll
            for (int i = 0; i < 4; ++i) S[i] = (f32x16){};
            float gtn = GC[(size_t)bh * 128];
            for (int n = 0; n < 128; ++n) {
                LDS_BARRIER();
                if (c.wave < 2) {
                const float gt = gtn; if (n + 1 < 128) gtn = GC[(size_t)bh * 128 + n + 1];
                f32x16 av[2];
#pragma unroll
                for (int tc = 0; tc < 2; ++tc)
#pragma unroll
                    for (int r = 0; r < 16; ++r) av[tc][r] = bf2f(UT[(32 * tc + crow(r, hh)) * 136 + e0 + l31]);
                f32x16 ao[2] = {(f32x16){}, (f32x16){}};
                bf16x8 fa[8], fb[8];
#define GDN_LDF_WQ(F, td_) do { _Pragma("unroll") for (int tc = 0; tc < 2; ++tc) _Pragma("unroll") for (int s_ = 0; s_ < 2; ++s_) { const int ko_ = 32 * (td_) + 16 * s_ + 4 * hh; \
                    F[tc * 2 + s_] = ldA_perm(WNs + (32 * tc + l31) * 136 + ko_); F[4 + tc * 2 + s_] = ldA_perm(QD + (32 * tc + l31) * 136 + ko_); } } while (0)
#define GDN_MMA_WQ(F, td_) do { const bf16x8 sb0_ = pkfrag(S[td_], 0), sb1_ = pkfrag(S[td_], 1); \
                    av[0] = __builtin_amdgcn_mfma_f32_32x32x16_bf16(F[0], sb0_, av[0], 0, 0, 0); ao[0] = __builtin_amdgcn_mfma_f32_32x32x16_bf16(F[4], sb0_, ao[0], 0, 0, 0); \
                    av[1] = __builtin_amdgcn_mfma_f32_32x32x16_bf16(F[2], sb0_, av[1], 0, 0, 0); ao[1] = __builtin_amdgcn_mfma_f32_32x32x16_bf16(F[6], sb0_, ao[1], 0, 0, 0); \
                    av[0] = __builtin_amdgcn_mfma_f32_32x32x16_bf16(F[1], sb1_, av[0], 0, 0, 0); ao[0] = __builtin_amdgcn_mfma_f32_32x32x16_bf16(F[5], sb1_, ao[0], 0, 0, 0); \
                    av[1] = __builtin_amdgcn_mfma_f32_32x32x16_bf16(F[3], sb1_, av[1], 0, 0, 0); ao[1] = __builtin_amdgcn_mfma_f32_32x32x16_bf16(F[7], sb1_, ao[1], 0, 0, 0); } while (0)
                GDN_LDF_WQ(fa, 0);
                GDN_LDF_WQ(fb, 1); GDN_MMA_WQ(fa, 0);
                GDN_LDF_WQ(fa, 2); GDN_MMA_WQ(fb, 1);
                GDN_LDF_WQ(fb, 3); GDN_MMA_WQ(fa, 2);
#pragma unroll
                for (int tc = 0; tc < 2; ++tc)
#pragma unroll
                    for (int ts = 0; ts < 2; ++ts)
#pragma unroll
                        for (int s_ = 0; s_ < 2; ++s_) fa[tc * 4 + ts * 2 + s_] = ldA_perm(QK + (32 * tc + l31) * 72 + 32 * ts + 16 * s_ + 4 * hh);
                GDN_MMA_WQ(fb, 3);
#undef GDN_LDF_WQ
#undef GDN_MMA_WQ
                bf16x8 Vb[2][2];
#pragma unroll
                for (int tc = 0; tc < 2; ++tc) { Vb[tc][0] = pkfrag(av[tc], 0); Vb[tc][1] = pkfrag(av[tc], 1); }
#define GDN_LDF_K(F, tdp_) do { _Pragma("unroll") for (int t2_ = 0; t2_ < 2; ++t2_) _Pragma("unroll") for (int tc = 0; tc < 2; ++tc) _Pragma("unroll") for (int s_ = 0; s_ < 2; ++s_) \
                    F[t2_ * 4 + tc * 2 + s_] = ldA_perm(KDT + (32 * (2 * (tdp_) + t2_) + l31) * 72 + 32 * tc + 16 * s_ + 4 * hh); } while (0)
#define GDN_MMA_K(F, tdp_) do { S[2 * (tdp_)] = S[2 * (tdp_)] * gt; S[2 * (tdp_) + 1] = S[2 * (tdp_) + 1] * gt; \
                    _Pragma("unroll") for (int tc = 0; tc < 2; ++tc) _Pragma("unroll") for (int s_ = 0; s_ < 2; ++s_) _Pragma("unroll") for (int t2_ = 0; t2_ < 2; ++t2_) \
                        S[2 * (tdp_) + t2_] = __builtin_amdgcn_mfma_f32_32x32x16_bf16(F[t2_ * 4 + tc * 2 + s_], Vb[tc][s_], S[2 * (tdp_) + t2_], 0, 0, 0); } while (0)
                GDN_LDF_K(fb, 0);
#pragma unroll
                for (int ts = 0; ts < 2; ++ts)
#pragma unroll
                    for (int s_ = 0; s_ < 2; ++s_)
#pragma unroll
                        for (int tc = 0; tc < 2; ++tc) ao[tc] = __builtin_amdgcn_mfma_f32_32x32x16_bf16(fa[tc * 4 + ts * 2 + s_], Vb[ts][s_], ao[tc], 0, 0, 0);
                GDN_LDF_K(fa, 1); GDN_MMA_K(fb, 0);
                GDN_MMA_K(fa, 1);
#undef GDN_LDF_K
#undef GDN_MMA_K
                LAS bf16_t* ob = OTb + (n & 1) * 4608;
#pragma unroll
                for (int tc = 0; tc < 2; ++tc)
#pragma unroll
                    for (int r = 0; r < 16; ++r) ob[(32 * tc + crow(r, hh)) * 72 + 32 * (c.wave & 1) + l31] = f2bf(ao[tc][r]);
                }
                LDS_BARRIER();
            }
            LDS_BARRIER();
        }
        __syncthreads();
#undef GDN_LOAD_TILES
#undef GDN_STORE_TILES
#undef GDN_STORE_O
    }
}
__device__ __forceinline__ void gdn_post(const Ctx& c, const Params& p, int e) {
    const bf16_t* Z = (const bf16_t*)(c.ws + WS_Z); bf16_t* Y = (bf16_t*)(c.ws + WS_AB); const float* onorm = p.in[c.zo + 11] + (size_t)e * 128;
    const int NT = c.G * 512, total = M_ * 24;
    for (int it = c.bid * 512 + c.tid; it < total; it += NT) { const int part = it & 3, h = (it >> 2) % 6, m = (it >> 2) / 6;
        bf16_t* yo = Y + (size_t)m * D_ + 256 + h * 128 + 32 * part; const bf16_t* zg = Z + (size_t)m * ZLD_E + 3072 + h * 128 + 32 * part; const float* on = onorm + 32 * part;
        float ov[32]; float ss = 0.f;
#pragma unroll
        for (int k = 0; k < 4; ++k) unpack8(*(const u32x4*)(yo + 8 * k), ov + 8 * k);
#pragma unroll
        for (int k = 0; k < 32; ++k) ss += ov[k] * ov[k];
        ss += __shfl_xor(ss, 1); ss += __shfl_xor(ss, 2);
        const float rn = rsqrtf(ss * (1.f / 128.f) + 1e-6f);
#pragma unroll
        for (int k = 0; k < 4; ++k) { float gz[8], out[8]; unpack8(*(const u32x4*)(zg + 8 * k), gz);
#pragma unroll
            for (int i = 0; i < 8; ++i) out[i] = ov[8 * k + i] * rn * on[8 * k + i] * siluf_(gz[i]);
            *(u32x4*)(yo + 8 * k) = pack8(out); } }
}

__device__ __forceinline__ float lerp_prev(const bf16_t* zp, int ld, int t, float mu) { const float z = bf2f(zp[0]); const float zq = (t > 0) ? bf2f(*(zp - ld)) : 0.f; return z + mu * (zq - z); }

__device__ __forceinline__ void odd_prep_a(const Ctx& c, const Params& p, int o) {
    const bf16_t* Z2 = (const bf16_t*)(c.ws + WS_Z2); bf16_t* LA = (bf16_t*)(c.ws + WS_LA); bf16_t* KR = (bf16_t*)(c.ws + WS_KR); float* RS = (float*)(c.ws + WS_RS);
    const float* mu = p.in[c.zo + 14] + (size_t)o * 1792; const float* vmu = o ? p.in[c.zo + 26] + (size_t)(o - 1) * 32 : p.in[c.zo + 26];
    if (c.bid == 0 && c.tid == 0) { unsigned* ctl = (unsigned*)(c.ws + WS_CTL); ctl[64 * o] = 0u; ctl[64 * o + 16] = 0u; }
    const int grp = c.lane; const int kind = grp < 8 ? 0 : grp < 16 ? 1 : grp < 32 ? 2 : grp < 36 ? 3 : 4;
    const int zc = (kind < 3) ? 8 * grp : 1056 + 8 * (grp - 32);
    float mv[8];
#pragma unroll
    for (int i = 0; i < 8; ++i) mv[i] = (kind < 3) ? mu[1536 + 8 * grp + i] : (kind == 3 ? vmu[8 * (grp - 32) + i] : 0.f);
    for (int m = c.gw; m < M_; m += c.ngw) { const int t = m & (T_ - 1); const bf16_t* zr = Z2 + (size_t)m * Z2_LD;
        if (grp < 48) { float out[8];
#pragma unroll
            for (int i = 0; i < 8; ++i) out[i] = 0.f;
            if (kind < 3 || (kind == 3 && o > 0)) { float cu[8], pv[8]; unpack8(*(const u32x4*)(zr + zc), cu);
                if (t > 0) unpack8(*(const u32x4*)(zr + zc - Z2_LD), pv); else {
#pragma unroll
                    for (int i = 0; i < 8; ++i) pv[i] = 0.f; }
#pragma unroll
                for (int i = 0; i < 8; ++i) { const float x = cu[i] + mv[i] * (pv[i] - cu[i]); out[i] = (kind == 0) ? tanhf(x) : (kind == 2 ? sigmoidf_(x) : x); } }
            *(u32x4*)(LA + (size_t)m * 384 + 8 * grp) = pack8(out); }
        if (c.lane < 32) KR[(size_t)m * 32 + c.lane] = zr[1024 + c.lane];
        float f[8]; unpack8(*(const u32x4*)(zr + 256 + 8 * c.lane), f); float s1 = 0.f;
#pragma unroll
        for (int i = 0; i < 8; ++i) s1 += f[i] * f[i];
        const u32x2 kvv = *(const u32x2*)(zr + 768 + 4 * c.lane);
        const float k0 = asf(kvv.x << 16), k1 = asf(kvv.x & 0xffff0000u), k2 = asf(kvv.y << 16), k3 = asf(kvv.y & 0xffff0000u);
        float s2 = (k0 * k0 + k1 * k1) + (k2 * k2 + k3 * k3);
        s1 = wave_sum_dpp(s1); s2 = wave_sum_dpp(s2);
        if (c.lane == 0) { RS[2 * m] = rsqrtf(s1 * (1.f / 512.f) + 1e-6f); RS[2 * m + 1] = rsqrtf(s2 * (1.f / 256.f) + 1e-6f); } }
}

__device__ __forceinline__ void rwkv_bnd_copy(const Ctx& c, const Params& p) {
    const bf16_t* RKV = (const bf16_t*)(c.ws + WS_RKV); bf16_t* BND = (bf16_t*)(c.ws + WS_BND);
    const int NT = c.G * 512, total = 1024 * 192;
    for (int it = c.bid * 512 + c.tid; it < total; it += NT) { const int rg = it / 192, c8 = (it % 192) * 8;
        if ((rg & 255) == 0) continue;
        *(u32x4*)(BND + (size_t)rg * 1536 + c8) = *(const u32x4*)(RKV + (size_t)(32 * rg - 1) * RKV_LD + c8); }
}
__device__ __forceinline__ void unpack4(u32x2 v, float* f) { f[0] = asf(v.x << 16); f[1] = asf(v.x & 0xffff0000u); f[2] = asf(v.y << 16); f[3] = asf(v.y & 0xffff0000u); }
__device__ __forceinline__ u32x2 pack4(const float* f) { u32x2 o; o.x = pk2(f[0], f[1]); o.y = pk2(f[2], f[3]); return o; }
__device__ __forceinline__ void rwkv_prep(const Ctx& c, const Params& p, int o) {
    bf16_t* RKV = (bf16_t*)(c.ws + WS_RKV); bf16_t* LO = (bf16_t*)(c.ws + WS_LO); bf16_t* VF = (bf16_t*)(c.ws + WS_VF); bf16_t* Y = (bf16_t*)(c.ws + WS_AB);
    const bf16_t* BND = (const bf16_t*)(c.ws + WS_BND); float* BON = (float*)(c.ws + WS_LA);
    const float* mu = p.in[c.zo + 14] + (size_t)o * 1792; const float* w0 = p.in[c.zo + 15] + (size_t)o * 512; const float* a0 = p.in[c.zo + 17] + (size_t)o * 512;
    const float* k_k = p.in[c.zo + 20] + (size_t)o * 512; const float* k_a = p.in[c.zo + 21] + (size_t)o * 512; const float* r_k = p.in[c.zo + 22] + (size_t)o * 512;
    const float* v0p = o ? p.in[c.zo + 27] + (size_t)(o - 1) * 512 : p.in[c.zo + 27];
    for (int item = c.gw; item < 2048; item += c.ngw) { const int rg = item >> 1, hf = item & 1, m0 = 32 * rg; const bool seq0 = (rg & 255) == 0;
        int ln_ = c.lane; asm volatile("" : "+v"(ln_));
        const int h = 4 * hf + (ln_ >> 4), c4 = h * 64 + 4 * (ln_ & 15);
        const f32x4 mur = *(const f32x4*)(mu + c4), muk = *(const f32x4*)(mu + 512 + c4), muv = *(const f32x4*)(mu + 1024 + c4), w0c = *(const f32x4*)(w0 + c4), a0c = *(const f32x4*)(a0 + c4);
        const f32x4 kkc = *(const f32x4*)(k_k + c4), kac = *(const f32x4*)(k_a + c4), v0c = *(const f32x4*)(v0p + c4), rkc = *(const f32x4*)(r_k + c4);
        u32x2 cr, ck, cv, pr, pk, pv, wl, al, vl = {}, vf = {};
        { const bf16_t* zr = RKV + (size_t)(m0 + 31) * RKV_LD + c4; cr = *(const u32x2*)zr; ck = *(const u32x2*)(zr + 512); cv = *(const u32x2*)(zr + 1024);
          const bf16_t* zq = zr - RKV_LD; pr = *(const u32x2*)zq; pk = *(const u32x2*)(zq + 512); pv = *(const u32x2*)(zq + 1024);
          const bf16_t* lo = LO + (size_t)(m0 + 31) * 2048 + c4; wl = *(const u32x2*)lo; al = *(const u32x2*)(lo + 512); if (o) { vl = *(const u32x2*)(lo + 1536); vf = *(const u32x2*)(VF + (size_t)(m0 + 31) * 512 + c4); } }
#pragma unroll 2
        for (int tt = 31; tt >= 0; --tt) { const int m = m0 + tt;
            u32x2 qr = {}, qk = {}, qv = {}, nwl = {}, nal = {}, nvl = {}, nvf = {};
            if (tt >= 2) { const bf16_t* zq = RKV + (size_t)(m - 2) * RKV_LD + c4; qr = *(const u32x2*)zq; qk = *(const u32x2*)(zq + 512); qv = *(const u32x2*)(zq + 1024); }
            else if (tt == 1 && !seq0) { const bf16_t* zq = BND + (size_t)rg * 1536 + c4; qr = *(const u32x2*)zq; qk = *(const u32x2*)(zq + 512); qv = *(const u32x2*)(zq + 1024); }
            if (tt >= 1) { const bf16_t* ln = LO + (size_t)(m - 1) * 2048 + c4; nwl = *(const u32x2*)ln; nal = *(const u32x2*)(ln + 512); if (o) { nvl = *(const u32x2*)(ln + 1536); nvf = *(const u32x2*)(VF + (size_t)(m - 1) * 512 + c4); } }
            const bool has_prev = (tt > 0) || !seq0;
            float fcr[4], fck[4], fcv[4], fpr[4], fpk[4], fpv[4], fwl[4], fal[4], fvl[4], fvf[4];
            unpack4(cr, fcr); unpack4(ck, fck); unpack4(cv, fcv); unpack4(pr, fpr); unpack4(pk, fpk); unpack4(pv, fpv); unpack4(wl, fwl); unpack4(al, fal); unpack4(vl, fvl); unpack4(vf, fvf);
            float r_[4], kx_[4], v_[4], ew_[4], ka_[4], kq_[4], a_[4]; float ss = 0.f, bs = 0.f;
#pragma unroll
            for (int j = 0; j < 4; ++j) { const float xr = has_prev ? fpr[j] : 0.f, xk = has_prev ? fpk[j] : 0.f, xv = has_prev ? fpv[j] : 0.f;
                r_[j] = fcr[j] + mur[j] * (xr - fcr[j]); const float kr = fck[j] + muk[j] * (xk - fck[j]); float v = fcv[j] + muv[j] * (xv - fcv[j]);
                const float wlog = -softplusf_(-(w0c[j] + fwl[j])) - 0.5f; ew_[j] = __expf(wlog);
                a_[j] = sigmoidf_(a0c[j] + fal[j]);
                kq_[j] = kr * kkc[j]; ss += kq_[j] * kq_[j];
                kx_[j] = kr * (1.f + (a_[j] - 1.f) * kac[j]);
                if (o) v = v + (fvf[j] - v) * sigmoidf_(v0c[j] + fvl[j]);
                v_[j] = v; bs += r_[j] * kx_[j] * rkc[j]; }
            ss = sum16_dpp(ss); bs = sum16_dpp(bs);
            const float rn = rsqrtf(ss + 1e-6f); float kk_[4];
#pragma unroll
            for (int j = 0; j < 4; ++j) { kk_[j] = kq_[j] * rn; ka_[j] = kk_[j] * a_[j]; }
            if (o == 0) *(u32x2*)(VF + (size_t)m * 512 + c4) = pack4(v_);
            bf16_t* zr = RKV + (size_t)m * RKV_LD + c4; *(u32x2*)zr = pack4(r_); *(u32x2*)(zr + 512) = pack4(kx_); *(u32x2*)(zr + 1024) = pack4(v_);
            bf16_t* lo = LO + (size_t)m * 2048 + c4; *(u32x2*)lo = pack4(ew_); *(u32x2*)(lo + 512) = pack4(ka_); *(u32x2*)(Y + (size_t)m * D_ + c4) = pack4(kk_);
            if ((ln_ & 15) == 0) BON[(size_t)m * 8 + h] = bs;
            cr = pr; ck = pk; cv = pv; pr = qr; pk = qk; pv = qv; wl = nwl; al = nal; vl = nvl; vf = nvf; } }
}
struct RwkvRegs { unsigned short vr[8], vx[8], vv[8], ve[8], va[8], vk[8]; };
__device__ __forceinline__ void rwkv_load_chunk(RwkvRegs& R, int n, int pw, int b, int col, const bf16_t* RKV, const bf16_t* LO, const bf16_t* Y) {
#pragma unroll
    for (int i = 0; i < 8; ++i) { const int tt = pw + 4 * i, m = b * T_ + 32 * n + tt; const bf16_t* zr = RKV + (size_t)m * RKV_LD; const bf16_t* lo = LO + (size_t)m * 2048;
        R.vr[i] = zr[col]; R.vx[i] = zr[512 + col]; R.vv[i] = zr[1024 + col]; R.ve[i] = lo[col]; R.va[i] = lo[512 + col]; R.vk[i] = Y[(size_t)m * D_ + col]; }
}
__device__ __forceinline__ void rwkv_write_chunk(LAS float* L, const RwkvRegs& R, int n, int pw, int lane) {
    LAS float* st = L + (n & 1) * 12288;
#pragma unroll
    for (int i = 0; i < 8; ++i) { const int tt = pw + 4 * i; LAS float* q = st + tt * 64 + lane;
        q[0] = bf2f(R.vr[i]); q[2048] = __expf(-bf2f(R.ve[i])); q[4096] = bf2f(R.vx[i]); q[6144] = bf2f(R.vk[i]); q[8192] = bf2f(R.va[i]); q[10240] = bf2f(R.vv[i]); }
}
__device__ __forceinline__ void rwkv_store_chunk(const LAS float* L, int n, int pw, int lane, int b, int col, bf16_t* YR, int half) {
    const LAS float* sY = L + 24576 + (n & 1) * 2048;
#pragma unroll
    for (int i = 0; i < 8; ++i) { const int tt = pw + 4 * i, m = b * T_ + 32 * n + tt; if ((lane >> 4) == half) YR[(size_t)m * 2048 + 1536 + col] = f2bf(sY[tt * 64 + lane]); }
}
__device__ __forceinline__ void rwkv_scan(const Ctx& c, const Params& p, int o, int nblk) {
    const bf16_t* RKV = (const bf16_t*)(c.ws + WS_RKV); const bf16_t* LO = (const bf16_t*)(c.ws + WS_LO); bf16_t* Y = (bf16_t*)(c.ws + WS_AB);
    LAS float* L = (LAS float*)(c.lds);
    const bool producer = c.wave >= 4;
    for (int item = c.bid; item < 128; item += nblk) {
        const int bh = item >> 2, half = item & 3, b = bh >> 3, h = bh & 7; const int col = h * 64 + c.lane;
        if (producer) {
            const int pw = c.wave - 4;
            RwkvRegs R;
            rwkv_load_chunk(R, 0, pw, b, col, RKV, LO, Y); rwkv_write_chunk(L, R, 0, pw, c.lane);
            rwkv_load_chunk(R, 1, pw, b, col, RKV, LO, Y);
            for (int n = 0; n < 256; ++n) {
                LDS_BARRIER();
                if (n + 1 < 256) rwkv_write_chunk(L, R, n + 1, pw, c.lane);
                if (n + 2 < 256) rwkv_load_chunk(R, n + 2, pw, b, col, RKV, LO, Y);
                if (n >= 1) rwkv_store_chunk(L, n - 1, pw, c.lane, b, col, (bf16_t*)LO, half);
            }
            LDS_BARRIER();
            rwkv_store_chunk(L, 255, pw, c.lane, b, col, (bf16_t*)LO, half);
        } else {
            f32x2 s2[2];
            s2[0] = (f32x2){0.f, 0.f}; s2[1] = (f32x2){0.f, 0.f};
            const int row = 16 * half + 4 * c.wave + (c.lane >> 4), kq = c.lane & 15;
            for (int n = 0; n < 256; ++n) {
                LDS_BARRIER();
                const LAS float* st = L + (n & 1) * 12288 + 4 * kq; const LAS float* sV = L + (n & 1) * 12288 + 10240 + row; LAS float* sY = L + 24576 + (n & 1) * 2048 + row;
                float yreg[32];
#pragma unroll
                for (int tt = 0; tt < 32; ++tt) { const LAS float* q4 = st + tt * 64;
                    const f32x4 rr = *(const LAS f32x4*)(q4), wd = *(const LAS f32x4*)(q4 + 2048), kx = *(const LAS f32x4*)(q4 + 4096), kk = *(const LAS f32x4*)(q4 + 6144), ka = *(const LAS f32x4*)(q4 + 8192);
                    const float vv = sV[tt * 64];
#define P2(v4, i) ((f32x2){v4[2 * (i)], v4[2 * (i) + 1]})
                    const f32x2 pa = s2[0] * P2(kk, 0) + s2[1] * P2(kk, 1);
                    float px_ = sum16_dpp(pa.x + pa.y); asm volatile("" : "+v"(px_)); const float sa = -px_;
                    s2[0] = s2[0] * P2(wd, 0) + (P2(ka, 0) * sa + P2(kx, 0) * vv); s2[1] = s2[1] * P2(wd, 1) + (P2(ka, 1) * sa + P2(kx, 1) * vv);
                    const f32x2 ya = s2[0] * P2(rr, 0) + s2[1] * P2(rr, 1);
#undef P2
                    float yx_ = sum16_dpp(ya.x + ya.y); asm volatile("" : "+v"(yx_));
                    yreg[tt] = yx_; }
                if (kq == 0) {
#pragma unroll
                    for (int tt = 0; tt < 32; ++tt) sY[tt * 64] = yreg[tt]; }
            }
            LDS_BARRIER();
        }
        LDS_BARRIER();
    }
}
__device__ __forceinline__ void rwkv_post(const Ctx& c, const Params& p, int o) {
    const bf16_t* RKV = (const bf16_t*)(c.ws + WS_RKV); const bf16_t* LO = (const bf16_t*)(c.ws + WS_LO); bf16_t* Y = (bf16_t*)(c.ws + WS_AB);
    const float* lnw = p.in[c.zo + 23] + (size_t)o * 512; const float* lnb = p.in[c.zo + 24] + (size_t)o * 512; const float* BON = (const float*)(c.ws + WS_LA);
    const int h = c.lane >> 3, c8 = h * 64 + 8 * (c.lane & 7);
    float lw[8], lb[8];
#pragma unroll
    for (int i = 0; i < 8; ++i) { lw[i] = lnw[c8 + i]; lb[i] = lnb[c8 + i]; }
    for (int m = c.gw; m < M_; m += c.ngw) { const bf16_t* lo = LO + (size_t)m * 2048;
        float y[8], v[8], g[8]; unpack8(*(const u32x4*)(lo + 1536 + c8), y); unpack8(*(const u32x4*)(RKV + (size_t)m * RKV_LD + 1024 + c8), v); unpack8(*(const u32x4*)(lo + 1024 + c8), g);
        const float bon = BON[(size_t)m * 8 + h];
        float s1 = 0.f;
#pragma unroll
        for (int i = 0; i < 8; ++i) s1 += y[i];
        const float mean = sum8_dpp(s1) * (1.f / 64.f); float s2 = 0.f;
#pragma unroll
        for (int i = 0; i < 8; ++i) { y[i] -= mean; s2 += y[i] * y[i]; }
        const float rs = rsqrtf(sum8_dpp(s2) * (1.f / 64.f) + 64e-5f); float out[8];
#pragma unroll
        for (int i = 0; i < 8; ++i) out[i] = (y[i] * rs * lw[i] + lb[i] + bon * v[i]) * g[i];
        *(u32x4*)(Y + (size_t)m * D_ + c8) = pack8(out); }
}

__device__ __forceinline__ void mla_prep(const Ctx& c, const Params& p, int o) {
    bf16_t* QR = (bf16_t*)(c.ws + WS_QR); const bf16_t* KVR = (const bf16_t*)(c.ws + WS_KVR); const bf16_t* KR = (const bf16_t*)(c.ws + WS_KR); const float* RS = (const float*)(c.ws + WS_RS);
    bf16_t* KH = (bf16_t*)(c.ws + WS_KH); bf16_t* VT = (bf16_t*)(c.ws + WS_VT);
    const float* qln = p.in[c.zo + 33] + (size_t)o * 96; const float* kln = p.in[c.zo + 34] + (size_t)o * 96; const int* pos = (const int*)p.in[c.zo + 1];
    LAS bf16_t* sVT = (LAS bf16_t*)c.lds;
    const int head = c.lane >> 3, sub = c.lane & 7;
    float gqn[8], gkn[8], gq1[2], gq2[2], gk1[2], gk2[2];
#pragma unroll
    for (int i = 0; i < 8; ++i) { gqn[i] = qln[8 * sub + i]; gkn[i] = kln[8 * sub + i]; }
#pragma unroll
    for (int j = 0; j < 2; ++j) { gq1[j] = qln[64 + 2 * sub + j]; gq2[j] = qln[80 + 2 * sub + j]; gk1[j] = kln[64 + 2 * sub + j]; gk2[j] = kln[80 + 2 * sub + j]; }
    const float QSCALE = 0.10206207261596577f * 1.4426950408889634f;
    const float invf = exp2f(-(float)(2 * (c.lane & 15)) * (13.287712379549449f / 32.f));
    for (int tile = c.bid; tile < 512; tile += c.G) { const int m0 = tile * 64;
#pragma unroll 2
        for (int q = 0; q < 8; ++q) { const int tt = c.wave * 8 + q, m = m0 + tt; const float rsq = RS[2 * m], rskv = RS[2 * m + 1];
            float sn_, cs_; sincosf((float)pos[m] * invf, &sn_, &cs_);
            float cs[2], sn[2];
#pragma unroll
            for (int j = 0; j < 2; ++j) { cs[j] = __shfl(cs_, 2 * sub + j); sn[j] = __shfl(sn_, 2 * sub + j); }
            { bf16_t* qp = QR + (size_t)m * 768 + head * 96; float v[8]; unpack8(*(const u32x4*)(qp + 8 * sub), v);
              const unsigned r1 = *(const unsigned*)(qp + 64 + 2 * sub), r2 = *(const unsigned*)(qp + 80 + 2 * sub);
              float x1[2] = {asf(r1 << 16) * rsq, asf(r1 & 0xffff0000u) * rsq}, x2[2] = {asf(r2 << 16) * rsq, asf(r2 & 0xffff0000u) * rsq};
              float ss = x1[0] * x1[0] + x1[1] * x1[1] + x2[0] * x2[0] + x2[1] * x2[1];
#pragma unroll
              for (int i = 0; i < 8; ++i) { v[i] *= rsq; ss += v[i] * v[i]; }
              const float rn = rsqrtf(sum8_dpp(ss) * (1.f / 96.f) + 1e-6f) ;
#pragma unroll
              for (int i = 0; i < 8; ++i) v[i] = v[i] * rn * gqn[i] * QSCALE;
              float o1[2], o2[2];
#pragma unroll
              for (int j = 0; j < 2; ++j) { const float a = x1[j] * rn * gq1[j], bq = x2[j] * rn * gq2[j]; o1[j] = (a * cs[j] - bq * sn[j]) * QSCALE; o2[j] = (bq * cs[j] + a * sn[j]) * QSCALE; }
              *(u32x4*)(qp + 8 * sub) = pack8(v); *(unsigned*)(qp + 64 + 2 * sub) = pk2(o1[0], o1[1]); *(unsigned*)(qp + 80 + 2 * sub) = pk2(o2[0], o2[1]); }
            { const bf16_t* kp = KVR + (size_t)m * 1024 + head * 128; float v[8]; unpack8(*(const u32x4*)(kp + 8 * sub), v);
              const unsigned r1 = *(const unsigned*)(KR + (size_t)m * 32 + 2 * sub), r2 = *(const unsigned*)(KR + (size_t)m * 32 + 16 + 2 * sub);
              float x1[2] = {asf(r1 << 16), asf(r1 & 0xffff0000u)}, x2[2] = {asf(r2 << 16), asf(r2 & 0xffff0000u)};
              float ss = x1[0] * x1[0] + x1[1] * x1[1] + x2[0] * x2[0] + x2[1] * x2[1];
#pragma unroll
              for (int i = 0; i < 8; ++i) { v[i] *= rskv; ss += v[i] * v[i]; }
              const float rn = rsqrtf(sum8_dpp(ss) * (1.f / 96.f) + 1e-6f);
#pragma unroll
              for (int i = 0; i < 8; ++i) v[i] = v[i] * rn * gkn[i];
              float o1[2], o2[2];
#pragma unroll
              for (int j = 0; j < 2; ++j) { const float a = x1[j] * rn * gk1[j], bq = x2[j] * rn * gk2[j]; o1[j] = a * cs[j] - bq * sn[j]; o2[j] = bq * cs[j] + a * sn[j]; }
              bf16_t* ko = KH + (size_t)m * 768 + head * 96;
              *(u32x4*)(ko + 8 * sub) = pack8(v); *(unsigned*)(ko + 64 + 2 * sub) = pk2(o1[0], o1[1]); *(unsigned*)(ko + 80 + 2 * sub) = pk2(o2[0], o2[1]);
              float vv[8]; unpack8(*(const u32x4*)(kp + 64 + 8 * sub), vv);
#pragma unroll
              for (int i = 0; i < 8; ++i) sVT[(head * 64 + 8 * sub + i) * 72 + tt] = f2bf(vv[i] * rskv); } }
        __syncthreads();
        { const int row = c.tid; const int b = m0 / T_, t0 = m0 & (T_ - 1); bf16_t* dst = VT + ((size_t)(b * 8) * 64 + row) * T_ + t0;
#pragma unroll
          for (int i = 0; i < 8; ++i) *(u32x4*)(dst + 8 * i) = *(const LAS u32x4*)(sVT + row * 72 + 8 * i); }
        __syncthreads();
    }
}

__device__ __forceinline__ void attn_phase(const Ctx& c, const Params& p, int o, int first, int cidx) {
    const bf16_t* QH = (const bf16_t*)(c.ws + WS_QR); const bf16_t* KH = (const bf16_t*)(c.ws + WS_KH); const bf16_t* VT = (const bf16_t*)(c.ws + WS_VT); bf16_t* Y = (bf16_t*)(c.ws + WS_AB);
    const int l31 = c.lane & 31, hh = c.lane >> 5;
    if (c.bid < first) return;
    unsigned* cnt = (unsigned*)(c.ws + WS_CTL) + 64 * o + 16 * cidx;
    LAS bf16_t* sK = (LAS bf16_t*)(c.lds);
    LAS bf16_t* sVt = (LAS bf16_t*)(c.lds + 26624);
    LAS unsigned* sU = (LAS unsigned*)(c.lds + 26624 + 18432);
    const int k0row = c.tid / 12, k0ch = c.tid % 12; const int k1p = c.tid + 512, k1row = k1p / 12, k1ch = k1p % 12; const bool k1on = c.tid < 256;
    const int vrow = c.tid >> 3, vch = c.tid & 7;
    for (;;) {
        if (c.tid == 0) sU[0] = atomicAdd(cnt, 1u);
        __syncthreads();
        const unsigned uu = sU[0];
        __syncthreads();
        if (uu >= 1024u) break;
        const int bh = uu & 31, b = bh >> 3, h = bh & 7; const int qblk = 31 - (int)(uu >> 5); const int q0 = qblk * 256, qs = q0 + 32 * c.wave;
        bf16x8 qf[6]; { const bf16_t* qp = QH + (size_t)(b * T_ + qs + l31) * 768 + h * 96 + 8 * hh;
#pragma unroll
            for (int ks = 0; ks < 6; ++ks) qf[ks] = *(const bf16x8*)(qp + 16 * ks); }
        f32x16 o0 = {}, o1 = {}; float mrun = -INFINITY, lrun = 0.f;
        const int ntile = 4 * (qblk + 1);
        const bf16_t* kg = KH + (size_t)(b * T_) * 768 + h * 96; const bf16_t* vg = VT + (size_t)bh * 64 * T_;
        u32x4 rk0, rk1 = {}, rv;
        rk0 = *(const u32x4*)(kg + (size_t)k0row * 768 + 8 * k0ch); if (k1on) rk1 = *(const u32x4*)(kg + (size_t)k1row * 768 + 8 * k1ch); rv = *(const u32x4*)(vg + (size_t)vrow * T_ + 8 * vch);
        *(LAS u32x4*)(sK + k0row * 104 + 8 * k0ch) = rk0; if (k1on) *(LAS u32x4*)(sK + k1row * 104 + 8 * k1ch) = rk1; *(LAS u32x4*)(sVt + vrow * 72 + 8 * vch) = rv;
        __syncthreads();
        for (int kt = 0; kt < ntile; ++kt) { const int kv0 = kt * 64; const int buf = kt & 1;
            if (kt + 1 < ntile) { const int kn = kv0 + 64;
                rk0 = *(const u32x4*)(kg + (size_t)(kn + k0row) * 768 + 8 * k0ch); if (k1on) rk1 = *(const u32x4*)(kg + (size_t)(kn + k1row) * 768 + 8 * k1ch); rv = *(const u32x4*)(vg + (size_t)vrow * T_ + kn + 8 * vch); }
            if (kv0 <= qs + 31) {
                const LAS bf16_t* kb = sK + buf * 6656 + l31 * 104 + 8 * hh; const LAS bf16_t* vb = sVt + buf * 4608 + l31 * 72 + 4 * hh;
                f32x16 p0 = {}, p1 = {};
#pragma unroll
                for (int ks = 0; ks < 6; ++ks) { const bf16x8 k0 = *(const LAS bf16x8*)(kb + 16 * ks); const bf16x8 k1 = *(const LAS bf16x8*)(kb + 32 * 104 + 16 * ks);
                    p0 = __builtin_amdgcn_mfma_f32_32x32x16_bf16(k0, qf[ks], p0, 0, 0, 0); p1 = __builtin_amdgcn_mfma_f32_32x32x16_bf16(k1, qf[ks], p1, 0, 0, 0); }
                if (kv0 + 63 > qs) { const int q = qs + l31;
#pragma unroll
                    for (int r = 0; r < 16; ++r) { const int kv = kv0 + crow(r, hh); if (kv > q) p0[r] = -INFINITY; if (kv + 32 > q) p1[r] = -INFINITY; } }
                float mxa = fmaxf(fmaxf(p0[0], p1[0]), p0[1]), mxb = fmaxf(fmaxf(p1[1], p0[2]), p1[2]);
#pragma unroll
                for (int r = 3; r < 15; r += 2) { mxa = fmaxf(fmaxf(mxa, p0[r]), p1[r]); mxb = fmaxf(fmaxf(mxb, p0[r + 1]), p1[r + 1]); }
                float mx = fmaxf(fmaxf(mxa, mxb), fmaxf(p0[15], p1[15]));
                { auto rr = __builtin_amdgcn_permlane32_swap(asu(mx), asu(mx), false, false); mx = fmaxf(asf(rr[0]), asf(rr[1])); }
                const float mnew = fmaxf(mrun, mx);
                if (__any(mnew > mrun)) { const float alpha = __builtin_amdgcn_exp2f(mrun - mnew); lrun *= alpha; o0 = o0 * alpha; o1 = o1 * alpha; }
                mrun = mnew;
                f32x16 e0, e1;
#pragma unroll
                for (int r = 0; r < 16; ++r) { e0[r] = __builtin_amdgcn_exp2f(p0[r] - mnew); e1[r] = __builtin_amdgcn_exp2f(p1[r] - mnew); }
                p0 = e0; p1 = e1;
                { const f32x16 t = e0 + e1; lrun += ((t[0] + t[1]) + (t[2] + t[3])) + ((t[4] + t[5]) + (t[6] + t[7])) + ((t[8] + t[9]) + (t[10] + t[11])) + ((t[12] + t[13]) + (t[14] + t[15])); }
                const bf16x8 pf00 = pkfrag(p0, 0), pf01 = pkfrag(p0, 1), pf10 = pkfrag(p1, 0), pf11 = pkfrag(p1, 1);
#define PV_STEP(OACC, mm, ktt, ss, PF) do { OACC = __builtin_amdgcn_mfma_f32_32x32x16_bf16(ldA_perm(vb + (mm) * 32 * 72 + 32 * (ktt) + 16 * (ss)), PF, OACC, 0, 0, 0); } while (0)
                PV_STEP(o0, 0, 0, 0, pf00); PV_STEP(o0, 0, 0, 1, pf01); PV_STEP(o0, 0, 1, 0, pf10); PV_STEP(o0, 0, 1, 1, pf11);
                PV_STEP(o1, 1, 0, 0, pf00); PV_STEP(o1, 1, 0, 1, pf01); PV_STEP(o1, 1, 1, 0, pf10); PV_STEP(o1, 1, 1, 1, pf11);
#undef PV_STEP
            }
            if (kt + 1 < ntile) { const int nb = buf ^ 1;
                *(LAS u32x4*)(sK + nb * 6656 + k0row * 104 + 8 * k0ch) = rk0; if (k1on) *(LAS u32x4*)(sK + nb * 6656 + k1row * 104 + 8 * k1ch) = rk1; *(LAS u32x4*)(sVt + nb * 4608 + vrow * 72 + 8 * vch) = rv; }
            __syncthreads();
        }
        float l; { auto rr = __builtin_amdgcn_permlane32_swap(asu(lrun), asu(lrun), false, false); l = asf(rr[0]) + asf(rr[1]); }
        const float inv = 1.f / l;
        bf16_t* yo = Y + (size_t)(b * T_ + qs + l31) * D_ + 512 + h * 64;
#pragma unroll
        for (int r = 0; r < 16; ++r) { yo[crow(r, hh)] = f2bf(o0[r] * inv); yo[32 + crow(r, hh)] = f2bf(o1[r] * inv); }
    }
}

#define XB_TMO      128
#define XB_XCNT(j)  (256  + 64 * (j))
#define XB_XSUB(j)  (1280 + 64 * (j))
#define XB_XGEN(j)  (2304 + 64 * (j))
#define XB_TOP      3328
#define XB_TOPGEN   3392
#define XCD_BAR_WORDS 3456
#define XB_SPIN_CAP (1u << 22)
__device__ __forceinline__ unsigned xb_ld(unsigned* p)              { return __hip_atomic_load(p, __ATOMIC_RELAXED, __HIP_MEMORY_SCOPE_AGENT); }
__device__ __forceinline__ unsigned xb_add(unsigned* p, unsigned v) { return __hip_atomic_fetch_add(p, v, __ATOMIC_RELAXED, __HIP_MEMORY_SCOPE_AGENT); }
__device__ __forceinline__ unsigned xb_xcc_id() { return (unsigned)__builtin_amdgcn_s_getreg((3 << 11) | 20) & 0xFu; }
#define XB_SPIN(cond, bar) do { unsigned _sp = 0; while (cond) { __builtin_amdgcn_s_sleep(1); \
    if ((++_sp & 255u) == 0u) { if (xb_ld(&(bar)[XB_TMO])) break; if (_sp > XB_SPIN_CAP) { atomicAdd(&(bar)[XB_TMO], 1u); break; } } } } while (0)
struct XcdBarrier { unsigned* bar; unsigned x; volatile LAS unsigned* st; };
__device__ __forceinline__ XcdBarrier xcd_barrier_post(unsigned* bar, volatile LAS unsigned* st) {
    XcdBarrier b; b.bar = bar; b.x = xb_xcc_id(); b.st = st;
    if (threadIdx.x == 0) (void)xb_add(&bar[XB_XCNT(b.x)], 1u);
    return b;
}
__device__ __forceinline__ void xcd_barrier_complete(unsigned* bar, unsigned x, unsigned& nloc, unsigned& nx) {
    const unsigned G = gridDim.x * gridDim.y * gridDim.z;
    unsigned sum, cnt, mine, sp = 0u;
    for (;;) {
        sum = 0u; cnt = 0u; mine = 0u;
#pragma unroll
        for (unsigned j = 0; j < 16; ++j) { const unsigned c = xb_ld(&bar[XB_XCNT(j)]); sum += c; cnt += (c > 0u) ? 1u : 0u; mine = (j == x) ? c : mine; }
        if (sum == G) break;
        __builtin_amdgcn_s_sleep(1);
        if ((++sp & 255u) == 0u) { if (xb_ld(&bar[XB_TMO])) break; if (sp > XB_SPIN_CAP) { atomicAdd(&bar[XB_TMO], 1u); break; } }
    }
    nloc = mine > 0u ? mine : 1u; nx = cnt > 0u ? cnt : 1u;
}
__device__ __forceinline__ void xcd_barrier(const XcdBarrier& b, int wave_s) {
    asm volatile("s_waitcnt vmcnt(0)" ::: "memory");
    __syncthreads();
    int l0_; asm volatile("v_mbcnt_lo_u32_b32 %0, -1, 0\n\tv_mbcnt_hi_u32_b32 %0, -1, %0" : "=v"(l0_));
    if (wave_s == 0 && l0_ == 0) {
        unsigned* bar = b.bar; asm volatile("" : "+s"(bar));
        __builtin_amdgcn_s_waitcnt(0);
        unsigned nloc = b.st[0], nx = b.st[1];
        if (nloc == 0u) { xcd_barrier_complete(bar, b.x, nloc, nx); b.st[0] = nloc; b.st[1] = nx; }
        const unsigned old = xb_add(&bar[XB_XSUB(b.x)], 1u);
        const unsigned gen = old / nloc;
        if (old + 1u == (gen + 1u) * nloc) {
            __builtin_amdgcn_fence(__ATOMIC_RELEASE, "agent");
            asm volatile("s_waitcnt vmcnt(0)" ::: "memory");
            const unsigned og = xb_add(&bar[XB_TOP], 1u);
            const unsigned tg = og / nx;
            if (og + 1u == (tg + 1u) * nx) xb_add(&bar[XB_TOPGEN], 1u);
            else XB_SPIN(xb_ld(&bar[XB_TOPGEN]) == tg, bar);
            __builtin_amdgcn_fence(__ATOMIC_ACQUIRE, "agent");
            xb_add(&bar[XB_XGEN(b.x)], 1u);
            asm volatile("s_waitcnt vmcnt(0)" ::: "memory");
        } else {
            XB_SPIN(xb_ld(&bar[XB_XGEN(b.x)]) == gen, bar);
            __builtin_amdgcn_fence(__ATOMIC_ACQUIRE, "agent");
            asm volatile("s_waitcnt vmcnt(0)" ::: "memory");
        }
    }
    __syncthreads();
}

__global__ void __launch_bounds__(512, 2) fwd_kernel(Params p) {
    extern __shared__ __attribute__((aligned(16))) unsigned char lds_raw[];
    const int wave_s = __builtin_amdgcn_readfirstlane((int)threadIdx.x >> 6);
    const int only = p.only;
#if !MULTI_LAUNCH
    cg::grid_group grid = cg::this_grid();
    { volatile LAS unsigned* misc_ = (volatile LAS unsigned*)((LAS unsigned char*)lds_raw + 131072); if (threadIdx.x < 64) misc_[threadIdx.x] = 0u; }
    __syncthreads();
    (void)xcd_barrier_post((unsigned*)(p.ws + WS_CTL) + 4096, (volatile LAS unsigned*)((LAS unsigned char*)lds_raw + 131072));
#endif
    for (int ph = 0; ph < 44; ++ph) {
        if (only >= 0 && only != ph) continue;
        int zo_ = 0; asm volatile("" : "+s"(zo_));
        int wv_ = wave_s, bid_ = blockIdx.x, G_ = gridDim.x; asm volatile("" : "+s"(wv_), "+s"(bid_), "+s"(G_));
        Ctx c; c.lds = (LAS unsigned char*)lds_raw + zo_;
        { int l_; asm volatile("v_mbcnt_lo_u32_b32 %0, -1, 0\n\tv_mbcnt_hi_u32_b32 %0, -1, %0" : "=v"(l_)); c.lane = l_; c.tid = wv_ * 64 + l_; }
        c.wave = wv_; c.bid = bid_; c.G = G_; c.gw = c.bid * 8 + c.wave; c.ngw = c.G * 8; c.zo = zo_;
        int L, k; if (ph < 10) { L = 0; k = ph; } else if (ph < 22) { L = 1; k = ph - 10; } else if (ph < 32) { L = 2; k = ph - 22; } else { L = 3; k = ph - 32; }
        const uintptr_t wsu_ = (uintptr_t)(*(unsigned char* const*)((const char*)&p.ws + zo_)), outu_ = (uintptr_t)(*(float* const*)((const char*)&p.out + zo_));
        unsigned wlo_ = (unsigned)(wsu_ & 0xffffffffu), whi_ = (unsigned)(wsu_ >> 32), olo_ = (unsigned)(outu_ & 0xffffffffu), ohi_ = (unsigned)(outu_ >> 32);
        wlo_ = (unsigned)__builtin_amdgcn_readfirstlane((int)wlo_); whi_ = (unsigned)__builtin_amdgcn_readfirstlane((int)whi_); olo_ = (unsigned)__builtin_amdgcn_readfirstlane((int)olo_); ohi_ = (unsigned)__builtin_amdgcn_readfirstlane((int)ohi_);
        asm volatile("" : "+s"(wlo_), "+s"(whi_), "+s"(olo_), "+s"(ohi_));
        unsigned char* ws = (unsigned char*)(((uintptr_t)whi_ << 32) | (uintptr_t)wlo_); c.ws = ws; float* xout = (float*)(((uintptr_t)ohi_ << 32) | (uintptr_t)olo_);
        bf16_t* AB = (bf16_t*)(ws + WS_AB); bf16_t* Zb = (bf16_t*)(ws + WS_Z);
        const bf16_t* W_GU = (const bf16_t*)(ws + WS_WB + WB_GU); const bf16_t* W_DN = (const bf16_t*)(ws + WS_WB + WB_DN);
        const bf16_t* W_IN = (const bf16_t*)(ws + WS_WB + WB_IN); const bf16_t* W_OUT = (const bf16_t*)(ws + WS_WB + WB_OUT);
        const bf16_t* W_LORA = (const bf16_t*)(ws + WS_WB + WB_LORA); const bf16_t* W_UQ = (const bf16_t*)(ws + WS_WB + WB_UQ); const bf16_t* W_UKV = (const bf16_t*)(ws + WS_WB + WB_UKV);
        const bool odd = (L & 1) != 0; const int e = L >> 1, o = L >> 1;
        const int kt = odd ? k - 8 : k - 6;
        if (k == 0) {
            const float* xcur = (L == 0) ? p.in[zo_] : xout;
            if (PM & 1) { if (odd) convert_odd(c, p, L); else convert_even(c, p, L); }
            if (PM & 2) rms_rows(c, xcur, p.in[2 + zo_] + (size_t)L * D_, AB, L == 0 ? xout : nullptr);
        } else if (kt == 0) { if (PM & 1024) run_gemm(c, AB, D_, W_OUT, D_, D_, pg8::EpiResid{xout, D_});
        } else if (kt == 1) { if (PM & 2) rms_rows(c, xout, p.in[3 + zo_] + (size_t)L * D_, AB, nullptr);
        } else if (kt == 2) { if (PM & 2048) run_gemm(c, AB, D_, W_GU, 2 * DFF, D_, pg8::EpiSwiglu{Zb, DFF});
        } else if (kt == 3) { if (PM & 1024) run_gemm(c, Zb, DFF, W_DN, D_, DFF, pg8::EpiResid{xout, D_});
        } else if (!odd) {
            if (k == 1) { if (PM & 4) run_gemm(c, AB, D_, W_IN, 4096, D_, pg8::EpiBf16{Zb, ZLD_E, ZLD_E}); }
            else if (k == 2) { if (PM & 8) halo_copy(c, p, e); }
            else if (k == 3) { if (PM & 8) even_prep(c, p, e); }
            else if (k == 4) { if (PM & 16) gdn_scan(c, p, e); }
            else { if (PM & 16) gdn_post(c, p, e); }
        } else {
            if (k == 1) { if (PM & 4) run_gemm(c, AB, D_, W_IN, ZLD_O, D_, pg8::EpiSplit{(bf16_t*)(ws + WS_RKV), RKV_LD, 1536, (bf16_t*)(ws + WS_Z2), Z2_LD, 1536 + Z2_LD}); }
            else if (k == 2) { if (PM & 32) { odd_prep_a(c, p, o); rwkv_bnd_copy(c, p); } }
            else if (k == 3) { if (PM & 4) { run_gemm(c, (const bf16_t*)(ws + WS_LA), 384, W_LORA, o ? 2048 : 1536, 384, pg8::EpiBf16{(bf16_t*)(ws + WS_LO), 2048, 2048});
                       asm volatile("" : "+v"(c.tid));
                       run_gemm(c, (const bf16_t*)(ws + WS_Z2) + 256, Z2_LD, W_UQ, 768, 512, pg8::EpiBf16{(bf16_t*)(ws + WS_QR), 768, 768});
                       asm volatile("" : "+v"(c.tid));
                       run_gemm(c, (const bf16_t*)(ws + WS_Z2) + 768, Z2_LD, W_UKV, 1024, 256, pg8::EpiBf16{(bf16_t*)(ws + WS_KVR), 1024, 1024}); } }
            else if (k == 4) { if (PM & 256) mla_prep(c, p, o); }
            else if (k == 5) { if (PM & 256) rwkv_prep(c, p, o); }
            else if (k == 6) { if (c.bid < SCAN_BLOCKS) { if (PM & 64) rwkv_scan(c, p, o, SCAN_BLOCKS); } if (PM & 512) attn_phase(c, p, o, 0, 0); }
            else { if (PM & 128) rwkv_post(c, p, o); }
        }
#if !MULTI_LAUNCH
        if (ph == 0 && only == -2) grid.sync();
        else if (ph != 43) { XcdBarrier xb; xb.bar = (unsigned*)(ws + WS_CTL) + 4096; xb.x = xb_xcc_id(); xb.st = (volatile LAS unsigned*)((LAS unsigned char*)lds_raw + 131072); xcd_barrier(xb, wave_s); }
#endif
    }
}

constexpr int N_PHASES = 44;

extern "C" void kernel_launch(void* const* d_in, const int* in_sizes, int n_in, void* d_out, int out_size, void* d_ws, size_t ws_size, hipStream_t stream) {
    static int grid = 0;
    if (grid == 0) {
        if (n_in != 36 || ws_size < WS_NEED) { fprintf(stderr, "kernel_launch: unexpected inputs (n_in %d, ws %zu)\n", n_in, ws_size); grid = -1; return; }
        int dev = 0, cus = 0, per_cu = 0;
        hipGetDevice(&dev); hipDeviceGetAttribute(&cus, hipDeviceAttributeMultiprocessorCount, dev);
        hipFuncSetAttribute((const void*)fwd_kernel, hipFuncAttributeMaxDynamicSharedMemorySize, LDS_BYTES);
        hipOccupancyMaxActiveBlocksPerMultiprocessor(&per_cu, (const void*)fwd_kernel, 512, LDS_BYTES);
        (void)hipGetLastError();
        if (per_cu < 1) per_cu = 1;
        grid = cus * 1;
        if (grid <= 0) grid = 256;
    }
    if (grid < 0) return;
    (void)hipMemsetAsync(d_ws, 0, 65536, stream);
    Params prm{};
    for (int i = 0; i < 36; ++i) prm.in[i] = (const float*)d_in[i];
    prm.out = (float*)d_out; prm.ws = (unsigned char*)d_ws; prm.only = -1; prm.pad = 0;
#if MULTI_LAUNCH
    for (int ph = 0; ph < N_PHASES; ++ph) { prm.only = ph; hipLaunchKernelGGL(fwd_kernel, dim3(grid), dim3(512), LDS_BYTES, stream, prm); }
#else
    void* args[] = {&prm};
    hipError_t e = hipLaunchCooperativeKernel((const void*)fwd_kernel, dim3(grid), dim3(512), args, LDS_BYTES, stream);
    if (e != hipSuccess) fprintf(stderr, "cooperative launch failed: %s (grid %d)\n", hipGetErrorString(e), grid);
#endif
}
```

```cpp
#include <hip/hip_runtime.h>
#include <hip/hip_cooperative_groups.h>
#include <cstdint>
#include <cstdio>
namespace cg = cooperative_groups;

#ifndef MULTI_LAUNCH
#define MULTI_LAUNCH 0
#endif

#ifndef PHASE_MASK
#define PHASE_MASK 0xFFFF
#endif
constexpr int PM = PHASE_MASK;
#ifndef DUP_MASK
#define DUP_MASK 0
#endif
constexpr int DM = DUP_MASK;
#define LAS __attribute__((address_space(3)))
typedef unsigned short bf16_t;
typedef short bf16x8 __attribute__((ext_vector_type(8)));
typedef short s16x4 __attribute__((ext_vector_type(4)));
typedef float f32x4 __attribute__((ext_vector_type(4)));
typedef float f32x2 __attribute__((ext_vector_type(2)));
typedef float f32x16 __attribute__((ext_vector_type(16)));
typedef unsigned u32x4 __attribute__((ext_vector_type(4)));
typedef unsigned u32x2 __attribute__((ext_vector_type(2)));
typedef __bf16 bf16x2_t __attribute__((ext_vector_type(2)));

constexpr int T_ = 8192, M_ = 32768, D_ = 1024, DFF = 2816;
constexpr int ZLD_E = 3856, ZLD_O = 2816;
constexpr size_t MiB = 1u << 20;
constexpr size_t WS_WB = 1 * MiB, WS_AB = 33 * MiB, WS_VF = 97 * MiB, WS_Z = 129 * MiB;
constexpr size_t WS_U = 370 * MiB, WS_WN = 418 * MiB, WS_GC = 466 * MiB, WS_HALO = 468 * MiB, WS_GCB = 476 * MiB;
constexpr size_t WS_CTL = 0;
constexpr size_t WS_RKV = 129 * MiB, WS_Z2 = 225 * MiB, WS_KH = 225 * MiB, WS_VT = 273 * MiB;
constexpr size_t WS_LA = 305 * MiB, WS_LO = 329 * MiB, WS_KR = 457 * MiB, WS_RS = 459 * MiB;
constexpr size_t WS_QR = 460 * MiB, WS_KVR = 33 * MiB;
constexpr size_t WS_BND = 508 * MiB;
constexpr size_t WS_NEED = 511 * MiB;
constexpr int RKV_LD = 1536, Z2_LD = 1280, SCAN_BLOCKS = 128;
constexpr size_t WB_GU = 0, WB_DN = 11534336, WB_IN = 17301504, WB_OUT = 25690112, WB_LORA = 27787264, WB_UQ = 29360128, WB_UKV = 30146560;
constexpr int LDS_BYTES = 135168;

__device__ __forceinline__ float asf(unsigned u) { return __builtin_bit_cast(float, u); }
__device__ __forceinline__ unsigned asu(float f) { return __builtin_bit_cast(unsigned, f); }
__device__ __forceinline__ float bf2f(bf16_t b) { return asf((unsigned)b << 16); }
__device__ __forceinline__ unsigned pk2(float lo, float hi) { f32x2 v = {lo, hi}; bf16x2_t b = __builtin_convertvector(v, bf16x2_t); return __builtin_bit_cast(unsigned, b); }
__device__ __forceinline__ bf16_t f2bf(float f) { return (bf16_t)(pk2(f, 0.f) & 0xffffu); }
__device__ __forceinline__ void unpack8(u32x4 v, float* f) {
    f[0] = asf(v.x << 16); f[1] = asf(v.x & 0xffff0000u); f[2] = asf(v.y << 16); f[3] = asf(v.y & 0xffff0000u);
    f[4] = asf(v.z << 16); f[5] = asf(v.z & 0xffff0000u); f[6] = asf(v.w << 16); f[7] = asf(v.w & 0xffff0000u);
}
__device__ __forceinline__ u32x4 pack8(const float* f) { u32x4 o; o.x = pk2(f[0], f[1]); o.y = pk2(f[2], f[3]); o.z = pk2(f[4], f[5]); o.w = pk2(f[6], f[7]); return o; }
__device__ __forceinline__ float sigmoidf_(float x) { return __builtin_amdgcn_rcpf(1.f + __expf(-x)); }
__device__ __forceinline__ float siluf_(float x) { return x * __builtin_amdgcn_rcpf(1.f + __expf(-x)); }
__device__ __forceinline__ float softplusf_(float x) { return fmaxf(x, 0.f) + __logf(1.f + __expf(-fabsf(x))); }
__device__ __forceinline__ int crow(int r, int hi) { return (r & 3) + 8 * (r >> 2) + 4 * hi; }
__device__ __forceinline__ float wsum(float v) {
#pragma unroll
    for (int o = 32; o > 0; o >>= 1) v += __shfl_xor(v, o);
    return v;
}
template <int CTRL> __device__ __forceinline__ float dppf(float v) { return __builtin_bit_cast(float, __builtin_amdgcn_update_dpp(0, __builtin_bit_cast(int, v), CTRL, 0xF, 0xF, true)); }
__device__ __forceinline__ float half32_sum(float v) {
    v += dppf<0x128>(v); v += dppf<0x124>(v); v += dppf<0x122>(v); v += dppf<0x121>(v);
    auto r = __builtin_amdgcn_permlane16_swap(asu(v), asu(v), false, false);
    return asf(r[0]) + asf(r[1]);
}
__device__ __forceinline__ float wave_sum_dpp(float v) { v = half32_sum(v); auto r = __builtin_amdgcn_permlane32_swap(asu(v), asu(v), false, false); return asf(r[0]) + asf(r[1]); }
__device__ __forceinline__ float sum8_dpp(float v) { v += dppf<0xB1>(v); v += dppf<0x4E>(v); v += dppf<0x141>(v); return v; }
__device__ __forceinline__ float sum16_dpp(float v) { v += dppf<0xB1>(v); v += dppf<0x4E>(v); v += dppf<0x141>(v); v += dppf<0x140>(v); return v; }
__device__ __forceinline__ bf16x8 pkfrag(const f32x16& v, int s) {
    u32x4 o; o.x = pk2(v[8 * s + 0], v[8 * s + 1]); o.y = pk2(v[8 * s + 2], v[8 * s + 3]); o.z = pk2(v[8 * s + 4], v[8 * s + 5]); o.w = pk2(v[8 * s + 6], v[8 * s + 7]);
    return __builtin_bit_cast(bf16x8, o);
}
__device__ __forceinline__ bf16x8 ldA_perm(const LAS bf16_t* p) { s16x4 a = *(const LAS s16x4*)p; s16x4 b = *(const LAS s16x4*)(p + 8); return (bf16x8){a[0], a[1], a[2], a[3], b[0], b[1], b[2], b[3]}; }
#define LDS_WAIT() asm volatile("s_waitcnt lgkmcnt(0)" ::: "memory")
#define LDS_BARRIER() do { asm volatile("s_waitcnt lgkmcnt(0)" ::: "memory"); __builtin_amdgcn_s_barrier(); asm volatile("" ::: "memory"); } while (0)

namespace pg8 {
#define PG8_LAS __attribute__((address_space(3)))
constexpr int BM = 256, BK = 64, HALF = 128, HTB = HALF * BK * 2, STAGE_BYTES = 8 * HTB, NXCD = 8, WGM = 8;
__host__ __device__ __forceinline__ int lds_byte(int r, int c) { const int st = (r >> 4) * 2 + (c >> 5), rr = r & 15, cc = c & 31, ob = rr * 64 + cc * 2; return st * 1024 + (ob ^ (((ob >> 9) & 1) << 5)); }
__host__ __device__ __forceinline__ void stage_rc(int b, int& R, int& C) { const int st = b / 1024, sb = b % 1024, swz = sb ^ (((sb >> 9) & 1) << 5); R = (st >> 1) * 16 + swz / 64; C = (st & 1) * 32 + (swz % 64) / 2; }
__host__ __device__ __forceinline__ int perm32(int rho) { const int n = rho >> 4, i = rho & 15; return 8 * (i >> 2) + 4 * n + (i & 3); }
struct Unit { int pm, pn; };
struct Gemm { const bf16_t* A; const bf16_t* Bt; int M, N, K, lda; };
struct StaticOrder {
    int nM, nN, nwg, G, c;
    __host__ __device__ void init(int M, int N, int G_, int c_) { nM = M / BM; nN = N / BM; nwg = nM * nN; G = G_; c = c_; }
    __host__ __device__ bool next(int i, Unit& u) const {
        const long L = (long)i * G + c; if (L >= nwg) return false;
        int wgid = (int)L; { const int q = nwg / NXCD, r = nwg % NXCD, xcd = wgid % NXCD, off = wgid / NXCD; wgid = (xcd < r ? xcd * (q + 1) : r * (q + 1) + (xcd - r) * q) + off; }
        const int nig = WGM * nN, gid = wgid / nig, fm = gid * WGM, gsz = (nM - fm) < WGM ? (nM - fm) : WGM;
        u.pm = fm + ((wgid % nig) % gsz); u.pn = (wgid % nig) / gsz; return true;
    }
    __device__ __forceinline__ void a_ready(const Unit&) const {}
    __device__ __forceinline__ void done(const Unit&) const {}
};
struct EpiBf16 {
    static constexpr bool PERM = true;
    bf16_t* O; int ldc; int ncols;
    __device__ __forceinline__ void operator()(const f32x4 (&acc)[2][2][4][2], const Unit& u, int wr, int wc, int fr, int fq) const {
        const int row0 = u.pm * BM + wr * 64 + fr; const int col0 = u.pn * BM + wc * 32 + 8 * fq;
#pragma unroll
        for (int ai = 0; ai < 2; ++ai)
#pragma unroll
            for (int m = 0; m < 4; ++m) { bf16_t* rowp = O + (size_t)(row0 + ai * HALF + m * 16) * ldc + col0;
#pragma unroll
                for (int bj = 0; bj < 2; ++bj) { if (col0 + bj * HALF < ncols) { const f32x4 v0 = acc[ai][bj][m][0], v1 = acc[ai][bj][m][1];
                    u32x4 w; w.x = pk2(v0[0], v0[1]); w.y = pk2(v0[2], v0[3]); w.z = pk2(v1[0], v1[1]); w.w = pk2(v1[2], v1[3]);
                    *(u32x4*)(rowp + bj * HALF) = w; } } }
    }
};
struct EpiSplit {
    static constexpr bool PERM = true;
    bf16_t* O1; int ld1; int split; bf16_t* O2; int ld2; int ncols;
    __device__ __forceinline__ void operator()(const f32x4 (&acc)[2][2][4][2], const Unit& u, int wr, int wc, int fr, int fq) const {
        const int row0 = u.pm * BM + wr * 64 + fr; const int col0 = u.pn * BM + wc * 32 + 8 * fq;
#pragma unroll
        for (int bj = 0; bj < 2; ++bj) { const int cg = col0 + bj * HALF; if (cg < ncols) { bf16_t* base = (cg < split) ? O1 + cg : O2 + (cg - split); const int ld = (cg < split) ? ld1 : ld2;
#pragma unroll
            for (int ai = 0; ai < 2; ++ai)
#pragma unroll
                for (int m = 0; m < 4; ++m) { const f32x4 v0 = acc[ai][bj][m][0], v1 = acc[ai][bj][m][1];
                    u32x4 w; w.x = pk2(v0[0], v0[1]); w.y = pk2(v0[2], v0[3]); w.z = pk2(v1[0], v1[1]); w.w = pk2(v1[2], v1[3]);
                    *(u32x4*)(base + (size_t)(row0 + ai * HALF + m * 16) * ld) = w; } } }
    }
};
struct EpiSwiglu {
    static constexpr bool PERM = true;
    bf16_t* O; int ldc;
    __device__ __forceinline__ void operator()(const f32x4 (&acc)[2][2][4][2], const Unit& u, int wr, int wc, int fr, int fq) const {
        const int row0 = u.pm * BM + wr * 64 + fr; const int col0 = u.pn * HALF + wc * 32 + 8 * fq;
#pragma unroll
        for (int ai = 0; ai < 2; ++ai)
#pragma unroll
            for (int m = 0; m < 4; ++m) { bf16_t* rowp = O + (size_t)(row0 + ai * HALF + m * 16) * ldc + col0;
                float h[8];
#pragma unroll
                for (int n = 0; n < 2; ++n)
#pragma unroll
                    for (int i = 0; i < 4; ++i) { const float g = acc[ai][0][m][n][i], up = acc[ai][1][m][n][i]; h[4 * n + i] = siluf_(g) * up; }
                *(u32x4*)rowp = pack8(h); }
    }
};
struct EpiResid {
    static constexpr bool PERM = false;
    float* out; int ldc;
    __device__ __forceinline__ void operator()(const f32x4 (&acc)[2][2][4][2], const Unit& u, int wr, int wc, int fr, int fq) const {
        const int row0 = u.pm * BM + wr * 64 + fr; const int col0 = u.pn * BM + wc * 32 + 4 * fq;
#pragma unroll
        for (int ai = 0; ai < 2; ++ai)
#pragma unroll
            for (int m = 0; m < 4; ++m) { float* rowp = out + (size_t)(row0 + ai * HALF + m * 16) * ldc + col0;
#pragma unroll
                for (int bj = 0; bj < 2; ++bj)
#pragma unroll
                    for (int n = 0; n < 2; ++n) { f32x4* q = (f32x4*)(rowp + bj * HALF + n * 16); *q = *q + acc[ai][bj][m][n]; }
                asm volatile("" ::: "memory"); }
    }
};

template <class Epi, class Sched>
__device__ __forceinline__ void gemm_phase(PG8_LAS unsigned char* lds, const int tid, const Gemm g, const Sched& S, const Epi& E) {
    constexpr bool ALIGN_EPI = true;
    const int wid = __builtin_amdgcn_readfirstlane(tid >> 6), lane = tid & 63, wr = wid >> 2, wc = wid & 3, fr = lane & 15, fq = lane >> 4;
    const int K = g.K, nt = K / BK, lda = g.lda;
    unsigned voffA[2], voffB[2];
#pragma unroll
    for (int i = 0; i < 2; ++i) { int R, C; stage_rc(tid * 16 + i * 8192, R, C); const int Rb = Epi::PERM ? ((R & ~31) + perm32(R & 31)) : R;
        voffA[i] = (unsigned)(R * lda + C) * 2u; voffB[i] = (unsigned)(Rb * K + C) * 2u; }
    const size_t kstep = (size_t)(BK * 2);
    const size_t hstepA = (size_t)HALF * lda * 2, hstepB = (size_t)HALF * K * 2;
    const size_t tstepA = 2 * hstepA, tstepB = 2 * hstepB;
    const unsigned ldsw = (unsigned)wid * 1024u;
    const int aoff = lds_byte(wr * 64 + fr, fq * 8), boff = lds_byte(wc * 32 + fr, fq * 8);
#define PG8_SA(b, h) (((b) * 2 + (h)) * HTB)
#define PG8_SB(b, h) ((4 + (b) * 2 + (h)) * HTB)
#define PG8_STAGE(bufoff, gbase, voff) do { _Pragma("unroll") for (int _i = 0; _i < 2; ++_i) \
        __builtin_amdgcn_global_load_lds((const unsigned*)((const char*)(gbase) + (voff)[_i]), (PG8_LAS unsigned*)(lds + (bufoff) + ldsw + _i * 8192), 16, 0, 0); } while (0)
#define PG8_LDA(dst, b, h) do { _Pragma("unroll") for (int m = 0; m < 4; ++m) _Pragma("unroll") for (int k = 0; k < 2; ++k) dst[m][k] = *(const PG8_LAS bf16x8*)(lds + PG8_SA(b, h) + aoff + m * 2048 + k * 1024); } while (0)
#define PG8_LDB(dst, b, h) do { _Pragma("unroll") for (int n = 0; n < 2; ++n) _Pragma("unroll") for (int k = 0; k < 2; ++k) dst[n][k] = *(const PG8_LAS bf16x8*)(lds + PG8_SB(b, h) + boff + n * 2048 + k * 1024); } while (0)
#define PG8_MMA(ai, bj, At, Bt) do { __builtin_amdgcn_s_setprio(1); _Pragma("unroll") for (int m = 0; m < 4; ++m) _Pragma("unroll") for (int n = 0; n < 2; ++n) _Pragma("unroll") for (int k = 0; k < 2; ++k) \
        acc[ai][bj][m][n] = __builtin_amdgcn_mfma_f32_16x16x32_bf16(Bt[n][k], At[m][k], acc[ai][bj][m][n], 0, 0, 0); __builtin_amdgcn_s_setprio(0); } while (0)
#define PG8_WAIT_V(n) asm volatile("s_waitcnt vmcnt(" #n ")" ::: "memory")
#define PG8_WAIT_L(n) asm volatile("s_waitcnt lgkmcnt(" #n ")" ::: "memory")
#define PG8_BAR __builtin_amdgcn_s_barrier()
#define PG8_SCHED __builtin_amdgcn_sched_barrier(0)
    Unit cur, nxt; int ui = 0;
    if (!S.next(0, cur)) return;
    f32x4 acc[2][2][4][2];
#pragma unroll
    for (int a = 0; a < 2; ++a)
#pragma unroll
        for (int b = 0; b < 2; ++b)
#pragma unroll
            for (int m = 0; m < 4; ++m)
#pragma unroll
                for (int n = 0; n < 2; ++n) acc[a][b][m][n] = (f32x4){0.f, 0.f, 0.f, 0.f};
    bf16x8 At[4][2], B0[2][2], B1[2][2];
    const char* cA = (const char*)g.A + (size_t)cur.pm * tstepA; const char* cB = (const char*)g.Bt + (size_t)cur.pn * tstepB;
    S.a_ready(cur);
    PG8_STAGE(PG8_SB(0, 0), cB, voffB); PG8_STAGE(PG8_SB(0, 1), cB + hstepB, voffB); PG8_STAGE(PG8_SA(0, 0), cA, voffA); PG8_STAGE(PG8_SA(0, 1), cA + hstepA, voffA);
    if (wr == 1) PG8_BAR;
    PG8_WAIT_V(2); PG8_BAR;
    PG8_STAGE(PG8_SB(1, 0), cB + kstep, voffB); PG8_STAGE(PG8_SA(1, 0), cA + kstep, voffA); PG8_STAGE(PG8_SB(1, 1), cB + hstepB + kstep, voffB);
    PG8_WAIT_V(6); PG8_BAR;
    for (;;) {
        const bool has_next = S.next(ui + 1, nxt);
        const char* nA = has_next ? (const char*)g.A + (size_t)nxt.pm * tstepA : cA; const char* nB = has_next ? (const char*)g.Bt + (size_t)nxt.pn * tstepB : cB;
        for (int t = 0; t < nt; t += 2) {
            const bool last = (t == nt - 2);
            const char* a1 = cA + (size_t)(t + 1) * kstep;
            const char* a2 = last ? nA : cA + (size_t)(t + 2) * kstep; const char* b2 = last ? nB : cB + (size_t)(t + 2) * kstep;
            const char* a3 = a2 + kstep; const char* b3 = b2 + kstep;
            if (last && has_next) S.a_ready(nxt);
            PG8_LDB(B0, 0, 0); PG8_LDB(B1, 0, 1); PG8_SCHED; PG8_LDA(At, 0, 0); PG8_STAGE(PG8_SA(1, 1), a1 + hstepA, voffA);
            PG8_WAIT_V(8); PG8_WAIT_L(0); PG8_BAR; PG8_MMA(0, 0, At, B0); PG8_MMA(0, 1, At, B1); PG8_BAR; PG8_SCHED;
            PG8_LDA(At, 0, 1); PG8_STAGE(PG8_SB(0, 0), b2, voffB); PG8_STAGE(PG8_SB(0, 1), b2 + hstepB, voffB); PG8_STAGE(PG8_SA(0, 0), a2, voffA);
            PG8_WAIT_V(8); PG8_WAIT_L(0); PG8_BAR; PG8_MMA(1, 0, At, B0); PG8_MMA(1, 1, At, B1); PG8_BAR; PG8_SCHED;
            PG8_LDB(B0, 1, 0); PG8_LDB(B1, 1, 1); PG8_SCHED; PG8_LDA(At, 1, 0); PG8_STAGE(PG8_SA(0, 1), a2 + hstepA, voffA);
            PG8_WAIT_V(8); PG8_WAIT_L(0); PG8_BAR; PG8_MMA(0, 0, At, B0); PG8_MMA(0, 1, At, B1); PG8_BAR; PG8_SCHED;
            PG8_LDA(At, 1, 1); PG8_STAGE(PG8_SB(1, 0), b3, voffB); PG8_STAGE(PG8_SB(1, 1), b3 + hstepB, voffB); PG8_STAGE(PG8_SA(1, 0), a3, voffA);
            PG8_WAIT_V(8); PG8_WAIT_L(0); PG8_BAR; PG8_MMA(1, 0, At, B0); PG8_MMA(1, 1, At, B1); PG8_BAR; PG8_SCHED;
        }
        if constexpr (ALIGN_EPI) { if (wr == 0) PG8_BAR; }
        E(acc, cur, wr, wc, fr, fq); S.done(cur);
        if (!has_next) break;
#pragma unroll
        for (int a = 0; a < 2; ++a)
#pragma unroll
            for (int b = 0; b < 2; ++b)
#pragma unroll
                for (int m = 0; m < 4; ++m)
#pragma unroll
                    for (int n = 0; n < 2; ++n) acc[a][b][m][n] = (f32x4){0.f, 0.f, 0.f, 0.f};
        cur = nxt; cA = nA; cB = nB; ++ui;
        if constexpr (ALIGN_EPI) { if (wr == 1) PG8_BAR; }
    }
    PG8_WAIT_V(0);
    if constexpr (!ALIGN_EPI) { if (wr == 0) PG8_BAR; }
    PG8_BAR;
#undef PG8_SA
#undef PG8_SB
#undef PG8_STAGE
#undef PG8_LDA
#undef PG8_LDB
#undef PG8_MMA
#undef PG8_WAIT_V
#undef PG8_WAIT_L
#undef PG8_BAR
#undef PG8_SCHED
}
}

struct Params { const float* in[36]; float* out; unsigned char* ws; int only; int pad; };
struct Ctx { LAS unsigned char* lds; unsigned char* ws; int tid, lane, wave, bid, G, gw, ngw, zo; };

template <class Epi> __device__ __forceinline__ void run_gemm(const Ctx& c, const bf16_t* A, int lda, const bf16_t* Bt, int N, int K, const Epi& E) {
    pg8::Gemm g{A, Bt, M_, N, K, lda}; pg8::StaticOrder S; S.init(M_, N, c.G, c.bid);
    pg8::gemm_phase<Epi, pg8::StaticOrder>(c.lds, c.tid, g, S, E);
}

__device__ __forceinline__ void tr_item(const float* src, int ld, int kv, int nv, const float* ks, bf16_t* dst, int ldd, LAS float* scr, int lane) {
    const int n = lane & 31;
    if (kv >= 64 && nv >= 32 && !ks) {
        float tmp[32]; const float* sp = src + (size_t)(lane >> 5) * ld + n;
#pragma unroll
        for (int i = 0; i < 32; ++i) tmp[i] = sp[(size_t)(2 * i) * ld];
#pragma unroll
        for (int i = 0; i < 32; ++i) scr[(2 * i + (lane >> 5)) * 33 + n] = tmp[i];
    } else {
#pragma unroll 4
        for (int i = 0; i < 32; ++i) { const int kk = 2 * i + (lane >> 5); float v = 0.f; if (kk < kv && n < nv) { v = src[(size_t)kk * ld + n]; if (ks) v *= ks[kk]; } scr[kk * 33 + n] = v; }
    }
    LDS_WAIT(); asm volatile("" ::: "memory");
    const int c = lane & 7;
#pragma unroll
    for (int j = 0; j < 4; ++j) { const int nn = (lane >> 3) + 8 * j; const LAS float* s = scr + (8 * c) * 33 + nn;
        u32x4 o; o.x = pk2(s[0 * 33], s[1 * 33]); o.y = pk2(s[2 * 33], s[3 * 33]); o.z = pk2(s[4 * 33], s[5 * 33]); o.w = pk2(s[6 * 33], s[7 * 33]);
        *(u32x4*)(dst + (size_t)nn * ldd + 8 * c) = o; }
    LDS_WAIT(); asm volatile("" ::: "memory");
}
__device__ __forceinline__ void tr_job(const Ctx& c, const float* src, int ld, int K, int N, const float* ks, bf16_t* dst, int ldd, int Kpad, int Npad) {
    LAS float* scr = (LAS float*)(c.lds + c.wave * 8448);
    const int nnb = Npad / 32, items = (Kpad / 64) * nnb;
    for (int it = c.gw; it < items; it += c.ngw) { const int kb = it / nnb, nb = it % nnb, k0 = 64 * kb, n0 = 32 * nb;
        tr_item(src + (size_t)k0 * ld + n0, ld, K - k0, N - n0, ks ? ks + k0 : nullptr, dst + (size_t)n0 * ldd + k0, ldd, scr, c.lane); }
}
__device__ __forceinline__ void convert_common(const Ctx& c, const Params& p, int L, const float* wout_src) {
    bf16_t* WB = (bf16_t*)(c.ws + WS_WB);
    LAS float* scr = (LAS float*)(c.lds + c.wave * 8448);
    { const float* src = p.in[c.zo + 4] + (size_t)L * D_ * 2 * DFF; bf16_t* dst = (bf16_t*)((unsigned char*)WB + WB_GU);
      const int nnb = 2 * DFF / 32, items = (D_ / 64) * nnb;
      for (int it = c.gw; it < items; it += c.ngw) { const int kb = it / nnb, nb = it % nnb, k0 = 64 * kb, n0 = 32 * nb; const int t = n0 >> 8, w = n0 & 255;
          const int sc = (w < 128) ? 128 * t + w : DFF + 128 * t + (w - 128);
          tr_item(src + (size_t)k0 * (2 * DFF) + sc, 2 * DFF, 64, 32, nullptr, dst + (size_t)n0 * D_ + k0, D_, scr, c.lane); } }
    tr_job(c, p.in[c.zo + 5] + (size_t)L * DFF * D_, D_, DFF, D_, nullptr, (bf16_t*)((unsigned char*)WB + WB_DN), DFF, DFF, D_);
    tr_job(c, wout_src, D_, D_, D_, nullptr, (bf16_t*)((unsigned char*)WB + WB_OUT), D_, D_, D_);
}
__device__ __forceinline__ void convert_even(const Ctx& c, const Params& p, int L) {
    const int e = L >> 1;
    convert_common(c, p, L, p.in[c.zo + 12] + (size_t)e * D_ * D_);
    tr_job(c, p.in[c.zo + 6] + (size_t)e * D_ * 3852, 3852, D_, 3852, nullptr, (bf16_t*)(c.ws + WS_WB + WB_IN), D_, D_, 4096);
}
__device__ __forceinline__ void convert_odd(const Ctx& c, const Params& p, int L) {
    const int o = L >> 1;
    convert_common(c, p, L, p.in[c.zo + 35] + (size_t)o * D_ * D_);
    bf16_t* win = (bf16_t*)(c.ws + WS_WB + WB_IN);
    tr_job(c, p.in[c.zo + 13] + (size_t)o * D_ * 2592, 2592, D_, 2592, nullptr, win, D_, D_, 2592);
    tr_job(c, o ? p.in[c.zo + 25] + (size_t)(o - 1) * D_ * 32 : p.in[c.zo + 25], 32, D_, o ? 32 : 0, nullptr, win + (size_t)2592 * D_, D_, D_, 32);
    tr_job(c, p.in[c.zo + 25], 32, D_, 0, nullptr, win + (size_t)2624 * D_, D_, D_, 192);
    bf16_t* wl = (bf16_t*)(c.ws + WS_WB + WB_LORA);
    { LAS float* scr = (LAS float*)(c.lds + c.wave * 8448);
      const int items = 6 * 64;
      for (int it = c.gw; it < items; it += c.ngw) { const int kb = it / 64, nb = it % 64, n0 = 32 * nb, R = n0 >> 9, nn0 = n0 & 511;
          const float* src = p.in[c.zo + 16]; int kv = 0, ld = 512;
          if (R == 0 && kb == 0) { src = p.in[c.zo + 16] + (size_t)o * 64 * 512 + nn0; kv = 64; }
          else if (R == 1 && kb == 1) { src = p.in[c.zo + 18] + (size_t)o * 64 * 512 + nn0; kv = 64; }
          else if (R == 2 && (kb == 2 || kb == 3)) { src = p.in[c.zo + 19] + (size_t)o * 128 * 512 + (size_t)(kb - 2) * 64 * 512 + nn0; kv = 64; }
          else if (R == 3 && kb == 4 && o > 0) { src = p.in[c.zo + 28] + (size_t)(o - 1) * 32 * 512 + nn0; kv = 32; }
          tr_item(src, ld, kv, kv ? 32 : 0, nullptr, wl + (size_t)n0 * 384 + 64 * kb, 384, scr, c.lane); } }
    tr_job(c, p.in[c.zo + 31] + (size_t)o * 512 * 768, 768, 512, 768, p.in[c.zo + 29] + (size_t)o * 512, (bf16_t*)(c.ws + WS_WB + WB_UQ), 512, 512, 768);
    tr_job(c, p.in[c.zo + 32] + (size_t)o * 256 * 1024, 1024, 256, 1024, p.in[c.zo + 30] + (size_t)o * 256, (bf16_t*)(c.ws + WS_WB + WB_UKV), 256, 256, 1024);
}

__device__ __forceinline__ void rms_rows(const Ctx& c, const float* x, const float* gain, bf16_t* out, float* xcopy) {
    f32x4 gv[4];
#pragma unroll
    for (int j = 0; j < 4; ++j) gv[j] = ((const f32x4*)gain)[c.lane + 64 * j];
    for (int m = c.gw; m < M_; m += c.ngw) {
        const f32x4* xr = (const f32x4*)(x + (size_t)m * D_) + c.lane;
        f32x4 v[4]; float s = 0.f;
#pragma unroll
        for (int j = 0; j < 4; ++j) { v[j] = xr[64 * j]; s += (v[j].x * v[j].x + v[j].y * v[j].y) + (v[j].z * v[j].z + v[j].w * v[j].w); }
        if (xcopy) { f32x4* xc = (f32x4*)(xcopy + (size_t)m * D_) + c.lane;
#pragma unroll
            for (int j = 0; j < 4; ++j) xc[64 * j] = v[j]; }
        const float r = rsqrtf(wave_sum_dpp(s) * (1.f / D_) + 1e-6f);
        u32x2* o8 = (u32x2*)(out + (size_t)m * D_) + c.lane;
#pragma unroll
        for (int j = 0; j < 4; ++j) { u32x2 w; w.x = pk2(v[j].x * r * gv[j].x, v[j].y * r * gv[j].y); w.y = pk2(v[j].z * r * gv[j].z, v[j].w * r * gv[j].w); o8[64 * j] = w; }
    }
}

__device__ __forceinline__ void conv4_silu8(const bf16_t* zp, int t, const float* cw, float* y) {
#pragma unroll
    for (int i = 0; i < 8; ++i) y[i] = 0.f;
#pragma unroll
    for (int j = 0; j < 4; ++j) { const int dt = j - 3;
        if (t + dt >= 0) { float xv[8]; unpack8(*(const u32x4*)(zp + (long)dt * ZLD_E), xv);
            const f32x4 w0 = *(const f32x4*)(cw + j * 2304), w1 = *(const f32x4*)(cw + j * 2304 + 4);
            y[0] += w0.x * xv[0]; y[1] += w0.y * xv[1]; y[2] += w0.z * xv[2]; y[3] += w0.w * xv[3];
            y[4] += w1.x * xv[4]; y[5] += w1.y * xv[5]; y[6] += w1.z * xv[6]; y[7] += w1.w * xv[7]; } }
#pragma unroll
    for (int i = 0; i < 8; ++i) y[i] = siluf_(y[i]);
}
__device__ __forceinline__ void conv4h(const bf16_t* zc, int row, const bf16_t* hp, bool has_prev, const float* cw, float* y) {
#pragma unroll
    for (int i = 0; i < 8; ++i) y[i] = 0.f;
#pragma unroll
    for (int j = 0; j < 4; ++j) { const int rr = row - 3 + j;
        if (rr >= 0 || has_prev) { const bf16_t* src = (rr >= 0) ? zc + (size_t)rr * ZLD_E : hp + (3 + rr) * 384; float xv[8]; unpack8(*(const u32x4*)src, xv);
            const f32x4 w0 = *(const f32x4*)(cw + j * 2304), w1 = *(const f32x4*)(cw + j * 2304 + 4);
            y[0] += w0.x * xv[0]; y[1] += w0.y * xv[1]; y[2] += w0.z * xv[2]; y[3] += w0.w * xv[3];
            y[4] += w1.x * xv[4]; y[5] += w1.y * xv[5]; y[6] += w1.z * xv[6]; y[7] += w1.w * xv[7]; } }
#pragma unroll
    for (int i = 0; i < 8; ++i) y[i] = siluf_(y[i]);
}
__device__ __forceinline__ float sum16(float v) { v += __shfl_xor(v, 1); v += __shfl_xor(v, 2); v += __shfl_xor(v, 4); v += __shfl_xor(v, 8); return v; }

__device__ __forceinline__ void even_prep(const Ctx& c, const Params& p, int e) {
    const bf16_t* Z = (const bf16_t*)(c.ws + WS_Z); bf16_t* Y = (bf16_t*)(c.ws + WS_AB);
    bf16_t* U = (bf16_t*)(c.ws + WS_U); bf16_t* WN = (bf16_t*)(c.ws + WS_WN); float* GC = (float*)(c.ws + WS_GC);
    const float* conv_a = p.in[c.zo + 7] + (size_t)e * 3 * 256; const float* conv_qkv = p.in[c.zo + 8] + (size_t)e * 4 * 2304;
    { const long NT = (long)c.G * 512;
      for (long it = (long)c.bid * 512 + c.tid; it < (long)M_ * 32; it += NT) { const int m = (int)(it >> 5), c8 = (int)(it & 31) * 8, t = m & (T_ - 1);
          const bf16_t* zr = Z + (size_t)m * ZLD_E; float ab[8], acc[8];
          unpack8(*(const u32x4*)(zr + c8), ab);
#pragma unroll
          for (int i = 0; i < 8; ++i) acc[i] = 0.f;
#pragma unroll
          for (int j = 0; j < 3; ++j) { const int dt = j - 2; if (t + dt >= 0) { const bf16_t* zc = zr + (long)dt * ZLD_E; float ac[8], ah[8];
              unpack8(*(const u32x4*)(zc + 256 + c8), ac); unpack8(*(const u32x4*)(zc + 512 + c8), ah);
#pragma unroll
              for (int i = 0; i < 8; ++i) acc[i] += conv_a[j * 256 + c8 + i] * (ac[i] * ah[i]); } }
#pragma unroll
          for (int i = 0; i < 8; ++i) acc[i] *= ab[i];
          *(u32x4*)(Y + (size_t)m * D_ + c8) = pack8(acc); } }
    const bf16_t* HALO = (const bf16_t*)(c.ws + WS_HALO); const float* GCB = (const float*)(c.ws + WS_GCB);
    bf16_t* Zw = (bf16_t*)(c.ws + WS_Z);
    LAS bf16_t* KN = (LAS bf16_t*)(c.lds);
    LAS float* VB = (LAS float*)(c.lds + 17408);
    LAS float* KBG = (LAS float*)(c.lds + 17408 + 32768);
    LAS float* Lm = (LAS float*)(c.lds + 17408 + 65536);
    LAS float* sgc = (LAS float*)(c.lds + 17408 + 65536 + 16384);
    LAS float* sbeta = sgc + 64;
    LAS bf16_t* QS = (LAS bf16_t*)(c.lds + 17408 + 65536 + 16384 + 512);
    for (int item = c.bid; item < 3072; item += c.G) {
        int tid_i = c.tid; asm volatile("" : "+v"(tid_i)); const int lane_i = tid_i & 63;
        const int n = item & 127, bh = item >> 7, h = bh % 6, b = bh / 6; const int m0 = b * T_ + 64 * n;
        if (tid_i < 128) sgc[tid_i] = GCB[(size_t)item * 128 + tid_i];
        __syncthreads();
        const float glast = sgc[63];
        u32x4 qdp0 = {}, qdp1 = {}, kdp0 = {}, kdp1 = {};
#pragma unroll 1
        for (int rep = 0; rep < 2; ++rep) { const int vi = tid_i + 512 * rep, row = vi >> 4, c8 = (vi & 15) * 8;
            const bf16_t* zc = Z + (size_t)m0 * ZLD_E + 768 + h * 128 + c8; const bf16_t* hp = HALO + (size_t)(bh * 128 + n) * 1152 + c8; float y[8], yd[8];
            conv4h(zc, row, hp, n > 0, conv_qkv + h * 128 + c8, y);
            float ss = 0.f;
#pragma unroll
            for (int i = 0; i < 8; ++i) ss += y[i] * y[i];
            ss = sum16_dpp(ss); float rn = rsqrtf(ss + 1e-6f) * 0.08838834764831845f;
            const float eg = __expf(sgc[row]);
#pragma unroll
            for (int i = 0; i < 8; ++i) { y[i] *= rn; yd[i] = y[i] * eg; }
            *(LAS u32x4*)(QS + row * 136 + c8) = pack8(y); { const u32x4 t_ = pack8(yd); if (rep == 0) qdp0 = t_; else qdp1 = t_; }
            conv4h(zc + 768, row, hp + 128, n > 0, conv_qkv + 768 + h * 128 + c8, y);
            ss = 0.f;
#pragma unroll
            for (int i = 0; i < 8; ++i) ss += y[i] * y[i];
            ss = sum16_dpp(ss); rn = rsqrtf(ss + 1e-6f);
            const float bg = sbeta[row] * eg; const float ek = __expf(glast - sgc[row]);
#pragma unroll
            for (int i = 0; i < 8; ++i) { y[i] *= rn; KBG[row * 128 + c8 + i] = y[i] * bg; yd[i] = y[i] * ek; }
            *(LAS u32x4*)(KN + row * 136 + c8) = pack8(y); { const u32x4 t_ = pack8(yd); if (rep == 0) kdp0 = t_; else kdp1 = t_; }
            conv4h(zc + 1536, row, hp + 256, n > 0, conv_qkv + 1536 + h * 128 + c8, y);
            const float be = sbeta[row];
#pragma unroll
            for (int i = 0; i < 8; ++i) VB[row * 128 + c8 + i] = y[i] * be; }
        __syncthreads();
#pragma unroll
        for (int rep = 0; rep < 2; ++rep) { const int vi = tid_i + 512 * rep, row = vi >> 4, c8 = (vi & 15) * 8;
            bf16_t* zc = Zw + (size_t)(m0 + row) * ZLD_E + 768 + h * 128 + c8; *(u32x4*)zc = rep ? qdp1 : qdp0;
            const u32x4 kd_ = rep ? kdp1 : kdp0; bf16_t* kt_ = Zw + (size_t)(m0 + (c8 >> 1)) * ZLD_E + 768 + 768 + h * 128 + row;
            kt_[0] = (bf16_t)(kd_.x & 0xffffu); kt_[64] = (bf16_t)(kd_.x >> 16); kt_[ZLD_E] = (bf16_t)(kd_.y & 0xffffu); kt_[ZLD_E + 64] = (bf16_t)(kd_.y >> 16);
            kt_[2 * ZLD_E] = (bf16_t)(kd_.z & 0xffffu); kt_[2 * ZLD_E + 64] = (bf16_t)(kd_.z >> 16); kt_[3 * ZLD_E] = (bf16_t)(kd_.w & 0xffffu); kt_[3 * ZLD_E + 64] = (bf16_t)(kd_.w >> 16); }
        { const int l31 = lane_i & 31, hh = lane_i >> 5; const int w = c.wave & 3; const int ti = (w == 0 || w == 3) ? 0 : 1, tj = (w >= 2) ? 1 : 0; const bool isq = c.wave >= 4;
            bf16_t* qko = Zw + (size_t)m0 * ZLD_E + 768 + 1536 + h * 128;
            if (w == 3) {
#pragma unroll
                for (int r = 0; r < 16; ++r) { const int i = 32 * ti + crow(r, hh), j = 32 * tj + l31; if (isq) qko[(size_t)i * ZLD_E + j] = 0; else Lm[i * 64 + j] = 0.f; }
            } else { f32x16 acc = {}; const LAS bf16_t* Am = isq ? QS : KN;
#pragma unroll
                for (int ks = 0; ks < 8; ++ks) { const bf16x8 a = *(const LAS bf16x8*)(Am + (32 * ti + l31) * 136 + 16 * ks + 8 * hh); const bf16x8 bb = *(const LAS bf16x8*)(KN + (32 * tj + l31) * 136 + 16 * ks + 8 * hh);
                    acc = __builtin_amdgcn_mfma_f32_32x32x16_bf16(a, bb, acc, 0, 0, 0); }
                const int j = 32 * tj + l31; const float gj = sgc[j];
#pragma unroll
                for (int r = 0; r < 16; ++r) { const int i = 32 * ti + crow(r, hh); const float dec = __expf(fminf(sgc[i] - gj, 0.f));
                    if (isq) qko[(size_t)i * ZLD_E + j] = (i >= j) ? f2bf(acc[r] * dec) : (bf16_t)0;
                    else Lm[i * 64 + j] = (i > j) ? sbeta[i] * acc[r] * dec : 0.f; } } }
        __syncthreads();
        if (tid_i < 256) { const int cc = tid_i & 127; const LAS float* src = (tid_i < 128) ? VB : KBG; float x[64];
            int vz = 0; asm volatile("" : "+v"(vz)); const LAS float* Lv = Lm + vz;
#pragma unroll
            for (int i = 0; i < 64; ++i) x[i] = src[i * 128 + cc];
#pragma unroll
            for (int i = 1; i < 64; ++i) { const LAS f32x4* Lr = (const LAS f32x4*)(Lv + i * 64); float a0 = x[i], a1 = 0.f;
#pragma unroll
                for (int j4 = 0; j4 < (i + 3) / 4; ++j4) { const f32x4 l = Lr[j4];
                    if (4 * j4 + 0 < i) a0 -= l[0] * x[4 * j4 + 0];
                    if (4 * j4 + 1 < i) a1 -= l[1] * x[4 * j4 + 1];
                    if (4 * j4 + 2 < i) a0 -= l[2] * x[4 * j4 + 2];
                    if (4 * j4 + 3 < i) a1 -= l[3] * x[4 * j4 + 3]; }
                x[i] = a0 + a1; }
            LAS float* dstl = (tid_i < 128) ? VB : KBG; const float sg = (tid_i < 128) ? 1.f : -1.f;
#pragma unroll
            for (int i = 0; i < 64; ++i) dstl[i * 128 + cc] = x[i] * sg; }
        __syncthreads();
#pragma unroll 1
        for (int rep = 0; rep < 4; ++rep) { const int vi = tid_i + 512 * rep, row = vi >> 5, which = (vi >> 4) & 1, c8 = (vi & 15) * 8;
            const LAS float* sp = (which ? KBG : VB) + row * 128 + c8; float f[8];
#pragma unroll
            for (int i = 0; i < 8; ++i) f[i] = sp[i];
            bf16_t* dp = (which ? WN : U) + (size_t)(m0 + row) * 768 + h * 128 + c8;
            *(u32x4*)dp = pack8(f); }
        __syncthreads();
    }
}

__device__ __forceinline__ void halo_copy(const Ctx& c, const Params& p, int e) {
    const bf16_t* Z = (const bf16_t*)(c.ws + WS_Z); bf16_t* HALO = (bf16_t*)(c.ws + WS_HALO);
    const int NT = c.G * 512, total = 24 * 128 * 3 * 3 * 16;
    for (int it = c.bid * 512 + c.tid; it < total; it += NT) { const int c8 = (it & 15) * 8; int r_ = it >> 4; const int part = r_ % 3; r_ /= 3; const int r = r_ % 3; r_ /= 3; const int n = r_ & 127, bh = r_ >> 7;
        if (n == 0) continue; const int h = bh % 6, b = bh / 6;
        *(u32x4*)(HALO + ((size_t)(bh * 128 + n) * 3 + r) * 384 + part * 128 + c8) = *(const u32x4*)(Z + (size_t)(b * T_ + 64 * n - 3 + r) * ZLD_E + 768 + part * 768 + h * 128 + c8); }
    float* GCB = (float*)(c.ws + WS_GCB); float* GC = (float*)(c.ws + WS_GC);
    for (int item = c.gw; item < 3072; item += c.ngw) { const int n = item & 127, bh = item >> 7, h = bh % 6, b = bh / 6, t = c.lane;
        const bf16_t* zr = Z + (size_t)(b * T_ + 64 * n + t) * ZLD_E;
        const float braw = bf2f(zr[3840 + h]), araw = bf2f(zr[3846 + h]);
        const float beta = sigmoidf_(braw);
        float g = -__expf(p.in[c.zo + 9][e * 6 + h]) * softplusf_(araw + p.in[c.zo + 10][e * 6 + h]);
#pragma unroll
        for (int o = 1; o < 64; o <<= 1) { const float u = __shfl_up(g, o); if (t >= o) g += u; }
        GCB[(size_t)item * 128 + t] = g; GCB[(size_t)item * 128 + 64 + t] = beta; if (t == 63) GC[(size_t)bh * 128 + n] = __expf(g); }
}

__device__ __forceinline__ void gdn_scan(const Ctx& c, const Params& p, int e) {
    const bf16_t* Z = (const bf16_t*)(c.ws + WS_Z); bf16_t* Y = (bf16_t*)(c.ws + WS_AB);
    const bf16_t* U = (const bf16_t*)(c.ws + WS_U); const bf16_t* WNg = (const bf16_t*)(c.ws + WS_WN); const float* GC = (const float*)(c.ws + WS_GC);
    LAS bf16_t* QD = (LAS bf16_t*)(c.lds);
    LAS bf16_t* WNs = (LAS bf16_t*)(c.lds + 17408);
    LAS bf16_t* UT = (LAS bf16_t*)(c.lds + 34816);
    LAS bf16_t* KDT = (LAS bf16_t*)(c.lds + 52224);
    LAS bf16_t* QK = (LAS bf16_t*)(c.lds + 70656);
    LAS bf16_t* OTb = (LAS bf16_t*)(c.lds + 79872);
    const int l31 = c.lane & 31, hh = c.lane >> 5;
    const bool producer = c.wave >= 4; const int ptid = c.tid & 255;
    for (int item = c.bid; item < 48; item += c.G) {
        const int bh = item >> 1, dvh = item & 1, h = bh % 6, b = bh / 6;
        const int e0 = 64 * dvh + 32 * (c.wave & 1);
#define GDN_LOAD_TILES(nn) do { const size_t mb_ = (size_t)(b * T_ + 64 * (nn)); _Pragma("unroll") for (int k_ = 0; k_ < 4; ++k_) { const size_t rz_ = (mb_ + prow + 16 * k_) * ZLD_E + 768 + h * 128 + pc8; const size_t ru_ = (mb_ + prow + 16 * k_) * 768 + h * 128 + pc8; \
            tq[k_] = *(const u32x4*)(Z + rz_); { const int vi_ = pt_ + 256 * k_, d_ = vi_ >> 3; tk[k_] = *(const u32x4*)(Z + (mb_ + (d_ >> 1)) * ZLD_E + 768 + 768 + h * 128 + (d_ & 1) * 64 + (vi_ & 7) * 8); } tw[k_] = *(const u32x4*)(WNg + ru_); tu[k_] = *(const u32x4*)(U + ru_); } \
            _Pragma("unroll") for (int k_ = 0; k_ < 2; ++k_) tqk[k_] = *(const u32x4*)(Z + (mb_ + qrow + 32 * k_) * ZLD_E + 768 + 1536 + h * 128 + qc8); } while (0)
#define GDN_STORE_TILES() do { _Pragma("unroll") for (int k_ = 0; k_ < 4; ++k_) { const int row_ = prow + 16 * k_; *(LAS u32x4*)(QD + row_ * 136 + pc8) = tq[k_]; *(LAS u32x4*)(WNs + row_ * 136 + pc8) = tw[k_]; *(LAS u32x4*)(UT + row_ * 136 + pc8) = tu[k_]; \
            { const int vi_ = pt_ + 256 * k_; *(LAS u32x4*)(KDT + (vi_ >> 3) * 72 + (vi_ & 7) * 8) = tk[k_]; } } \
            _Pragma("unroll") for (int k_ = 0; k_ < 2; ++k_) *(LAS u32x4*)(QK + (qrow + 32 * k_) * 72 + qc8) = tqk[k_]; } while (0)
#define GDN_STORE_O(nn) do { const LAS bf16_t* ob_ = OTb + ((nn) & 1) * 4608; _Pragma("unroll") for (int k_ = 0; k_ < 2; ++k_) { const int vi_ = pt_ + 256 * k_, row_ = vi_ >> 3, c8_ = (vi_ & 7) * 8; \
            *(u32x4*)(Y + (size_t)(b * T_ + 64 * (nn) + row_) * D_ + 256 + h * 128 + 64 * dvh + c8_) = *(const LAS u32x4*)(ob_ + row_ * 72 + c8_); } } while (0)
        if (producer) {
            int pt_ = ptid; asm volatile("" : "+v"(pt_));
            u32x4 tq[4], tk[4], tw[4], tu[4], tqk[2];
            const int prow = pt_ >> 4, pc8 = (pt_ & 15) * 8;
            const int qrow = pt_ >> 3, qc8 = (pt_ & 7) * 8;
            GDN_LOAD_TILES(0); GDN_STORE_TILES();
            for (int n = 0; n < 128; ++n) {
                LDS_BARRIER();
                if (n + 1 < 128) GDN_LOAD_TILES(n + 1);
                if (n >= 1) GDN_STORE_O(n - 1);
                LDS_BARRIER();
                if (n + 1 < 128) GDN_STORE_TILES();
            }
            LDS_BARRIER();
            GDN_STORE_O(127);
        } else {
            f32x16 S[4];
#pragma unroll
            for (int i = 0; i < 4; ++i) S[i] = (f32x16){};
            float gtn = GC[(size_t)bh * 128];
            for (int n = 0; n < 128; ++n) {
                LDS_BARRIER();
                if (c.wave < 2) {
                const float gt = gtn; if (n + 1 < 128) gtn = GC[(size_t)bh * 128 + n + 1];
                f32x16 av[2];
#pragma unroll
                for (int tc = 0; tc < 2; ++tc)
#pragma unroll
                    for (int r = 0; r < 16; ++r) av[tc][r] = bf2f(UT[(32 * tc + crow(r, hh)) * 136 + e0 + l31]);
                f32x16 ao[2] = {(f32x16){}, (f32x16){}};
                bf16x8 fa[8], fb[8];
#define GDN_LDF_WQ(F, td_) do { _Pragma("unroll") for (int tc = 0; tc < 2; ++tc) _Pragma("unroll") for (int s_ = 0; s_ < 2; ++s_) { const int ko_ = 32 * (td_) + 16 * s_ + 4 * hh; \
                    F[tc * 2 + s_] = ldA_perm(WNs + (32 * tc + l31) * 136 + ko_); F[4 + tc * 2 + s_] = ldA_perm(QD + (32 * tc + l31) * 136 + ko_); } } while (0)
#define GDN_MMA_WQ(F, td_) do { const bf16x8 sb0_ = pkfrag(S[td_], 0), sb1_ = pkfrag(S[td_], 1); \
                    av[0] = __builtin_amdgcn_mfma_f32_32x32x16_bf16(F[0], sb0_, av[0], 0, 0, 0); ao[0] = __builtin_amdgcn_mfma_f32_32x32x16_bf16(F[4], sb0_, ao[0], 0, 0, 0); \
                    av[1] = __builtin_amdgcn_mfma_f32_32x32x16_bf16(F[2], sb0_, av[1], 0, 0, 0); ao[1] = __builtin_amdgcn_mfma_f32_32x32x16_bf16(F[6], sb0_, ao[1], 0, 0, 0); \
                    av[0] = __builtin_amdgcn_mfma_f32_32x32x16_bf16(F[1], sb1_, av[0], 0, 0, 0); ao[0] = __builtin_amdgcn_mfma_f32_32x32x16_bf16(F[5], sb1_, ao[0], 0, 0, 0); \
                    av[1] = __builtin_amdgcn_mfma_f32_32x32x16_bf16(F[3], sb1_, av[1], 0, 0, 0); ao[1] = __builtin_amdgcn_mfma_f32_32x32x16_bf16(F[7], sb1_, ao[1], 0, 0, 0); } while (0)
                GDN_LDF_WQ(fa, 0);
                GDN_LDF_WQ(fb, 1); GDN_MMA_WQ(fa, 0);
                GDN_LDF_WQ(fa, 2); GDN_MMA_WQ(fb, 1);
                GDN_LDF_WQ(fb, 3); GDN_MMA_WQ(fa, 2);
#pragma unroll
                for (int tc = 0; tc < 2; ++tc)
#pragma unroll
                    for (int ts = 0; ts < 2; ++ts)
#pragma unroll
                        for (int s_ = 0; s_ < 2; ++s_) fa[tc * 4 + ts * 2 + s_] = ldA_perm(QK + (32 * tc + l31) * 72 + 32 * ts + 16 * s_ + 4 * hh);
                GDN_MMA_WQ(fb, 3);
#undef GDN_LDF_WQ
#undef GDN_MMA_WQ
                bf16x8 Vb[2][2];
#pragma unroll
                for (int tc = 0; tc < 2; ++tc) { Vb[tc][0] = pkfrag(av[tc], 0); Vb[tc][1] = pkfrag(av[tc], 1); }
#define GDN_LDF_K(F, tdp_) do { _Pragma("unroll") for (int t2_ = 0; t2_ < 2; ++t2_) _Pragma("unroll") for (int tc = 0; tc < 2; ++tc) _Pragma("unroll") for (int s_ = 0; s_ < 2; ++s_) \
                    F[t2_ * 4 + tc * 2 + s_] = ldA_perm(KDT + (32 * (2 * (tdp_) + t2_) + l31) * 72 + 32 * tc + 16 * s_ + 4 * hh); } while (0)
#define GDN_MMA_K(F, tdp_) do { S[2 * (tdp_)] = S[2 * (tdp_)] * gt; S[2 * (tdp_) + 1] = S[2 * (tdp_) + 1] * gt; \
                    _Pragma("unroll") for (int tc = 0; tc < 2; ++tc) _Pragma("unroll") for (int s_ = 0; s_ < 2; ++s_) _Pragma("unroll") for (int t2_ = 0; t2_ < 2; ++t2_) \
                        S[2 * (tdp_) + t2_] = __builtin_amdgcn_mfma_f32_32x32x16_bf16(F[t2_ * 4 + tc * 2 + s_], Vb[tc][s_], S[2 * (tdp_) + t2_], 0, 0, 0); } while (0)
                GDN_LDF_K(fb, 0);
#pragma unroll
                for (int ts = 0; ts < 2; ++ts)
#pragma unroll
                    for (int s_ = 0; s_ < 2; ++s_)
#pragma unroll
                        for (int tc = 0; tc < 2; ++tc) ao[tc] = __builtin_amdgcn_mfma_f32_32x32x16_bf16(fa[tc * 4 + ts * 2 + s_], Vb[ts][s_], ao[tc], 0, 0, 0);
                GDN_LDF_K(fa, 1); GDN_MMA_K(fb, 0);
                GDN_MMA_K(fa, 1);
#undef GDN_LDF_K
#undef GDN_MMA_K
                LAS bf16_t* ob = OTb + (n & 1) * 4608;
#pragma unroll
                for (int tc = 0; tc < 2; ++tc)
#pragma unroll
                    for (int r = 0; r < 16; ++r) ob[(32 * tc + crow(r, hh)) * 72 + 32 * (c.wave & 1) + l31] = f2bf(ao[tc][r]);
                }
                LDS_BARRIER();
            }
            LDS_BARRIER();
        }
        __syncthreads();
#undef GDN_LOAD_TILES
#undef GDN_STORE_TILES
#undef GDN_STORE_O
    }
}
__device__ __forceinline__ void gdn_post(const Ctx& c, const Params& p, int e) {
    const bf16_t* Z = (const bf16_t*)(c.ws + WS_Z); bf16_t* Y = (bf16_t*)(c.ws + WS_AB); const float* onorm = p.in[c.zo + 11] + (size_t)e * 128;
    const int NT = c.G * 512, total = M_ * 24;
    for (int it = c.bid * 512 + c.tid; it < total; it += NT) { const int part = it & 3, h = (it >> 2) % 6, m = (it >> 2) / 6;
        bf16_t* yo = Y + (size_t)m * D_ + 256 + h * 128 + 32 * part; const bf16_t* zg = Z + (size_t)m * ZLD_E + 3072 + h * 128 + 32 * part; const float* on = onorm + 32 * part;
        float ov[32]; float ss = 0.f;
#pragma unroll
        for (int k = 0; k < 4; ++k) unpack8(*(const u32x4*)(yo + 8 * k), ov + 8 * k);
#pragma unroll
        for (int k = 0; k < 32; ++k) ss += ov[k] * ov[k];
        ss += dppf<0xB1>(ss); ss += dppf<0x4E>(ss);
        const float rn = rsqrtf(ss * (1.f / 128.f) + 1e-6f);
#pragma unroll
        for (int k = 0; k < 4; ++k) { float gz[8], out[8]; unpack8(*(const u32x4*)(zg + 8 * k), gz);
#pragma unroll
            for (int i = 0; i < 8; ++i) out[i] = ov[8 * k + i] * rn * on[8 * k + i] * siluf_(gz[i]);
            *(u32x4*)(yo + 8 * k) = pack8(out); } }
}

__device__ __forceinline__ float lerp_prev(const bf16_t* zp, int ld, int t, float mu) { const float z = bf2f(zp[0]); const float zq = (t > 0) ? bf2f(*(zp - ld)) : 0.f; return z + mu * (zq - z); }

__device__ __forceinline__ void odd_prep_a(const Ctx& c, const Params& p, int o) {
    const bf16_t* Z2 = (const bf16_t*)(c.ws + WS_Z2); bf16_t* LA = (bf16_t*)(c.ws + WS_LA); bf16_t* KR = (bf16_t*)(c.ws + WS_KR); float* RS = (float*)(c.ws + WS_RS);
    const float* mu = p.in[c.zo + 14] + (size_t)o * 1792; const float* vmu = o ? p.in[c.zo + 26] + (size_t)(o - 1) * 32 : p.in[c.zo + 26];
    if (c.bid == 0 && c.tid == 0) { unsigned* ctl = (unsigned*)(c.ws + WS_CTL); ctl[64 * o] = 0u; ctl[64 * o + 16] = 0u; }
    const int grp = c.lane; const int kind = grp < 8 ? 0 : grp < 16 ? 1 : grp < 32 ? 2 : grp < 36 ? 3 : 4;
    const int zc = (kind < 3) ? 8 * grp : 1056 + 8 * (grp - 32);
    float mv[8];
#pragma unroll
    for (int i = 0; i < 8; ++i) mv[i] = (kind < 3) ? mu[1536 + 8 * grp + i] : (kind == 3 ? vmu[8 * (grp - 32) + i] : 0.f);
    for (int m = c.gw; m < M_; m += c.ngw) { const int t = m & (T_ - 1); const bf16_t* zr = Z2 + (size_t)m * Z2_LD;
        if (grp < 48) { float out[8];
#pragma unroll
            for (int i = 0; i < 8; ++i) out[i] = 0.f;
            if (kind < 3 || (kind == 3 && o > 0)) { float cu[8], pv[8]; unpack8(*(const u32x4*)(zr + zc), cu);
                if (t > 0) unpack8(*(const u32x4*)(zr + zc - Z2_LD), pv); else {
#pragma unroll
                    for (int i = 0; i < 8; ++i) pv[i] = 0.f; }
#pragma unroll
                for (int i = 0; i < 8; ++i) { const float x = cu[i] + mv[i] * (pv[i] - cu[i]); out[i] = (kind == 0) ? (2.f * sigmoidf_(2.f * x) - 1.f) : (kind == 2 ? sigmoidf_(x) : x); } }
            *(u32x4*)(LA + (size_t)m * 384 + 8 * grp) = pack8(out); }
        if (c.lane < 32) KR[(size_t)m * 32 + c.lane] = zr[1024 + c.lane];
        float f[8]; unpack8(*(const u32x4*)(zr + 256 + 8 * c.lane), f); float s1 = 0.f;
#pragma unroll
        for (int i = 0; i < 8; ++i) s1 += f[i] * f[i];
        const u32x2 kvv = *(const u32x2*)(zr + 768 + 4 * c.lane);
        const float k0 = asf(kvv.x << 16), k1 = asf(kvv.x & 0xffff0000u), k2 = asf(kvv.y << 16), k3 = asf(kvv.y & 0xffff0000u);
        float s2 = (k0 * k0 + k1 * k1) + (k2 * k2 + k3 * k3);
        s1 = wave_sum_dpp(s1); s2 = wave_sum_dpp(s2);
        if (c.lane == 0) { RS[2 * m] = rsqrtf(s1 * (1.f / 512.f) + 1e-6f); RS[2 * m + 1] = rsqrtf(s2 * (1.f / 256.f) + 1e-6f); } }
}

__device__ __forceinline__ void rwkv_bnd_copy(const Ctx& c, const Params& p) {
    const bf16_t* RKV = (const bf16_t*)(c.ws + WS_RKV); bf16_t* BND = (bf16_t*)(c.ws + WS_BND);
    const int NT = c.G * 512, total = 1024 * 192;
    for (int it = c.bid * 512 + c.tid; it < total; it += NT) { const int rg = it / 192, c8 = (it % 192) * 8;
        if ((rg & 255) == 0) continue;
        *(u32x4*)(BND + (size_t)rg * 1536 + c8) = *(const u32x4*)(RKV + (size_t)(32 * rg - 1) * RKV_LD + c8); }
}
__device__ __forceinline__ void unpack4(u32x2 v, float* f) { f[0] = asf(v.x << 16); f[1] = asf(v.x & 0xffff0000u); f[2] = asf(v.y << 16); f[3] = asf(v.y & 0xffff0000u); }
__device__ __forceinline__ u32x2 pack4(const float* f) { u32x2 o; o.x = pk2(f[0], f[1]); o.y = pk2(f[2], f[3]); return o; }
__device__ __forceinline__ void rwkv_prep(const Ctx& c, const Params& p, int o) {
    bf16_t* RKV = (bf16_t*)(c.ws + WS_RKV); bf16_t* LO = (bf16_t*)(c.ws + WS_LO); bf16_t* VF = (bf16_t*)(c.ws + WS_VF); bf16_t* Y = (bf16_t*)(c.ws + WS_AB);
    const bf16_t* BND = (const bf16_t*)(c.ws + WS_BND); float* BON = (float*)(c.ws + WS_LA);
    const float* mu = p.in[c.zo + 14] + (size_t)o * 1792; const float* w0 = p.in[c.zo + 15] + (size_t)o * 512; const float* a0 = p.in[c.zo + 17] + (size_t)o * 512;
    const float* k_k = p.in[c.zo + 20] + (size_t)o * 512; const float* k_a = p.in[c.zo + 21] + (size_t)o * 512; const float* r_k = p.in[c.zo + 22] + (size_t)o * 512;
    const float* v0p = o ? p.in[c.zo + 27] + (size_t)(o - 1) * 512 : p.in[c.zo + 27];
    for (int item = c.gw; item < 2048; item += c.ngw) { const int rg = item >> 1, hf = item & 1, m0 = 32 * rg; const bool seq0 = (rg & 255) == 0;
        int ln_ = c.lane; asm volatile("" : "+v"(ln_));
        const int h = 4 * hf + (ln_ >> 4), c4 = h * 64 + 4 * (ln_ & 15);
        const f32x4 mur = *(const f32x4*)(mu + c4), muk = *(const f32x4*)(mu + 512 + c4), muv = *(const f32x4*)(mu + 1024 + c4), w0c = *(const f32x4*)(w0 + c4), a0c = *(const f32x4*)(a0 + c4);
        const f32x4 kkc = *(const f32x4*)(k_k + c4), kac = *(const f32x4*)(k_a + c4), v0c = *(const f32x4*)(v0p + c4), rkc = *(const f32x4*)(r_k + c4);
        u32x2 cr, ck, cv, pr, pk, pv, wl, al, vl = {}, vf = {};
        { const bf16_t* zr = RKV + (size_t)(m0 + 31) * RKV_LD + c4; cr = *(const u32x2*)zr; ck = *(const u32x2*)(zr + 512); cv = *(const u32x2*)(zr + 1024);
          const bf16_t* zq = zr - RKV_LD; pr = *(const u32x2*)zq; pk = *(const u32x2*)(zq + 512); pv = *(const u32x2*)(zq + 1024);
          const bf16_t* lo = LO + (size_t)(m0 + 31) * 2048 + c4; wl = *(const u32x2*)lo; al = *(const u32x2*)(lo + 512); if (o) { vl = *(const u32x2*)(lo + 1536); vf = *(const u32x2*)(VF + (size_t)(m0 + 31) * 512 + c4); } }
#pragma unroll 2
        for (int tt = 31; tt >= 0; --tt) { const int m = m0 + tt;
            u32x2 qr = {}, qk = {}, qv = {}, nwl = {}, nal = {}, nvl = {}, nvf = {};
            if (tt >= 2) { const bf16_t* zq = RKV + (size_t)(m - 2) * RKV_LD + c4; qr = *(const u32x2*)zq; qk = *(const u32x2*)(zq + 512); qv = *(const u32x2*)(zq + 1024); }
            else if (tt == 1 && !seq0) { const bf16_t* zq = BND + (size_t)rg * 1536 + c4; qr = *(const u32x2*)zq; qk = *(const u32x2*)(zq + 512); qv = *(const u32x2*)(zq + 1024); }
            if (tt >= 1) { const bf16_t* ln = LO + (size_t)(m - 1) * 2048 + c4; nwl = *(const u32x2*)ln; nal = *(const u32x2*)(ln + 512); if (o) { nvl = *(const u32x2*)(ln + 1536); nvf = *(const u32x2*)(VF + (size_t)(m - 1) * 512 + c4); } }
            const bool has_prev = (tt > 0) || !seq0;
            float fcr[4], fck[4], fcv[4], fpr[4], fpk[4], fpv[4], fwl[4], fal[4], fvl[4], fvf[4];
            unpack4(cr, fcr); unpack4(ck, fck); unpack4(cv, fcv); unpack4(pr, fpr); unpack4(pk, fpk); unpack4(pv, fpv); unpack4(wl, fwl); unpack4(al, fal); unpack4(vl, fvl); unpack4(vf, fvf);
            float r_[4], kx_[4], v_[4], ew_[4], ka_[4], kq_[4], a_[4]; float ss = 0.f, bs = 0.f;
#pragma unroll
            for (int j = 0; j < 4; ++j) { const float xr = has_prev ? fpr[j] : 0.f, xk = has_prev ? fpk[j] : 0.f, xv = has_prev ? fpv[j] : 0.f;
                r_[j] = fcr[j] + mur[j] * (xr - fcr[j]); const float kr = fck[j] + muk[j] * (xk - fck[j]); float v = fcv[j] + muv[j] * (xv - fcv[j]);
                ew_[j] = 0.6065306597126334f * sigmoidf_(w0c[j] + fwl[j]);
                a_[j] = sigmoidf_(a0c[j] + fal[j]);
                kq_[j] = kr * kkc[j]; ss += kq_[j] * kq_[j];
                kx_[j] = kr * (1.f + (a_[j] - 1.f) * kac[j]);
                if (o) v = v + (fvf[j] - v) * sigmoidf_(v0c[j] + fvl[j]);
                v_[j] = v; bs += r_[j] * kx_[j] * rkc[j]; }
            ss = sum16_dpp(ss); bs = sum16_dpp(bs);
            const float rn = rsqrtf(ss + 1e-6f); float kk_[4];
#pragma unroll
            for (int j = 0; j < 4; ++j) { kk_[j] = kq_[j] * rn; ka_[j] = kk_[j] * a_[j]; }
            if (o == 0) *(u32x2*)(VF + (size_t)m * 512 + c4) = pack4(v_);
            bf16_t* zr = RKV + (size_t)m * RKV_LD + c4; *(u32x2*)zr = pack4(r_); *(u32x2*)(zr + 512) = pack4(kx_); *(u32x2*)(zr + 1024) = pack4(v_);
            bf16_t* lo = LO + (size_t)m * 2048 + c4; *(u32x2*)lo = pack4(ew_); *(u32x2*)(lo + 512) = pack4(ka_); *(u32x2*)(Y + (size_t)m * D_ + c4) = pack4(kk_);
            if ((ln_ & 15) == 0) BON[(size_t)m * 8 + h] = bs;
            cr = pr; ck = pk; cv = pv; pr = qr; pk = qk; pv = qv; wl = nwl; al = nal; vl = nvl; vf = nvf; } }
}
struct RwkvRegs { unsigned short vr[8], vx[8], vv[8], ve[8], va[8], vk[8]; };
__device__ __forceinline__ void rwkv_load_chunk(RwkvRegs& R, int n, int pw, int b, int col, const bf16_t* RKV, const bf16_t* LO, const bf16_t* Y) {
#pragma unroll
    for (int i = 0; i < 8; ++i) { const int tt = pw + 4 * i, m = b * T_ + 32 * n + tt; const bf16_t* zr = RKV + (size_t)m * RKV_LD; const bf16_t* lo = LO + (size_t)m * 2048;
        R.vr[i] = zr[col]; R.vx[i] = zr[512 + col]; R.vv[i] = zr[1024 + col]; R.ve[i] = lo[col]; R.va[i] = lo[512 + col]; R.vk[i] = Y[(size_t)m * D_ + col]; }
}
__device__ __forceinline__ void rwkv_write_chunk(LAS float* L, const RwkvRegs& R, int n, int pw, int lane) {
    LAS float* st = L + (n & 1) * 12288;
#pragma unroll
    for (int i = 0; i < 8; ++i) { const int tt = pw + 4 * i; LAS float* q = st + tt * 64 + lane;
        q[0] = bf2f(R.vr[i]); q[2048] = __expf(-bf2f(R.ve[i])); q[4096] = bf2f(R.vx[i]); q[6144] = bf2f(R.vk[i]); q[8192] = bf2f(R.va[i]); q[10240] = bf2f(R.vv[i]); }
}
__device__ __forceinline__ void rwkv_store_chunk(const LAS float* L, int n, int pw, int lane, int b, int col, bf16_t* YR, int half) {
    const LAS float* sY = L + 24576 + (n & 1) * 2048;
#pragma unroll
    for (int i = 0; i < 8; ++i) { const int tt = pw + 4 * i, m = b * T_ + 32 * n + tt; if ((lane >> 4) == half) YR[(size_t)m * 2048 + 1536 + col] = f2bf(sY[tt * 64 + lane]); }
}
__device__ __forceinline__ void rwkv_scan(const Ctx& c, const Params& p, int o, int nblk) {
    const bf16_t* RKV = (const bf16_t*)(c.ws + WS_RKV); const bf16_t* LO = (const bf16_t*)(c.ws + WS_LO); bf16_t* Y = (bf16_t*)(c.ws + WS_AB);
    LAS float* L = (LAS float*)(c.lds);
    const bool producer = c.wave >= 4;
    for (int item = c.bid; item < 128; item += nblk) {
        const int bh = item >> 2, half = item & 3, b = bh >> 3, h = bh & 7; const int col = h * 64 + c.lane;
        if (producer) {
            const int pw = c.wave - 4;
            RwkvRegs R;
            rwkv_load_chunk(R, 0, pw, b, col, RKV, LO, Y); rwkv_write_chunk(L, R, 0, pw, c.lane);
            rwkv_load_chunk(R, 1, pw, b, col, RKV, LO, Y);
            for (int n = 0; n < 256; ++n) {
                LDS_BARRIER();
                if (n + 1 < 256) rwkv_write_chunk(L, R, n + 1, pw, c.lane);
                if (n + 2 < 256) rwkv_load_chunk(R, n + 2, pw, b, col, RKV, LO, Y);
                if (n >= 1) rwkv_store_chunk(L, n - 1, pw, c.lane, b, col, (bf16_t*)LO, half);
            }
            LDS_BARRIER();
            rwkv_store_chunk(L, 255, pw, c.lane, b, col, (bf16_t*)LO, half);
        } else {
            f32x2 s2[2];
            s2[0] = (f32x2){0.f, 0.f}; s2[1] = (f32x2){0.f, 0.f};
            const int row = 16 * half + 4 * c.wave + (c.lane >> 4), kq = c.lane & 15;
            for (int n = 0; n < 256; ++n) {
                LDS_BARRIER();
                const LAS float* st = L + (n & 1) * 12288 + 4 * kq; const LAS float* sV = L + (n & 1) * 12288 + 10240 + row; LAS float* sY = L + 24576 + (n & 1) * 2048 + row;
                float yreg[32];
#pragma unroll
                for (int tt = 0; tt < 32; ++tt) { const LAS float* q4 = st + tt * 64;
                    const f32x4 rr = *(const LAS f32x4*)(q4), wd = *(const LAS f32x4*)(q4 + 2048), kx = *(const LAS f32x4*)(q4 + 4096), kk = *(const LAS f32x4*)(q4 + 6144), ka = *(const LAS f32x4*)(q4 + 8192);
                    const float vv = sV[tt * 64];
#define P2(v4, i) ((f32x2){v4[2 * (i)], v4[2 * (i) + 1]})
                    const f32x2 pa = s2[0] * P2(kk, 0) + s2[1] * P2(kk, 1);
                    float px_ = sum16_dpp(pa.x + pa.y); asm volatile("" : "+v"(px_)); const float sa = -px_;
                    s2[0] = s2[0] * P2(wd, 0) + (P2(ka, 0) * sa + P2(kx, 0) * vv); s2[1] = s2[1] * P2(wd, 1) + (P2(ka, 1) * sa + P2(kx, 1) * vv);
                    const f32x2 ya = s2[0] * P2(rr, 0) + s2[1] * P2(rr, 1);
#undef P2
                    float yx_ = sum16_dpp(ya.x + ya.y); asm volatile("" : "+v"(yx_));
                    yreg[tt] = yx_; }
                if (kq == 0) {
#pragma unroll
                    for (int tt = 0; tt < 32; ++tt) sY[tt * 64] = yreg[tt]; }
            }
            LDS_BARRIER();
        }
        LDS_BARRIER();
    }
}
__device__ __forceinline__ void rwkv_post(const Ctx& c, const Params& p, int o) {
    const bf16_t* RKV = (const bf16_t*)(c.ws + WS_RKV); const bf16_t* LO = (const bf16_t*)(c.ws + WS_LO); bf16_t* Y = (bf16_t*)(c.ws + WS_AB);
    const float* lnw = p.in[c.zo + 23] + (size_t)o * 512; const float* lnb = p.in[c.zo + 24] + (size_t)o * 512; const float* BON = (const float*)(c.ws + WS_LA);
    const int h = c.lane >> 3, c8 = h * 64 + 8 * (c.lane & 7);
    float lw[8], lb[8];
#pragma unroll
    for (int i = 0; i < 8; ++i) { lw[i] = lnw[c8 + i]; lb[i] = lnb[c8 + i]; }
    for (int m = c.gw; m < M_; m += c.ngw) { const bf16_t* lo = LO + (size_t)m * 2048;
        float y[8], v[8], g[8]; unpack8(*(const u32x4*)(lo + 1536 + c8), y); unpack8(*(const u32x4*)(RKV + (size_t)m * RKV_LD + 1024 + c8), v); unpack8(*(const u32x4*)(lo + 1024 + c8), g);
        const float bon = BON[(size_t)m * 8 + h];
        float s1 = 0.f;
#pragma unroll
        for (int i = 0; i < 8; ++i) s1 += y[i];
        const float mean = sum8_dpp(s1) * (1.f / 64.f); float s2 = 0.f;
#pragma unroll
        for (int i = 0; i < 8; ++i) { y[i] -= mean; s2 += y[i] * y[i]; }
        const float rs = rsqrtf(sum8_dpp(s2) * (1.f / 64.f) + 64e-5f); float out[8];
#pragma unroll
        for (int i = 0; i < 8; ++i) out[i] = (y[i] * rs * lw[i] + lb[i] + bon * v[i]) * g[i];
        *(u32x4*)(Y + (size_t)m * D_ + c8) = pack8(out); }
}

__device__ __forceinline__ void mla_prep(const Ctx& c, const Params& p, int o) {
    bf16_t* QR = (bf16_t*)(c.ws + WS_QR); const bf16_t* KVR = (const bf16_t*)(c.ws + WS_KVR); const bf16_t* KR = (const bf16_t*)(c.ws + WS_KR); const float* RS = (const float*)(c.ws + WS_RS);
    bf16_t* KH = (bf16_t*)(c.ws + WS_KH); bf16_t* VT = (bf16_t*)(c.ws + WS_VT);
    const float* qln = p.in[c.zo + 33] + (size_t)o * 96; const float* kln = p.in[c.zo + 34] + (size_t)o * 96; const int* pos = (const int*)p.in[c.zo + 1];
    LAS bf16_t* sVT = (LAS bf16_t*)c.lds;
    const int head = c.lane >> 3, sub = c.lane & 7;
    float gqn[8], gkn[8], gq1[2], gq2[2], gk1[2], gk2[2];
#pragma unroll
    for (int i = 0; i < 8; ++i) { gqn[i] = qln[8 * sub + i]; gkn[i] = kln[8 * sub + i]; }
#pragma unroll
    for (int j = 0; j < 2; ++j) { gq1[j] = qln[64 + 2 * sub + j]; gq2[j] = qln[80 + 2 * sub + j]; gk1[j] = kln[64 + 2 * sub + j]; gk2[j] = kln[80 + 2 * sub + j]; }
    const float QSCALE = 0.10206207261596577f * 1.4426950408889634f;
    const float invr = exp2f(-(float)(2 * (c.lane & 15)) * (13.287712379549449f / 32.f)) * 0.15915494309189535f;
    for (int tile = c.bid; tile < 512; tile += c.G) { const int m0 = tile * 64;
#pragma unroll 2
        for (int q = 0; q < 8; ++q) { const int tt = c.wave * 8 + q, m = m0 + tt; const float rsq = RS[2 * m], rskv = RS[2 * m + 1];
            float sn_, cs_; { const float rev = (float)pos[m] * invr; const float fr = rev - floorf(rev); sn_ = __builtin_amdgcn_sinf(fr); cs_ = __builtin_amdgcn_cosf(fr); }
            float cs[2], sn[2];
#pragma unroll
            for (int j = 0; j < 2; ++j) { cs[j] = __shfl(cs_, 2 * sub + j); sn[j] = __shfl(sn_, 2 * sub + j); }
            { bf16_t* qp = QR + (size_t)m * 768 + head * 96; float v[8]; unpack8(*(const u32x4*)(qp + 8 * sub), v);
              const unsigned r1 = *(const unsigned*)(qp + 64 + 2 * sub), r2 = *(const unsigned*)(qp + 80 + 2 * sub);
              float x1[2] = {asf(r1 << 16) * rsq, asf(r1 & 0xffff0000u) * rsq}, x2[2] = {asf(r2 << 16) * rsq, asf(r2 & 0xffff0000u) * rsq};
              float ss = x1[0] * x1[0] + x1[1] * x1[1] + x2[0] * x2[0] + x2[1] * x2[1];
#pragma unroll
              for (int i = 0; i < 8; ++i) { v[i] *= rsq; ss += v[i] * v[i]; }
              const float rn = rsqrtf(sum8_dpp(ss) * (1.f / 96.f) + 1e-6f) ;
#pragma unroll
              for (int i = 0; i < 8; ++i) v[i] = v[i] * rn * gqn[i] * QSCALE;
              float o1[2], o2[2];
#pragma unroll
              for (int j = 0; j < 2; ++j) { const float a = x1[j] * rn * gq1[j], bq = x2[j] * rn * gq2[j]; o1[j] = (a * cs[j] - bq * sn[j]) * QSCALE; o2[j] = (bq * cs[j] + a * sn[j]) * QSCALE; }
              *(u32x4*)(qp + 8 * sub) = pack8(v); *(unsigned*)(qp + 64 + 2 * sub) = pk2(o1[0], o1[1]); *(unsigned*)(qp + 80 + 2 * sub) = pk2(o2[0], o2[1]); }
            { const bf16_t* kp = KVR + (size_t)m * 1024 + head * 128; float v[8]; unpack8(*(const u32x4*)(kp + 8 * sub), v);
              const unsigned r1 = *(const unsigned*)(KR + (size_t)m * 32 + 2 * sub), r2 = *(const unsigned*)(KR + (size_t)m * 32 + 16 + 2 * sub);
              float x1[2] = {asf(r1 << 16), asf(r1 & 0xffff0000u)}, x2[2] = {asf(r2 << 16), asf(r2 & 0xffff0000u)};
              float ss = x1[0] * x1[0] + x1[1] * x1[1] + x2[0] * x2[0] + x2[1] * x2[1];
#pragma unroll
              for (int i = 0; i < 8; ++i) { v[i] *= rskv; ss += v[i] * v[i]; }
              const float rn = rsqrtf(sum8_dpp(ss) * (1.f / 96.f) + 1e-6f);
#pragma unroll
              for (int i = 0; i < 8; ++i) v[i] = v[i] * rn * gkn[i];
              float o1[2], o2[2];
#pragma unroll
              for (int j = 0; j < 2; ++j) { const float a = x1[j] * rn * gk1[j], bq = x2[j] * rn * gk2[j]; o1[j] = a * cs[j] - bq * sn[j]; o2[j] = bq * cs[j] + a * sn[j]; }
              bf16_t* ko = KH + (size_t)m * 768 + head * 96;
              *(u32x4*)(ko + 8 * sub) = pack8(v); *(unsigned*)(ko + 64 + 2 * sub) = pk2(o1[0], o1[1]); *(unsigned*)(ko + 80 + 2 * sub) = pk2(o2[0], o2[1]);
              float vv[8]; unpack8(*(const u32x4*)(kp + 64 + 8 * sub), vv);
#pragma unroll
              for (int i = 0; i < 8; ++i) sVT[(head * 64 + 8 * sub + i) * 72 + tt] = f2bf(vv[i] * rskv); } }
        __syncthreads();
        { const int row = c.tid; const int b = m0 / T_, t0 = m0 & (T_ - 1); bf16_t* dst = VT + ((size_t)(b * 8) * 64 + row) * T_ + t0;
#pragma unroll
          for (int i = 0; i < 8; ++i) *(u32x4*)(dst + 8 * i) = *(const LAS u32x4*)(sVT + row * 72 + 8 * i); }
        __syncthreads();
    }
}

__device__ __forceinline__ void attn_phase(const Ctx& c, const Params& p, int o, int first, int cidx) {
    const bf16_t* QH = (const bf16_t*)(c.ws + WS_QR); const bf16_t* KH = (const bf16_t*)(c.ws + WS_KH); const bf16_t* VT = (const bf16_t*)(c.ws + WS_VT); bf16_t* Y = (bf16_t*)(c.ws + WS_AB);
    const int l31 = c.lane & 31, hh = c.lane >> 5;
    if (c.bid < first) return;
    unsigned* cnt = (unsigned*)(c.ws + WS_CTL) + 64 * o + 16 * cidx;
    LAS bf16_t* sK = (LAS bf16_t*)(c.lds);
    LAS bf16_t* sVt = (LAS bf16_t*)(c.lds + 26624);
    LAS unsigned* sU = (LAS unsigned*)(c.lds + 26624 + 18432);
    const int k0row = c.tid / 12, k0ch = c.tid % 12; const int k1p = c.tid + 512, k1row = k1p / 12, k1ch = k1p % 12; const bool k1on = c.tid < 256;
    const int vrow = c.tid >> 3, vch = c.tid & 7;
    for (;;) {
        if (c.tid == 0) sU[0] = atomicAdd(cnt, 1u);
        __syncthreads();
        const unsigned uu = sU[0];
        __syncthreads();
        if (uu >= 1024u) break;
        const int bh = uu & 31, b = bh >> 3, h = bh & 7; const int qblk = 31 - (int)(uu >> 5); const int q0 = qblk * 256, qs = q0 + 32 * c.wave;
        bf16x8 qf[6]; { const bf16_t* qp = QH + (size_t)(b * T_ + qs + l31) * 768 + h * 96 + 8 * hh;
#pragma unroll
            for (int ks = 0; ks < 6; ++ks) qf[ks] = *(const bf16x8*)(qp + 16 * ks); }
        f32x16 o0 = {}, o1 = {}; float mrun = -INFINITY, lrun = 0.f;
        const int ntile = 4 * (qblk + 1);
        const bf16_t* kg = KH + (size_t)(b * T_) * 768 + h * 96; const bf16_t* vg = VT + (size_t)bh * 64 * T_;
        u32x4 rk0, rk1 = {}, rv;
        rk0 = *(const u32x4*)(kg + (size_t)k0row * 768 + 8 * k0ch); if (k1on) rk1 = *(const u32x4*)(kg + (size_t)k1row * 768 + 8 * k1ch); rv = *(const u32x4*)(vg + (size_t)vrow * T_ + 8 * vch);
        *(LAS u32x4*)(sK + k0row * 104 + 8 * k0ch) = rk0; if (k1on) *(LAS u32x4*)(sK + k1row * 104 + 8 * k1ch) = rk1; *(LAS u32x4*)(sVt + vrow * 72 + 8 * vch) = rv;
        __syncthreads();
        for (int kt = 0; kt < ntile; ++kt) { const int kv0 = kt * 64; const int buf = kt & 1;
            if (kt + 1 < ntile) { const int kn = kv0 + 64;
                rk0 = *(const u32x4*)(kg + (size_t)(kn + k0row) * 768 + 8 * k0ch); if (k1on) rk1 = *(const u32x4*)(kg + (size_t)(kn + k1row) * 768 + 8 * k1ch); rv = *(const u32x4*)(vg + (size_t)vrow * T_ + kn + 8 * vch); }
            if (kv0 <= qs + 31) {
                const LAS bf16_t* kb = sK + buf * 6656 + l31 * 104 + 8 * hh; const LAS bf16_t* vb = sVt + buf * 4608 + l31 * 72 + 4 * hh;
                f32x16 p0 = {}, p1 = {};
#pragma unroll
                for (int ks = 0; ks < 6; ++ks) { const bf16x8 k0 = *(const LAS bf16x8*)(kb + 16 * ks); const bf16x8 k1 = *(const LAS bf16x8*)(kb + 32 * 104 + 16 * ks);
                    p0 = __builtin_amdgcn_mfma_f32_32x32x16_bf16(k0, qf[ks], p0, 0, 0, 0); p1 = __builtin_amdgcn_mfma_f32_32x32x16_bf16(k1, qf[ks], p1, 0, 0, 0); }
                if (kv0 + 63 > qs) { const int q = qs + l31;
#pragma unroll
                    for (int r = 0; r < 16; ++r) { const int kv = kv0 + crow(r, hh); if (kv > q) p0[r] = -INFINITY; if (kv + 32 > q) p1[r] = -INFINITY; } }
                float mxa = fmaxf(fmaxf(p0[0], p1[0]), p0[1]), mxb = fmaxf(fmaxf(p1[1], p0[2]), p1[2]);
#pragma unroll
                for (int r = 3; r < 15; r += 2) { mxa = fmaxf(fmaxf(mxa, p0[r]), p1[r]); mxb = fmaxf(fmaxf(mxb, p0[r + 1]), p1[r + 1]); }
                float mx = fmaxf(fmaxf(mxa, mxb), fmaxf(p0[15], p1[15]));
                { auto rr = __builtin_amdgcn_permlane32_swap(asu(mx), asu(mx), false, false); mx = fmaxf(asf(rr[0]), asf(rr[1])); }
                const float mnew = fmaxf(mrun, mx);
                if (__any(mnew > mrun)) { const float alpha = __builtin_amdgcn_exp2f(mrun - mnew); lrun *= alpha; o0 = o0 * alpha; o1 = o1 * alpha; }
                mrun = mnew;
                f32x16 e0, e1;
#pragma unroll
                for (int r = 0; r < 16; ++r) { e0[r] = __builtin_amdgcn_exp2f(p0[r] - mnew); e1[r] = __builtin_amdgcn_exp2f(p1[r] - mnew); }
                p0 = e0; p1 = e1;
                { const f32x16 t = e0 + e1; lrun += ((t[0] + t[1]) + (t[2] + t[3])) + ((t[4] + t[5]) + (t[6] + t[7])) + ((t[8] + t[9]) + (t[10] + t[11])) + ((t[12] + t[13]) + (t[14] + t[15])); }
                const bf16x8 pf00 = pkfrag(p0, 0), pf01 = pkfrag(p0, 1), pf10 = pkfrag(p1, 0), pf11 = pkfrag(p1, 1);
#define PV_STEP(OACC, mm, ktt, ss, PF) do { OACC = __builtin_amdgcn_mfma_f32_32x32x16_bf16(ldA_perm(vb + (mm) * 32 * 72 + 32 * (ktt) + 16 * (ss)), PF, OACC, 0, 0, 0); } while (0)
                PV_STEP(o0, 0, 0, 0, pf00); PV_STEP(o0, 0, 0, 1, pf01); PV_STEP(o0, 0, 1, 0, pf10); PV_STEP(o0, 0, 1, 1, pf11);
                PV_STEP(o1, 1, 0, 0, pf00); PV_STEP(o1, 1, 0, 1, pf01); PV_STEP(o1, 1, 1, 0, pf10); PV_STEP(o1, 1, 1, 1, pf11);
#undef PV_STEP
            }
            if (kt + 1 < ntile) { const int nb = buf ^ 1;
                *(LAS u32x4*)(sK + nb * 6656 + k0row * 104 + 8 * k0ch) = rk0; if (k1on) *(LAS u32x4*)(sK + nb * 6656 + k1row * 104 + 8 * k1ch) = rk1; *(LAS u32x4*)(sVt + nb * 4608 + vrow * 72 + 8 * vch) = rv; }
            __syncthreads();
        }
        float l; { auto rr = __builtin_amdgcn_permlane32_swap(asu(lrun), asu(lrun), false, false); l = asf(rr[0]) + asf(rr[1]); }
        const float inv = 1.f / l;
        bf16_t* yo = Y + (size_t)(b * T_ + qs + l31) * D_ + 512 + h * 64;
#pragma unroll
        for (int r = 0; r < 16; ++r) { yo[crow(r, hh)] = f2bf(o0[r] * inv); yo[32 + crow(r, hh)] = f2bf(o1[r] * inv); }
    }
}

#define XB_TMO      128
#define XB_XCNT(j)  (256  + 64 * (j))
#define XB_XSUB(j)  (1280 + 64 * (j))
#define XB_XGEN(j)  (2304 + 64 * (j))
#define XB_TOP      3328
#define XB_TOPGEN   3392
#define XCD_BAR_WORDS 3456
#define XB_SPIN_CAP (1u << 22)
__device__ __forceinline__ unsigned xb_ld(unsigned* p)              { return __hip_atomic_load(p, __ATOMIC_RELAXED, __HIP_MEMORY_SCOPE_AGENT); }
__device__ __forceinline__ unsigned xb_add(unsigned* p, unsigned v) { return __hip_atomic_fetch_add(p, v, __ATOMIC_RELAXED, __HIP_MEMORY_SCOPE_AGENT); }
__device__ __forceinline__ unsigned xb_xcc_id() { return (unsigned)__builtin_amdgcn_s_getreg((3 << 11) | 20) & 0xFu; }
#define XB_SPIN(cond, bar) do { unsigned _sp = 0; while (cond) { __builtin_amdgcn_s_sleep(1); \
    if ((++_sp & 255u) == 0u) { if (xb_ld(&(bar)[XB_TMO])) break; if (_sp > XB_SPIN_CAP) { atomicAdd(&(bar)[XB_TMO], 1u); break; } } } } while (0)
struct XcdBarrier { unsigned* bar; unsigned x; volatile LAS unsigned* st; };
__device__ __forceinline__ XcdBarrier xcd_barrier_post(unsigned* bar, volatile LAS unsigned* st) {
    XcdBarrier b; b.bar = bar; b.x = xb_xcc_id(); b.st = st;
    if (threadIdx.x == 0) (void)xb_add(&bar[XB_XCNT(b.x)], 1u);
    return b;
}
__device__ __forceinline__ void xcd_barrier_complete(unsigned* bar, unsigned x, unsigned& nloc, unsigned& nx) {
    const unsigned G = gridDim.x * gridDim.y * gridDim.z;
    unsigned sum, cnt, mine, sp = 0u;
    for (;;) {
        sum = 0u; cnt = 0u; mine = 0u;
#pragma unroll
        for (unsigned j = 0; j < 16; ++j) { const unsigned c = xb_ld(&bar[XB_XCNT(j)]); sum += c; cnt += (c > 0u) ? 1u : 0u; mine = (j == x) ? c : mine; }
        if (sum == G) break;
        __builtin_amdgcn_s_sleep(1);
        if ((++sp & 255u) == 0u) { if (xb_ld(&bar[XB_TMO])) break; if (sp > XB_SPIN_CAP) { atomicAdd(&bar[XB_TMO], 1u); break; } }
    }
    nloc = mine > 0u ? mine : 1u; nx = cnt > 0u ? cnt : 1u;
}
__device__ __forceinline__ void xcd_barrier(const XcdBarrier& b, int wave_s) {
    asm volatile("s_waitcnt vmcnt(0)" ::: "memory");
    __syncthreads();
    int l0_; asm volatile("v_mbcnt_lo_u32_b32 %0, -1, 0\n\tv_mbcnt_hi_u32_b32 %0, -1, %0" : "=v"(l0_));
    if (wave_s == 0 && l0_ == 0) {
        unsigned* bar = b.bar; asm volatile("" : "+s"(bar));
        __builtin_amdgcn_s_waitcnt(0);
        unsigned nloc = b.st[0], nx = b.st[1];
        if (nloc == 0u) { xcd_barrier_complete(bar, b.x, nloc, nx); b.st[0] = nloc; b.st[1] = nx; }
        const unsigned old = xb_add(&bar[XB_XSUB(b.x)], 1u);
        const unsigned gen = old / nloc;
        if (old + 1u == (gen + 1u) * nloc) {
            __builtin_amdgcn_fence(__ATOMIC_RELEASE, "agent");
            asm volatile("s_waitcnt vmcnt(0)" ::: "memory");
            const unsigned og = xb_add(&bar[XB_TOP], 1u);
            const unsigned tg = og / nx;
            if (og + 1u == (tg + 1u) * nx) xb_add(&bar[XB_TOPGEN], 1u);
            else XB_SPIN(xb_ld(&bar[XB_TOPGEN]) == tg, bar);
            __builtin_amdgcn_fence(__ATOMIC_ACQUIRE, "agent");
            xb_add(&bar[XB_XGEN(b.x)], 1u);
            asm volatile("s_waitcnt vmcnt(0)" ::: "memory");
        } else {
            XB_SPIN(xb_ld(&bar[XB_XGEN(b.x)]) == gen, bar);
            __builtin_amdgcn_fence(__ATOMIC_ACQUIRE, "agent");
            asm volatile("s_waitcnt vmcnt(0)" ::: "memory");
        }
    }
    __syncthreads();
}

__global__ void __launch_bounds__(512, 2) fwd_kernel(Params p) {
    extern __shared__ __attribute__((aligned(16))) unsigned char lds_raw[];
    const int wave_s = __builtin_amdgcn_readfirstlane((int)threadIdx.x >> 6);
    const int only = p.only;
#if !MULTI_LAUNCH
    cg::grid_group grid = cg::this_grid();
    { volatile LAS unsigned* misc_ = (volatile LAS unsigned*)((LAS unsigned char*)lds_raw + 131072); if (threadIdx.x < 64) misc_[threadIdx.x] = 0u; }
    __syncthreads();
    (void)xcd_barrier_post((unsigned*)(p.ws + WS_CTL) + 4096, (volatile LAS unsigned*)((LAS unsigned char*)lds_raw + 131072));
#endif
    for (int ph = 0; ph < 44; ++ph) {
        if (only >= 0 && only != ph) continue;
        int zo_ = 0; asm volatile("" : "+s"(zo_));
        int wv_ = wave_s, bid_ = blockIdx.x, G_ = gridDim.x; asm volatile("" : "+s"(wv_), "+s"(bid_), "+s"(G_));
        Ctx c; c.lds = (LAS unsigned char*)lds_raw + zo_;
        { int l_; asm volatile("v_mbcnt_lo_u32_b32 %0, -1, 0\n\tv_mbcnt_hi_u32_b32 %0, -1, %0" : "=v"(l_)); c.lane = l_; c.tid = wv_ * 64 + l_; }
        c.wave = wv_; c.bid = bid_; c.G = G_; c.gw = c.bid * 8 + c.wave; c.ngw = c.G * 8; c.zo = zo_;
        int L, k; if (ph < 10) { L = 0; k = ph; } else if (ph < 22) { L = 1; k = ph - 10; } else if (ph < 32) { L = 2; k = ph - 22; } else { L = 3; k = ph - 32; }
        const uintptr_t wsu_ = (uintptr_t)(*(unsigned char* const*)((const char*)&p.ws + zo_)), outu_ = (uintptr_t)(*(float* const*)((const char*)&p.out + zo_));
        unsigned wlo_ = (unsigned)(wsu_ & 0xffffffffu), whi_ = (unsigned)(wsu_ >> 32), olo_ = (unsigned)(outu_ & 0xffffffffu), ohi_ = (unsigned)(outu_ >> 32);
        wlo_ = (unsigned)__builtin_amdgcn_readfirstlane((int)wlo_); whi_ = (unsigned)__builtin_amdgcn_readfirstlane((int)whi_); olo_ = (unsigned)__builtin_amdgcn_readfirstlane((int)olo_); ohi_ = (unsigned)__builtin_amdgcn_readfirstlane((int)ohi_);
        asm volatile("" : "+s"(wlo_), "+s"(whi_), "+s"(olo_), "+s"(ohi_));
        unsigned char* ws = (unsigned char*)(((uintptr_t)whi_ << 32) | (uintptr_t)wlo_); c.ws = ws; float* xout = (float*)(((uintptr_t)ohi_ << 32) | (uintptr_t)olo_);
        bf16_t* AB = (bf16_t*)(ws + WS_AB); bf16_t* Zb = (bf16_t*)(ws + WS_Z);
        const bf16_t* W_GU = (const bf16_t*)(ws + WS_WB + WB_GU); const bf16_t* W_DN = (const bf16_t*)(ws + WS_WB + WB_DN);
        const bf16_t* W_IN = (const bf16_t*)(ws + WS_WB + WB_IN); const bf16_t* W_OUT = (const bf16_t*)(ws + WS_WB + WB_OUT);
        const bf16_t* W_LORA = (const bf16_t*)(ws + WS_WB + WB_LORA); const bf16_t* W_UQ = (const bf16_t*)(ws + WS_WB + WB_UQ); const bf16_t* W_UKV = (const bf16_t*)(ws + WS_WB + WB_UKV);
        const bool odd = (L & 1) != 0; const int e = L >> 1, o = L >> 1;
        const int kt = odd ? k - 8 : k - 6;
        if (k == 0) {
            const float* xcur = (L == 0) ? p.in[zo_] : xout;
            if (PM & 1) { if (odd) convert_odd(c, p, L); else convert_even(c, p, L); }
            if (PM & 2) rms_rows(c, xcur, p.in[2 + zo_] + (size_t)L * D_, AB, L == 0 ? xout : nullptr);
        } else if (kt == 0) { if (PM & 1024) run_gemm(c, AB, D_, W_OUT, D_, D_, pg8::EpiResid{xout, D_});
        } else if (kt == 1) { if (PM & 2) rms_rows(c, xout, p.in[3 + zo_] + (size_t)L * D_, AB, nullptr);
        } else if (kt == 2) { if (PM & 2048) run_gemm(c, AB, D_, W_GU, 2 * DFF, D_, pg8::EpiSwiglu{Zb, DFF});
        } else if (kt == 3) { if (PM & 1024) run_gemm(c, Zb, DFF, W_DN, D_, DFF, pg8::EpiResid{xout, D_});
        } else if (!odd) {
            if (k == 1) { if (PM & 4) run_gemm(c, AB, D_, W_IN, 4096, D_, pg8::EpiBf16{Zb, ZLD_E, ZLD_E}); }
            else if (k == 2) { if (PM & 8) halo_copy(c, p, e); }
            else if (k == 3) { if (PM & 8) even_prep(c, p, e); }
            else if (k == 4) { if (PM & 16) gdn_scan(c, p, e); }
            else { if (PM & 16) gdn_post(c, p, e); }
        } else {
            if (k == 1) { if (PM & 4) run_gemm(c, AB, D_, W_IN, ZLD_O, D_, pg8::EpiSplit{(bf16_t*)(ws + WS_RKV), RKV_LD, 1536, (bf16_t*)(ws + WS_Z2), Z2_LD, 1536 + Z2_LD}); }
            else if (k == 2) { if (PM & 32) { odd_prep_a(c, p, o); rwkv_bnd_copy(c, p); } }
            else if (k == 3) { if (PM & 4) { run_gemm(c, (const bf16_t*)(ws + WS_LA), 384, W_LORA, o ? 2048 : 1536, 384, pg8::EpiBf16{(bf16_t*)(ws + WS_LO), 2048, 2048});
                       asm volatile("" : "+v"(c.tid));
                       run_gemm(c, (const bf16_t*)(ws + WS_Z2) + 256, Z2_LD, W_UQ, 768, 512, pg8::EpiBf16{(bf16_t*)(ws + WS_QR), 768, 768});
                       asm volatile("" : "+v"(c.tid));
                       run_gemm(c, (const bf16_t*)(ws + WS_Z2) + 768, Z2_LD, W_UKV, 1024, 256, pg8::EpiBf16{(bf16_t*)(ws + WS_KVR), 1024, 1024}); } }
            else if (k == 4) { if (PM & 256) mla_prep(c, p, o); }
            else if (k == 5) { if (PM & 256) rwkv_prep(c, p, o); }
            else if (k == 6) { if (c.bid < SCAN_BLOCKS) { if (PM & 64) rwkv_scan(c, p, o, SCAN_BLOCKS); } if (PM & 512) attn_phase(c, p, o, 0, 0); }
            else { if (PM & 128) rwkv_post(c, p, o); }
        }
#if !MULTI_LAUNCH
        if (ph == 0 && only == -2) grid.sync();
        else if (ph != 43) { XcdBarrier xb; xb.bar = (unsigned*)(ws + WS_CTL) + 4096; xb.x = xb_xcc_id(); xb.st = (volatile LAS unsigned*)((LAS unsigned char*)lds_raw + 131072); xcd_barrier(xb, wave_s); }
#endif
    }
}

constexpr int N_PHASES = 44;

extern "C" void kernel_launch(void* const* d_in, const int* in_sizes, int n_in, void* d_out, int out_size, void* d_ws, size_t ws_size, hipStream_t stream) {
    static int grid = 0;
    if (grid == 0) {
        if (n_in != 36 || ws_size < WS_NEED) { fprintf(stderr, "kernel_launch: unexpected inputs (n_in %d, ws %zu)\n", n_in, ws_size); grid = -1; return; }
        int dev = 0, cus = 0, per_cu = 0;
        hipGetDevice(&dev); hipDeviceGetAttribute(&cus, hipDeviceAttributeMultiprocessorCount, dev);
        hipFuncSetAttribute((const void*)fwd_kernel, hipFuncAttributeMaxDynamicSharedMemorySize, LDS_BYTES);
        hipOccupancyMaxActiveBlocksPerMultiprocessor(&per_cu, (const void*)fwd_kernel, 512, LDS_BYTES);
        (void)hipGetLastError();
        if (per_cu < 1) per_cu = 1;
        grid = cus * 1;
        if (grid <= 0) grid = 256;
    }
    if (grid < 0) return;
    (void)hipMemsetAsync(d_ws, 0, 65536, stream);
    Params prm{};
    for (int i = 0; i < 36; ++i) prm.in[i] = (const float*)d_in[i];
    prm.out = (float*)d_out; prm.ws = (unsigned char*)d_ws; prm.only = -1; prm.pad = 0;
#if MULTI_LAUNCH
    for (int ph = 0; ph < N_PHASES; ++ph) { prm.only = ph; hipLaunchKernelGGL(fwd_kernel, dim3(grid), dim3(512), LDS_BYTES, stream, prm); }
#else
    void* args[] = {&prm};
    hipError_t e = hipLaunchCooperativeKernel((const void*)fwd_kernel, dim3(grid), dim3(512), args, LDS_BYTES, stream);
    if (e != hipSuccess) fprintf(stderr, "cooperative launch failed: %s (grid %d)\n", hipGetErrorString(e), grid);
#endif
}
```
